# Optimizing an MI355X kernel written in HIP

```python
import math
import jax
import jax.numpy as jnp
from jax import lax
import numpy as np

D_MODEL = 2048
BATCH = 32
SEQ = 256
DEPTH = 2
DEC_BATCH = 2
DEC_SEQ = 1024
PAST_LEN = 512

GRID_W = 64
N_HEADS = 16
HEAD_DIM = D_MODEL // N_HEADS
NA_KH = 8
NA_KW = 16
Q_BLOCK = 128
ROW_BLOCK = Q_BLOCK // GRID_W
GROUP_CH = 16
N_GROUPS = D_MODEL // GROUP_CH
SSM_STATE = 64
D_FF = 128 * ((8 * D_MODEL // 3 + 127) // 128)
N_ATTN = (DEPTH + 1) // 2
N_SSM = DEPTH // 2
NORM_EPS = 1e-6
NEG_INF = -1e30

kernel_name = 'hybrid_na_s5_prefix_diffusion_step'


def rms_norm(x, g):
    xf = x.astype(jnp.float32)
    y = xf * lax.rsqrt(jnp.mean(xf * xf, axis=-1, keepdims=True) + NORM_EPS)
    return (y * g.astype(jnp.float32)).astype(x.dtype)


def ada_params(cond, w, b):
    mod = jax.nn.silu(cond) @ w + b
    return jnp.split(mod[:, None, :], 6, axis=-1)


def split_heads(t):
    return t.reshape(t.shape[:-1] + (N_HEADS, HEAD_DIM))


def dense_attention(q, k, v):
    bsz, length = q.shape[:2]
    nb = length // Q_BLOCK
    qb = q.reshape(bsz, nb, Q_BLOCK, N_HEADS, HEAD_DIM).swapaxes(0, 1)

    def one_block(qi):
        s = jnp.einsum('bqhd,bkhd->bhqk', qi, k).astype(jnp.float32) * HEAD_DIM ** -0.5
        p = jax.nn.softmax(s, axis=-1).astype(v.dtype)
        return jnp.einsum('bhqk,bkhd->bqhd', p, v)

    o = lax.map(one_block, qb)
    return o.swapaxes(0, 1).reshape(bsz, length, D_MODEL)


def na_context(h, w_qkv, w_o):
    q, k, v = (split_heads(t) for t in jnp.split(h @ w_qkv, 3, axis=-1))
    return dense_attention(q, k, v) @ w_o, k, v


def na_latent(h, k_ctx, v_ctx, w_qkv, rpb, w_o):
    bsz, length, _ = h.shape
    rows = length // GRID_W
    kh = min(NA_KH, rows)
    nrb = rows // ROW_BLOCK
    q, k, v = (split_heads(t).reshape(bsz, rows, GRID_W, N_HEADS, HEAD_DIM)
               for t in jnp.split(h @ w_qkv, 3, axis=-1))
    r = jnp.arange(rows)
    row_idx = jnp.clip(r - kh // 2, 0, rows - kh)[:, None] + jnp.arange(kh)[None, :]
    drow = row_idx - r[:, None]
    col = jnp.arange(GRID_W)
    col_start = jnp.clip(col - NA_KW // 2, 0, GRID_W - NA_KW)
    col_in = (col[None, :] >= col_start[:, None]) & (col[None, :] < col_start[:, None] + NA_KW)
    dcol = jnp.clip(col[None, :] - col[:, None], -(NA_KW - 1), NA_KW - 1) + NA_KW - 1
    col_bias = jnp.where(col_in, rpb.astype(jnp.float32)[:, :, dcol], NEG_INF)
    scale = HEAD_DIM ** -0.5
    n_win = kh * GRID_W

    def one_block(args):
        q_b, ridx, dr = args
        k_rows = k[:, ridx]
        v_rows = v[:, ridx]
        bias = col_bias[:, dr + NA_KH - 1].transpose(0, 1, 3, 2, 4)
        s_win = jnp.einsum('brqhd,brjkhd->bhrqjk', q_b, k_rows).astype(jnp.float32) * scale + bias
        s_ctx = jnp.einsum('brqhd,bkhd->bhrqk', q_b, k_ctx).astype(jnp.float32) * scale
        logits = jnp.concatenate([s_win.reshape(s_win.shape[:4] + (n_win,)), s_ctx], axis=-1)
        p = jax.nn.softmax(logits, axis=-1).astype(v.dtype)
        p_win = p[..., :n_win].reshape(s_win.shape)
        return (jnp.einsum('bhrqjk,brjkhd->brqhd', p_win, v_rows)
                + jnp.einsum('bhrqk,bkhd->brqhd', p[..., n_win:], v_ctx))

    q_blocks = q.reshape(bsz, nrb, ROW_BLOCK, GRID_W, N_HEADS, HEAD_DIM).swapaxes(0, 1)
    o = lax.map(one_block, (q_blocks, row_idx.reshape(nrb, ROW_BLOCK, kh), drow.reshape(nrb, ROW_BLOCK, kh)))
    return o.swapaxes(0, 1).reshape(bsz, length, D_MODEL) @ w_o


def _ssm_combine(e1, e2):
    a1r, a1i, b1r, b1i = e1
    a2r, a2i, b2r, b2i = e2
    return (a1r * a2r - a1i * a2i, a1r * a2i + a1i * a2r,
            a2r * b1r - a2i * b1i + b2r, a2r * b1i + a2i * b1r + b2i)


def s5_direction(ug, h0_re, h0_im, a_re, a_im, log_dt, b_re, b_im, c_re, c_im, reverse):
    length = ug.shape[1]
    dt = jnp.exp(log_dt)[:, None]
    mag = jnp.exp(a_re * dt)
    abar_re = mag * jnp.cos(a_im * dt)
    abar_im = mag * jnp.sin(a_im * dt)
    den = a_re * a_re + a_im * a_im
    num_re = abar_re - 1.0
    coef_re = (num_re * a_re + abar_im * a_im) / den
    coef_im = (abar_im * a_re - num_re * a_im) / den
    bb_re = coef_re[..., None] * b_re - coef_im[..., None] * b_im
    bb_im = coef_re[..., None] * b_im + coef_im[..., None] * b_re
    bu_re = jnp.einsum('blgc,gpc->blgp', ug, bb_re)
    bu_im = jnp.einsum('blgc,gpc->blgp', ug, bb_im)
    edge = length - 1 if reverse else 0
    bu_re = bu_re.at[:, edge].add(abar_re * h0_re - abar_im * h0_im)
    bu_im = bu_im.at[:, edge].add(abar_re * h0_im + abar_im * h0_re)
    a_shape = (1, length) + abar_re.shape
    _, _, hs_re, hs_im = lax.associative_scan(
        _ssm_combine,
        (jnp.broadcast_to(abar_re, a_shape), jnp.broadcast_to(abar_im, a_shape), bu_re, bu_im),
        reverse=reverse, axis=1)
    y = jnp.einsum('blgp,gcp->blgc', hs_re, c_re) - jnp.einsum('blgp,gcp->blgc', hs_im, c_im)
    last = 0 if reverse else length - 1
    return y, hs_re[:, last], hs_im[:, last]


def s5_mixer(h, h0_re, h0_im, w_in, a_re, a_im, log_dt, b_re, b_im, c_re, c_im, d_skip, w_gate, w_out):
    bsz, length, _ = h.shape
    f32 = lambda t: t.astype(jnp.float32)
    u = f32(h @ w_in)
    ug = u.reshape(bsz, length, N_GROUPS, GROUP_CH)
    y = f32(d_skip) * u
    fin_re, fin_im = [], []
    for d, rev in ((0, False), (1, True)):
        y_d, s_re, s_im = s5_direction(ug, f32(h0_re[:, d]), f32(h0_im[:, d]), f32(a_re[d]), f32(a_im[d]),
                                       f32(log_dt[d]), f32(b_re[d]), f32(b_im[d]), f32(c_re[d]),
                                       f32(c_im[d]), rev)
        y = y + y_d.reshape(bsz, length, D_MODEL)
        fin_re.append(s_re)
        fin_im.append(s_im)
    y = jax.nn.gelu(y).astype(h.dtype)
    y = y * jax.nn.sigmoid(y @ w_gate)
    return y @ w_out, jnp.stack(fin_re, axis=1), jnp.stack(fin_im, axis=1)


def conv_ffn(h, w_up, conv_w, conv_b, w_down):
    length = h.shape[1]
    up = h @ w_up
    pad = jnp.pad(up, ((0, 0), (1, 1), (0, 0)))
    z = conv_w[0] * pad[:, :length] + conv_w[1] * pad[:, 1:length + 1] + conv_w[2] * pad[:, 2:] + conv_b
    gate, val = jnp.split(z, 2, axis=-1)
    return (jax.nn.silu(gate) * val) @ w_down


def setup_inputs(seed: int = 0) -> dict:
    key = jax.random.key(seed)
    ks = iter(jax.random.split(key, 40))
    nrm = lambda shape, s: jax.random.normal(next(ks), shape, jnp.float32) * s
    D, F, G, P, GC = D_MODEL, D_FF, N_GROUPS, SSM_STATE, GROUP_CH
    n_idx = jnp.arange(P, dtype=jnp.float32)
    return {
        'x_prompt': nrm((BATCH, SEQ, D), 1.0),
        'x_sample': nrm((DEC_BATCH, DEC_SEQ, D), 1.0),
        'cache_k': nrm((DEC_BATCH, N_ATTN, PAST_LEN, N_HEADS, HEAD_DIM), 1.0),
        'cache_v': nrm((DEC_BATCH, N_ATTN, PAST_LEN, N_HEADS, HEAD_DIM), 1.0),
        'state_re': nrm((DEC_BATCH, N_SSM, 2, G, P), 0.5),
        'state_im': nrm((DEC_BATCH, N_SSM, 2, G, P), 0.5),
        'c': nrm((DEC_BATCH, D), 1.0),
        'c_ctx': nrm((D,), 1.0),
        'ada_w': nrm((DEPTH, D, 6 * D), 0.5 * D ** -0.5),
        'ada_b': nrm((DEPTH, 6 * D), 0.02),
        'norm1_g': 1.0 + nrm((DEPTH, D), 0.02),
        'norm2_g': 1.0 + nrm((DEPTH, D), 0.02),
        'na_w_qkv': nrm((N_ATTN, D, 3 * D), D ** -0.5),
        'na_rpb': nrm((N_ATTN, N_HEADS, 2 * NA_KH - 1, 2 * NA_KW - 1), 0.1),
        'na_w_o': nrm((N_ATTN, D, D), D ** -0.5),
        's5_w_in': nrm((N_SSM, D, D), D ** -0.5),
        's5_a_re': -0.5 + nrm((N_SSM, 2, G, P), 0.01),
        's5_a_im': math.pi * n_idx + nrm((N_SSM, 2, G, P), 0.01),
        's5_log_dt': jax.random.uniform(next(ks), (N_SSM, 2, G), jnp.float32, math.log(1e-3), math.log(1e-1)),
        's5_b_re': nrm((N_SSM, 2, G, P, GC), (2 * GC) ** -0.5),
        's5_b_im': nrm((N_SSM, 2, G, P, GC), (2 * GC) ** -0.5),
        's5_c_re': nrm((N_SSM, 2, G, GC, P), (2 * P) ** -0.5),
        's5_c_im': nrm((N_SSM, 2, G, GC, P), (2 * P) ** -0.5),
        's5_d': nrm((N_SSM, D), 1.0),
        's5_w_gate': nrm((N_SSM, D, D), D ** -0.5),
        's5_w_out': nrm((N_SSM, D, D), D ** -0.5),
        'ffn_w_up': nrm((DEPTH, D, 2 * F), D ** -0.5),
        'ffn_conv_w': nrm((DEPTH, 3, 2 * F), 3 ** -0.5),
        'ffn_conv_b': nrm((DEPTH, 2 * F), 0.02),
        'ffn_w_down': nrm((DEPTH, F, D), F ** -0.5),
        'final_g': 1.0 + nrm((D,), 0.02),
    }


def reference(x_prompt, x_sample, cache_k, cache_v, state_re, state_im, c, c_ctx,
              ada_w, ada_b, norm1_g, norm2_g, na_w_qkv, na_rpb, na_w_o,
              s5_w_in, s5_a_re, s5_a_im, s5_log_dt, s5_b_re, s5_b_im, s5_c_re, s5_c_im, s5_d,
              s5_w_gate, s5_w_out, ffn_w_up, ffn_conv_w, ffn_conv_b, ffn_w_down, final_g):
    xp, xs = x_prompt, x_sample
    new_k, new_v, new_sre, new_sim = [], [], [], []
    for i in range(DEPTH):
        j = i // 2
        mp = ada_params(c_ctx[None, :], ada_w[i], ada_b[i])
        ms = ada_params(c, ada_w[i], ada_b[i])
        hp = rms_norm(xp, norm1_g[i]) * (1 + mp[1]) + mp[0]
        hs = rms_norm(xs, norm1_g[i]) * (1 + ms[1]) + ms[0]
        if i % 2 == 0:
            op, kc, vc = na_context(hp, na_w_qkv[j], na_w_o[j])
            os_ = na_latent(hs, cache_k[:, j], cache_v[:, j], na_w_qkv[j], na_rpb[j], na_w_o[j])
            new_k.append(kc)
            new_v.append(vc)
        else:
            ssm = (s5_w_in[j], s5_a_re[j], s5_a_im[j], s5_log_dt[j], s5_b_re[j], s5_b_im[j],
                   s5_c_re[j], s5_c_im[j], s5_d[j], s5_w_gate[j], s5_w_out[j])
            zero_state = jnp.zeros((xp.shape[0], 2, N_GROUPS, SSM_STATE), jnp.float32)
            op, s_re, s_im = s5_mixer(hp, zero_state, zero_state, *ssm)
            os_, _, _ = s5_mixer(hs, state_re[:, j], state_im[:, j], *ssm)
            new_sre.append(s_re)
            new_sim.append(s_im)
        xp = xp + mp[2] * op
        xs = xs + ms[2] * os_
        ffn = (ffn_w_up[i], ffn_conv_w[i], ffn_conv_b[i], ffn_w_down[i])
        hp = rms_norm(xp, norm2_g[i]) * (1 + mp[4]) + mp[3]
        hs = rms_norm(xs, norm2_g[i]) * (1 + ms[4]) + ms[3]
        xp = xp + mp[5] * conv_ffn(hp, *ffn)
        xs = xs + ms[5] * conv_ffn(hs, *ffn)
    return (rms_norm(xp, final_g), rms_norm(xs, final_g),
            jnp.stack(new_k, axis=1), jnp.stack(new_v, axis=1),
            jnp.stack(new_sre, axis=1), jnp.stack(new_sim, axis=1))
```

```cpp
#define DBG_CHECKS 0
#define N_LAUNCHES 1
#include <hip/hip_runtime.h>
#include <cstdio>
#include <cstdint>
namespace pg8 {
#define PG8_LAS __attribute__((address_space(3)))
typedef unsigned short bf16_t;
typedef short bf16x8 __attribute__((ext_vector_type(8)));
typedef float f32x4 __attribute__((ext_vector_type(4)));
typedef unsigned u32x4 __attribute__((ext_vector_type(4)));
constexpr int BM = 256, BK = 64, HALF = 128, HTB = HALF * BK * 2  , STAGE_BYTES = 8 * HTB, NXCD = 8, WGM = 8;

__host__ __device__ __forceinline__ int lds_byte(int r, int c) { const int st = (r >> 4) * 2 + (c >> 5), rr = r & 15, cc = c & 31, ob = rr * 64 + cc * 2; return st * 1024 + (ob ^ (((ob >> 9) & 1) << 5)); }
__host__ __device__ __forceinline__ void stage_rc(int b, int& R, int& C) { const int st = b / 1024, sb = b % 1024, swz = sb ^ (((sb >> 9) & 1) << 5); R = (st >> 1) * 16 + swz / 64; C = (st & 1) * 32 + (swz % 64) / 2; }
__host__ __device__ __forceinline__ int perm32(int rho) { const int n = rho >> 4, i = rho & 15; return 8 * (i >> 2) + 4 * n + (i & 3); }

struct Unit { int pm, pn; };
struct Gemm { const bf16_t* A; const bf16_t* Bt; int M, N, K; };

struct StaticOrder {
    int nM, nN, nwg, G, c;
    __host__ __device__ void init(int M, int N, int G_, int c_) { nM = M / BM; nN = N / BM; nwg = nM * nN; G = G_; c = c_; }
    __host__ __device__ bool next(int i, Unit& u) const {
        const long L = (long)i * G + c; if (L >= nwg) return false;
        int wgid = (int)L; { const int q = nwg / NXCD, r = nwg % NXCD, xcd = wgid % NXCD, off = wgid / NXCD; wgid = (xcd < r ? xcd * (q + 1) : r * (q + 1) + (xcd - r) * q) + off; }
        const int nig = WGM * nN, gid = wgid / nig, fm = gid * WGM, gsz = (nM - fm) < WGM ? (nM - fm) : WGM;
        u.pm = fm + ((wgid % nig) % gsz); u.pn = (wgid % nig) / gsz; return true;
    }
    __device__ __forceinline__ void a_ready(const Unit&) const {}
    __device__ __forceinline__ void done(const Unit&) const {}
};

__device__ __forceinline__ unsigned cvt_pk_bf16(float lo, float hi) { unsigned r; asm volatile("v_cvt_pk_bf16_f32 %0, %1, %2" : "=v"(r) : "v"(lo), "v"(hi)); return r; }
typedef float f32x2 __attribute__((ext_vector_type(2)));
__device__ __forceinline__ f32x2 gelu_pk(f32x2 v) {
    const f32x2 av = __builtin_elementwise_abs(v), d = av * 0.2316418882f + 1.0f;
    f32x2 t; t.x = __builtin_amdgcn_rcpf(d.x); t.y = __builtin_amdgcn_rcpf(d.y);
    f32x2 q = t * 0.5307027145f + (-0.7265760135f); q = q * t + 0.7107068705f; q = q * t + (-0.142248368f); q = q * t + 0.127414796f; q = q * t;
    const f32x2 s = (v * v) * (-0.72134752044f);
    f32x2 e; e.x = __builtin_amdgcn_exp2f(s.x); e.y = __builtin_amdgcn_exp2f(s.y);
    const f32x2 m = v * (q * e), r = v - m;
    f32x2 o; o.x = v.x < 0.f ? m.x : r.x; o.y = v.y < 0.f ? m.y : r.y; return o;
}

template <int ACT  > struct EpiBf16 {
    static constexpr bool PERM = true, AFTER_DRAIN = false; static_assert(ACT == 0 || ACT == 1, "EpiBf16: ACT is 0 (none) or 1 (gelu_pk)");
    bf16_t* O; int ldc; const float* bias; int split_cols; size_t split_stride; float scale0;
    __device__ __forceinline__ void operator()(const f32x4 (&acc)[2][2][4][2], const Unit& u, int wr, int wc, int fr, int fq) const {
        const int row0 = u.pm * BM + wr * 64 + fr; int colt = u.pn * BM; bf16_t* base = O;
        float sc = 1.f; if (split_cols) { const int t = colt / split_cols; base += (size_t)t * split_stride; colt -= t * split_cols; if (t == 0) sc = scale0; }
        const int col0 = colt + wc * 32 + 8 * fq, bcol0 = u.pn * BM + wc * 32 + 8 * fq;
        f32x4 bv[2][2];
#pragma unroll
        for (int bj = 0; bj < 2; ++bj)
#pragma unroll
            for (int n = 0; n < 2; ++n) bv[bj][n] = bias ? *(const f32x4*)(bias + bcol0 + bj * HALF + 4 * n) : (f32x4){0.f, 0.f, 0.f, 0.f};
#pragma unroll
        for (int ai = 0; ai < 2; ++ai)
#pragma unroll
            for (int m = 0; m < 4; ++m) { bf16_t* rowp = base + (size_t)(row0 + ai * HALF + m * 16) * ldc + col0;
#pragma unroll
                for (int bj = 0; bj < 2; ++bj) { f32x4 v0 = acc[ai][bj][m][0] + bv[bj][0], v1 = acc[ai][bj][m][1] + bv[bj][1];
                    if (ACT == 1) { f32x2 a = gelu_pk((f32x2){v0[0], v0[1]}), b = gelu_pk((f32x2){v0[2], v0[3]}), c = gelu_pk((f32x2){v1[0], v1[1]}), d = gelu_pk((f32x2){v1[2], v1[3]});
                        v0 = (f32x4){a.x, a.y, b.x, b.y}; v1 = (f32x4){c.x, c.y, d.x, d.y}; }
                    v0 = v0 * sc; v1 = v1 * sc; u32x4 w; w.x = cvt_pk_bf16(v0[0], v0[1]); w.y = cvt_pk_bf16(v0[2], v0[3]); w.z = cvt_pk_bf16(v1[0], v1[1]); w.w = cvt_pk_bf16(v1[2], v1[3]);
                    *(u32x4*)(rowp + bj * HALF) = w; } }
    }
};

__host__ __device__ __forceinline__ int perm16(int ko) { return 8 * ((ko >> 2) & 1) + (ko & 3) + 4 * (ko >> 3); }

struct EpiQKV {
    static constexpr bool PERM = true, AFTER_DRAIN = false;
    bf16_t* Q; bf16_t* K; bf16_t* VTp; bf16_t* VTs; float* nk; float* nv; float c2;
    __device__ __forceinline__ void operator()(const f32x4 (&acc)[2][2][4][2], const Unit& u, int wr, int wc, int fr, int fq) const {
        const int sec = u.pn >> 3, colt = (u.pn & 7) * BM;
        const int row0 = u.pm * BM + wr * 64 + fr, col0 = colt + wc * 32 + 8 * fq;
        const bool prompt = u.pm < 32;
#pragma unroll
        for (int ai = 0; ai < 2; ++ai)
#pragma unroll
            for (int m = 0; m < 4; ++m) {
                const int row = row0 + ai * HALF + m * 16;
#pragma unroll
                for (int bj = 0; bj < 2; ++bj) {
                    f32x4 v0 = acc[ai][bj][m][0], v1 = acc[ai][bj][m][1];
                    const int col = col0 + bj * HALF;
                    const size_t off = (size_t)row * 2048 + col;
                    if (sec == 0) {
                        v0 = v0 * c2; v1 = v1 * c2;
                        u32x4 w; w.x = cvt_pk_bf16(v0[0], v0[1]); w.y = cvt_pk_bf16(v0[2], v0[3]); w.z = cvt_pk_bf16(v1[0], v1[1]); w.w = cvt_pk_bf16(v1[2], v1[3]);
                        *(u32x4*)(Q + off) = w;
                    } else if (sec == 1) {
                        u32x4 w; w.x = cvt_pk_bf16(v0[0], v0[1]); w.y = cvt_pk_bf16(v0[2], v0[3]); w.z = cvt_pk_bf16(v1[0], v1[1]); w.w = cvt_pk_bf16(v1[2], v1[3]);
                        *(u32x4*)(K + off) = w;
                        if (prompt) { *(f32x4*)(nk + off) = v0; *(f32x4*)(nk + off + 4) = v1; }
                    } else {
                        if (prompt) { *(f32x4*)(nv + off) = v0; *(f32x4*)(nv + off + 4) = v1; }
                        const unsigned w0 = cvt_pk_bf16(v0[0], v0[1]), w1 = cvt_pk_bf16(v0[2], v0[3]), w2 = cvt_pk_bf16(v1[0], v1[1]), w3 = cvt_pk_bf16(v1[2], v1[3]);
                        const int h = col >> 7, d0 = col & 127;
                        const int rs = prompt ? row : row - 8192, sh = prompt ? 8 : 10, b = rs >> sh, t = rs & ((1 << sh) - 1);
                        const size_t st = (size_t)1 << sh;
                        bf16_t* p = VTp + (prompt ? (size_t)0 : (size_t)16777216) + (((size_t)((b * 16 + h) * 128 + d0)) << sh) + (t & ~15) + perm16(t & 15);
                        p[0] = (bf16_t)(w0 & 0xffffu); p[st] = (bf16_t)(w0 >> 16); p[2 * st] = (bf16_t)(w1 & 0xffffu); p[3 * st] = (bf16_t)(w1 >> 16);
                        p[4 * st] = (bf16_t)(w2 & 0xffffu); p[5 * st] = (bf16_t)(w2 >> 16); p[6 * st] = (bf16_t)(w3 & 0xffffu); p[7 * st] = (bf16_t)(w3 >> 16);
                    }
                }
            }
    }
};

struct EpiRes {
    static constexpr bool PERM = false, AFTER_DRAIN = false;
    const float* baseP; const float* baseS; float* out; const float* gate;
    __device__ __forceinline__ void operator()(const f32x4 (&acc)[2][2][4][2], const Unit& u, int wr, int wc, int fr, int fq) const {
        const int cond = u.pm < 32 ? 0 : 1 + ((u.pm - 32) >> 2);
        const float* g = gate + cond * 12288; const float* base = u.pm < 32 ? baseP : baseS;
        const int row0 = u.pm * BM + wr * 64 + fr, col0 = u.pn * BM + wc * 32 + 4 * fq;
        f32x4 gv[2][2];
#pragma unroll
        for (int bj = 0; bj < 2; ++bj)
#pragma unroll
            for (int n = 0; n < 2; ++n) gv[bj][n] = *(const f32x4*)(g + col0 + bj * HALF + n * 16);
#pragma unroll
        for (int ai = 0; ai < 2; ++ai)
#pragma unroll
            for (int m = 0; m < 4; ++m) { const size_t off = (size_t)(row0 + ai * HALF + m * 16) * 2048 + col0;
#pragma unroll
                for (int bj = 0; bj < 2; ++bj)
#pragma unroll
                    for (int n = 0; n < 2; ++n) { const f32x4 bs = *(const f32x4*)(base + off + bj * HALF + n * 16); *(f32x4*)(out + off + bj * HALF + n * 16) = bs + gv[bj][n] * acc[ai][bj][m][n]; }
                if (m & 1) asm volatile("" ::: "memory"); }
    }
};

struct EpiGate {
    static constexpr bool PERM = true, AFTER_DRAIN = false;
    const bf16_t* Y; bf16_t* Y2;
    __device__ __forceinline__ void operator()(const f32x4 (&acc)[2][2][4][2], const Unit& u, int wr, int wc, int fr, int fq) const {
        const int row0 = u.pm * BM + wr * 64 + fr, col0 = u.pn * BM + wc * 32 + 8 * fq;
#pragma unroll
        for (int ai = 0; ai < 2; ++ai)
#pragma unroll
            for (int m = 0; m < 4; ++m) {
#pragma unroll
                for (int bj = 0; bj < 2; ++bj) {
                    const size_t off = (size_t)(row0 + ai * HALF + m * 16) * 2048 + col0 + bj * HALF;
                    const u32x4 yv = *(const u32x4*)(Y + off);
                    const f32x4 z0 = acc[ai][bj][m][0], z1 = acc[ai][bj][m][1];
                    float y[8], o[8];
                    y[0] = __uint_as_float(yv.x << 16); y[1] = __uint_as_float(yv.x & 0xffff0000u); y[2] = __uint_as_float(yv.y << 16); y[3] = __uint_as_float(yv.y & 0xffff0000u);
                    y[4] = __uint_as_float(yv.z << 16); y[5] = __uint_as_float(yv.z & 0xffff0000u); y[6] = __uint_as_float(yv.w << 16); y[7] = __uint_as_float(yv.w & 0xffff0000u);
#pragma unroll
                    for (int e = 0; e < 4; ++e) { o[e] = y[e] * __builtin_amdgcn_rcpf(1.0f + __builtin_amdgcn_exp2f(-1.4426950408889634f * z0[e])); o[4 + e] = y[4 + e] * __builtin_amdgcn_rcpf(1.0f + __builtin_amdgcn_exp2f(-1.4426950408889634f * z1[e])); }
                    u32x4 w; w.x = cvt_pk_bf16(o[0], o[1]); w.y = cvt_pk_bf16(o[2], o[3]); w.z = cvt_pk_bf16(o[4], o[5]); w.w = cvt_pk_bf16(o[6], o[7]);
                    *(u32x4*)(Y2 + off) = w;
                }
            }
    }
};

template <class Epi, class Sched, bool ALIGN_EPI = false, bool SP2 = false>
__device__ __forceinline__ void gemm_phase(PG8_LAS unsigned char* lds, const Gemm g, const Sched& S, const Epi& E) {
    const int tid = threadIdx.x, wid = __builtin_amdgcn_readfirstlane(tid >> 6), lane = tid & 63, wr = wid >> 2, wc = wid & 3, fr = lane & 15, fq = lane >> 4;
    const int K = g.K, nt = K / BK;
    unsigned voffA[2], voffB[2];
#pragma unroll
    for (int i = 0; i < 2; ++i) { int R, C; stage_rc(tid * 16 + i * 8192, R, C); const int Rb = Epi::PERM ? ((R & ~31) + perm32(R & 31)) : R;
        voffA[i] = (unsigned)(R * K + C) * 2u; voffB[i] = (unsigned)(Rb * K + C) * 2u; }
    const size_t kstep = (size_t)(BK * 2);
    const size_t hstep = (size_t)HALF * K * 2;
    const size_t tstep = 2 * hstep;
    const unsigned ldsw = (unsigned)wid * 1024u;
    const int aoff = lds_byte(wr * 64 + fr, fq * 8), boff = lds_byte(wc * 32 + fr, fq * 8);
#define PG8_SA(b, h) (((b) * 2 + (h)) * HTB)
#define PG8_SB(b, h) ((4 + (b) * 2 + (h)) * HTB)
#define PG8_STAGE(bufoff, gbase, voff) do { _Pragma("unroll") for (int _i = 0; _i < 2; ++_i) \
        __builtin_amdgcn_global_load_lds((const unsigned*)((const char*)(gbase) + (voff)[_i]), (PG8_LAS unsigned*)(lds + (bufoff) + ldsw + _i * 8192), 16, 0, 0); } while (0)
#define PG8_LDA(dst, b, h) do { _Pragma("unroll") for (int m = 0; m < 4; ++m) _Pragma("unroll") for (int k = 0; k < 2; ++k) dst[m][k] = *(const PG8_LAS bf16x8*)(lds + PG8_SA(b, h) + aoff + m * 2048 + k * 1024); } while (0)
#define PG8_LDB(dst, b, h) do { _Pragma("unroll") for (int n = 0; n < 2; ++n) _Pragma("unroll") for (int k = 0; k < 2; ++k) dst[n][k] = *(const PG8_LAS bf16x8*)(lds + PG8_SB(b, h) + boff + n * 2048 + k * 1024); } while (0)
#define PG8_MMA(ai, bj, At, Bt) do { __builtin_amdgcn_s_setprio(1); _Pragma("unroll") for (int m = 0; m < 4; ++m) _Pragma("unroll") for (int n = 0; n < 2; ++n) _Pragma("unroll") for (int k = 0; k < 2; ++k) \
        acc[ai][bj][m][n] = __builtin_amdgcn_mfma_f32_16x16x32_bf16(Bt[n][k], At[m][k], acc[ai][bj][m][n], 0, 0, 0); __builtin_amdgcn_s_setprio(0); } while (0)
#define PG8_WAIT_V(n) asm volatile("s_waitcnt vmcnt(" #n ")" ::: "memory")
#define PG8_WAIT_L(n) asm volatile("s_waitcnt lgkmcnt(" #n ")" ::: "memory")
#define PG8_BAR __builtin_amdgcn_s_barrier()
#define PG8_SCHED __builtin_amdgcn_sched_barrier(0)
    Unit cur, nxt; int ui = 0;
    if (!S.next(0, cur)) return;
    f32x4 acc[2][2][4][2];
#pragma unroll
    for (int a = 0; a < 2; ++a)
#pragma unroll
        for (int b = 0; b < 2; ++b)
#pragma unroll
            for (int m = 0; m < 4; ++m)
#pragma unroll
                for (int n = 0; n < 2; ++n) acc[a][b][m][n] = (f32x4){0.f, 0.f, 0.f, 0.f};
    bf16x8 At[4][2], B0[2][2], B1[2][2];
    const char* cA = (const char*)g.A + (size_t)cur.pm * tstep; const char* cB = (const char*)g.Bt + (size_t)cur.pn * tstep;
    S.a_ready(cur);
    if constexpr (SP2) {
        PG8_STAGE(PG8_SB(0, 0), cB, voffB); PG8_STAGE(PG8_SB(0, 1), cB + hstep, voffB); PG8_STAGE(PG8_SA(0, 0), cA, voffA); PG8_STAGE(PG8_SA(0, 1), cA + hstep, voffA);
        if (wr == 1) PG8_BAR;
        PG8_WAIT_V(2); PG8_BAR;
        PG8_STAGE(PG8_SB(1, 0), cB + kstep, voffB); PG8_STAGE(PG8_SA(1, 0), cA + kstep, voffA); PG8_STAGE(PG8_SB(1, 1), cB + hstep + kstep, voffB);
        PG8_WAIT_V(6); PG8_BAR;
    } else {
        PG8_STAGE(PG8_SB(0, 0), cB, voffB); PG8_STAGE(PG8_SA(0, 0), cA, voffA); PG8_STAGE(PG8_SB(0, 1), cB + hstep, voffB); PG8_STAGE(PG8_SA(0, 1), cA + hstep, voffA);
        if (wr == 1) PG8_BAR;
        PG8_WAIT_V(4); PG8_BAR;
        PG8_STAGE(PG8_SB(1, 0), cB + kstep, voffB); PG8_STAGE(PG8_SA(1, 0), cA + kstep, voffA); PG8_STAGE(PG8_SB(1, 1), cB + hstep + kstep, voffB);
        PG8_WAIT_V(6); PG8_BAR;
    }
    for (;;) {
        const bool has_next = S.next(ui + 1, nxt);
        const char* nA = has_next ? (const char*)g.A + (size_t)nxt.pm * tstep : cA; const char* nB = has_next ? (const char*)g.Bt + (size_t)nxt.pn * tstep : cB;
        for (int t = 0; t < nt; t += 2) {
            const bool last = (t == nt - 2);
            const char* a1 = cA + (size_t)(t + 1) * kstep;
            const char* a2 = last ? nA : cA + (size_t)(t + 2) * kstep; const char* b2 = last ? nB : cB + (size_t)(t + 2) * kstep;
            const char* a3 = a2 + kstep; const char* b3 = b2 + kstep;
            if (last && has_next) S.a_ready(nxt);
            if constexpr (SP2) {
            PG8_LDB(B0, 0, 0); PG8_LDB(B1, 0, 1); PG8_SCHED; PG8_LDA(At, 0, 0); PG8_STAGE(PG8_SA(1, 1), a1 + hstep, voffA);
            PG8_WAIT_V(8); PG8_WAIT_L(0); PG8_BAR; PG8_MMA(0, 0, At, B0); PG8_MMA(0, 1, At, B1); PG8_BAR; PG8_SCHED;
            PG8_LDA(At, 0, 1); PG8_STAGE(PG8_SB(0, 0), b2, voffB); PG8_STAGE(PG8_SB(0, 1), b2 + hstep, voffB); PG8_STAGE(PG8_SA(0, 0), a2, voffA);
            PG8_WAIT_V(8); PG8_WAIT_L(0); PG8_BAR; PG8_MMA(1, 0, At, B0); PG8_MMA(1, 1, At, B1); PG8_BAR; PG8_SCHED;
            PG8_LDB(B0, 1, 0); PG8_LDB(B1, 1, 1); PG8_SCHED; PG8_LDA(At, 1, 0); PG8_STAGE(PG8_SA(0, 1), a2 + hstep, voffA);
            PG8_WAIT_V(8); PG8_WAIT_L(0); PG8_BAR; PG8_MMA(0, 0, At, B0); PG8_MMA(0, 1, At, B1); PG8_BAR; PG8_SCHED;
            PG8_LDA(At, 1, 1); PG8_STAGE(PG8_SB(1, 0), b3, voffB); PG8_STAGE(PG8_SB(1, 1), b3 + hstep, voffB); PG8_STAGE(PG8_SA(1, 0), a3, voffA);
            PG8_WAIT_V(8); PG8_WAIT_L(0); PG8_BAR; PG8_MMA(1, 0, At, B0); PG8_MMA(1, 1, At, B1); PG8_BAR; PG8_SCHED;
            } else {
            PG8_LDB(B0, 0, 0); PG8_SCHED; PG8_LDA(At, 0, 0); PG8_STAGE(PG8_SA(1, 1), a1 + hstep, voffA);
            PG8_WAIT_L(8); PG8_BAR; PG8_WAIT_L(0); PG8_MMA(0, 0, At, B0); PG8_BAR; PG8_SCHED;
            PG8_LDB(B1, 0, 1); PG8_STAGE(PG8_SB(0, 0), b2, voffB);
            PG8_BAR; PG8_WAIT_L(0); PG8_MMA(0, 1, At, B1); PG8_BAR;
            PG8_LDA(At, 0, 1); PG8_STAGE(PG8_SA(0, 0), a2, voffA);
            PG8_BAR; PG8_WAIT_L(0); PG8_MMA(1, 0, At, B0); PG8_BAR; PG8_SCHED;
            PG8_STAGE(PG8_SB(0, 1), b2 + hstep, voffB);
            PG8_WAIT_V(6); PG8_BAR; PG8_MMA(1, 1, At, B1); PG8_BAR;
            PG8_LDB(B0, 1, 0); PG8_SCHED; PG8_LDA(At, 1, 0); PG8_STAGE(PG8_SA(0, 1), a2 + hstep, voffA);
            PG8_WAIT_L(8); PG8_BAR; PG8_WAIT_L(0); PG8_MMA(0, 0, At, B0); PG8_BAR; PG8_SCHED;
            PG8_LDB(B1, 1, 1); PG8_STAGE(PG8_SB(1, 0), b3, voffB);
            PG8_BAR; PG8_WAIT_L(0); PG8_MMA(0, 1, At, B1); PG8_BAR;
            PG8_LDA(At, 1, 1); PG8_STAGE(PG8_SA(1, 0), a3, voffA);
            PG8_BAR; PG8_WAIT_L(0); PG8_MMA(1, 0, At, B0); PG8_BAR; PG8_SCHED;
            PG8_STAGE(PG8_SB(1, 1), b3 + hstep, voffB);
            PG8_WAIT_V(6); PG8_BAR; PG8_MMA(1, 1, At, B1); PG8_BAR;
            }
        }
        if constexpr (ALIGN_EPI) { if (wr == 0) PG8_BAR; }
        if constexpr (!Epi::AFTER_DRAIN) { E(acc, cur, wr, wc, fr, fq); S.done(cur); }
        if (!has_next) break;
#pragma unroll
        for (int a = 0; a < 2; ++a)
#pragma unroll
            for (int b = 0; b < 2; ++b)
#pragma unroll
                for (int m = 0; m < 4; ++m)
#pragma unroll
                    for (int n = 0; n < 2; ++n) acc[a][b][m][n] = (f32x4){0.f, 0.f, 0.f, 0.f};
        cur = nxt; cA = nA; cB = nB; ++ui;
        if constexpr (ALIGN_EPI) { if (wr == 1) PG8_BAR; }
    }
    PG8_WAIT_V(0);
    if constexpr (!ALIGN_EPI) { if (wr == 0) PG8_BAR; }
    PG8_BAR;
    if constexpr (Epi::AFTER_DRAIN) { E.fused(acc, cur, wr, wc, fr, fq, lds, wid, lane); S.done(cur); }
#undef PG8_SA
#undef PG8_SB
#undef PG8_STAGE
#undef PG8_LDA
#undef PG8_LDB
#undef PG8_MMA
#undef PG8_WAIT_V
#undef PG8_WAIT_L
#undef PG8_BAR
#undef PG8_SCHED
}
}
#define GAS __attribute__((address_space(1)))
#define LAS __attribute__((address_space(3)))
typedef unsigned short bf16;
typedef unsigned v4u __attribute__((ext_vector_type(4)));
typedef float f32x4 __attribute__((ext_vector_type(4)));
typedef short bf16x8 __attribute__((ext_vector_type(8)));
typedef GAS unsigned gu32;
typedef GAS unsigned long long gu64;
#define RLX_AGENT __ATOMIC_RELAXED, __HIP_MEMORY_SCOPE_AGENT
#define LDS_WAIT() asm volatile("s_waitcnt lgkmcnt(0)" ::: "memory")
#define VM_WAIT() asm volatile("s_waitcnt vmcnt(0)" ::: "memory")
__device__ __forceinline__ unsigned long long rt() { return __builtin_amdgcn_s_memrealtime(); }
__device__ __forceinline__ unsigned f2bf(float f) { unsigned u = __builtin_bit_cast(unsigned, f); return (u + 0x7fffu + ((u >> 16) & 1u)) >> 16; }
__device__ __forceinline__ unsigned pk2(float lo, float hi) { return f2bf(lo) | (f2bf(hi) << 16); }

#define XB_TMO      128
#define XB_XCNT(j)  (256  + 64 * (j))
#define XB_XSUB(j)  (1280 + 64 * (j))
#define XB_XGEN(j)  (2304 + 64 * (j))
#define XB_TOP      3328
#define XB_TOPGEN   3392
#define XCD_BAR_WORDS 3456
#define XB_SPIN_CAP (1u << 18)

__device__ __forceinline__ unsigned xb_ld(unsigned* p)              { return __hip_atomic_load(p, __ATOMIC_RELAXED, __HIP_MEMORY_SCOPE_AGENT); }
__device__ __forceinline__ unsigned xb_add(unsigned* p, unsigned v) { return __hip_atomic_fetch_add(p, v, __ATOMIC_RELAXED, __HIP_MEMORY_SCOPE_AGENT); }
__device__ __forceinline__ unsigned xb_xcc_id() { return (unsigned)__builtin_amdgcn_s_getreg((3 << 11) | 20) & 0xFu; }
#define XB_SPIN(cond, bar) do { unsigned _sp = 0; while (cond) { __builtin_amdgcn_s_sleep(1); \
    if ((++_sp & 255u) == 0u) { if (xb_ld(&(bar)[XB_TMO])) break; if (_sp > XB_SPIN_CAP) { atomicAdd(&(bar)[XB_TMO], 1u); break; } } } } while (0)

struct XcdBarrier {
    unsigned* bar; unsigned x;
    volatile LAS unsigned* st;
};

__device__ __forceinline__ XcdBarrier xcd_barrier_post(unsigned* bar, volatile LAS unsigned* st) {
    XcdBarrier b; b.bar = bar; b.x = xb_xcc_id(); b.st = st;
    if (threadIdx.x == 0) (void)xb_add(&bar[XB_XCNT(b.x)], 1u);
    return b;
}
__device__ __forceinline__ void xcd_barrier_complete(unsigned* bar, unsigned x, unsigned& nloc, unsigned& nx) {
    const unsigned G = gridDim.x * gridDim.y * gridDim.z;
    unsigned sum, cnt, mine, sp = 0u;
    for (;;) {
        sum = 0u; cnt = 0u; mine = 0u;
#pragma unroll
        for (unsigned j = 0; j < 16; ++j) { const unsigned c = xb_ld(&bar[XB_XCNT(j)]); sum += c; cnt += (c > 0u) ? 1u : 0u; mine = (j == x) ? c : mine; }
        if (sum == G) break;
        __builtin_amdgcn_s_sleep(1);
        if ((++sp & 255u) == 0u) { if (xb_ld(&bar[XB_TMO])) break; if (sp > XB_SPIN_CAP) { atomicAdd(&bar[XB_TMO], 1u); break; } }
    }
    nloc = mine > 0u ? mine : 1u; nx = cnt > 0u ? cnt : 1u;
}

__device__ __forceinline__ void xcd_barrier(const XcdBarrier& b) {
    asm volatile("s_waitcnt vmcnt(0)" ::: "memory");
    __syncthreads();
    if (threadIdx.x == 0) {
        unsigned* bar = b.bar;
        __builtin_amdgcn_s_waitcnt(0);
        unsigned nloc = b.st[0], nx = b.st[1];
        if (nloc == 0u) { xcd_barrier_complete(bar, b.x, nloc, nx); b.st[0] = nloc; b.st[1] = nx; }
        const unsigned old = xb_add(&bar[XB_XSUB(b.x)], 1u);
        const unsigned gen = old / nloc;
        if (old + 1u == (gen + 1u) * nloc) {
            __builtin_amdgcn_fence(__ATOMIC_RELEASE, "agent");
            asm volatile("s_waitcnt vmcnt(0)" ::: "memory");
            const unsigned og = xb_add(&bar[XB_TOP], 1u);
            const unsigned tg = og / nx;
            if (og + 1u == (tg + 1u) * nx) xb_add(&bar[XB_TOPGEN], 1u);
            else XB_SPIN(xb_ld(&bar[XB_TOPGEN]) == tg, bar);
            __builtin_amdgcn_fence(__ATOMIC_ACQUIRE, "agent");
            xb_add(&bar[XB_XGEN(b.x)], 1u);
            asm volatile("s_waitcnt vmcnt(0)" ::: "memory");
        } else {
            XB_SPIN(xb_ld(&bar[XB_XGEN(b.x)]) == gen, bar);
            __builtin_amdgcn_fence(__ATOMIC_ACQUIRE, "agent");
            asm volatile("s_waitcnt vmcnt(0)" ::: "memory");
        }
    }
    __syncthreads();
}
constexpr int D = 2048, NH = 16, HD = 128, FF = 5504, F2 = 11008, MP = 8192, MS = 2048, M = 10240;
constexpr int SEQ = 256, DSEQ = 1024, PAST = 512, NG = 128, GC = 16, SP = 64;
constexpr float NORM_EPS = 1e-6f;
constexpr float LOG2E = 1.4426950408889634f;
constexpr float C2 = 0.08838834764831845f * 1.4426950408889634f;
constexpr int NWAVES = 8, NTHR = 512;
enum { I_XP = 0, I_XS, I_CK, I_CV, I_SRE, I_SIM, I_C, I_CCTX, I_ADAW, I_ADAB, I_N1G, I_N2G, I_WQKV, I_RPB, I_WO, I_WIN, I_ARE, I_AIM, I_LOGDT, I_BRE, I_BIM, I_CRE, I_CIM, I_SD, I_WGATE, I_WOUT, I_WUP, I_CONVW, I_CONVB, I_WDN, I_FG, N_IN };

struct Args;
typedef const __attribute__((address_space(4))) unsigned char* kseg_t;
__device__ __forceinline__ const float* ARG_IN(int i) { kseg_t k = (kseg_t)__builtin_amdgcn_kernarg_segment_ptr(); return *(const float* const volatile __attribute__((address_space(4)))*)(k + 8 * i); }
__device__ __forceinline__ float* ARG_OUT() { kseg_t k = (kseg_t)__builtin_amdgcn_kernarg_segment_ptr(); return *(float* const volatile __attribute__((address_space(4)))*)(k + 8 * N_IN); }
__device__ __forceinline__ int ARG_I32(int i) { kseg_t k = (kseg_t)__builtin_amdgcn_kernarg_segment_ptr(); return *(const volatile __attribute__((address_space(4))) int*)(k + 8 * N_IN + 16 + 4 * i); }
__device__ __forceinline__ unsigned char* ARG_WS() { kseg_t k = (kseg_t)__builtin_amdgcn_kernarg_segment_ptr(); return *(unsigned char* const volatile __attribute__((address_space(4)))*)(k + 8 * N_IN + 8); }
constexpr size_t O_Y = 0, O_NK = (size_t)M * D, O_NV = O_NK + (size_t)MP * D, O_SRE = O_NV + (size_t)MP * D, O_SIM = O_SRE + 32 * 2 * 128 * 64, O_END = O_SIM + 32 * 2 * 128 * 64;

constexpr size_t MiB = 1u << 20, KiB = 1u << 10;
constexpr size_t WS_CTL = 0, CTL_ZERO_BYTES = 1 * MiB;
constexpr size_t WS_MOD = 256 * KiB;
constexpr size_t WS_DBG = 768 * KiB;
constexpr size_t WS_WQKV = 1 * MiB, WS_WO = 25 * MiB, WS_WIN = 33 * MiB, WS_WGATE = 41 * MiB, WS_WOUT = 49 * MiB;
constexpr size_t WS_WUP0 = 57 * MiB, WS_WUP1 = 100 * MiB, WS_WDN0 = 143 * MiB, WS_WDN1 = 143 * MiB + 22016 * KiB;
constexpr size_t WS_X1 = 186 * MiB, WS_HB = 266 * MiB, WS_S = 306 * MiB;
constexpr size_t WS_Q = WS_S, WS_K = WS_S + 40 * MiB, WS_VTP = WS_S + 80 * MiB, WS_VTS = WS_S + 112 * MiB, WS_KC = WS_S + 120 * MiB, WS_VTC = WS_S + 124 * MiB, WS_O = WS_S + 128 * MiB;
constexpr size_t WS_UP = WS_S, WS_ACT = WS_S + 215 * MiB;
constexpr size_t WS_U = WS_S, WS_Y = WS_S + 40 * MiB, WS_Y2 = WS_S + 80 * MiB, WS_S5W = WS_S + 120 * MiB;
constexpr size_t WS_END = WS_S + 323 * MiB;
static_assert(WS_WDN1 + (size_t)D * FF * 2 <= WS_X1 && WS_WUP0 + (size_t)F2 * D * 2 <= WS_WUP1 && WS_WUP1 + (size_t)F2 * D * 2 <= WS_WDN0 && WS_WDN0 + (size_t)D * FF * 2 <= WS_WDN1, "weight map");
static_assert(WS_UP + (size_t)M * F2 * 2 <= WS_ACT && WS_ACT + (size_t)M * FF * 2 <= WS_END && WS_O + (size_t)M * D * 2 <= WS_END && WS_S5W + (size_t)NG * 3 * 131072 <= WS_END, "scratch map");
constexpr int CW_BAR = 4096;

constexpr int RING_BYTES = 131072, LDSCTL_OFF = RING_BYTES, MISC_OFF = LDSCTL_OFF + 320, LDS_BYTES = 147456;

typedef float f32x16 __attribute__((ext_vector_type(16)));
typedef unsigned u32x2 __attribute__((ext_vector_type(2)));
__device__ __forceinline__ unsigned cvtpk(float lo, float hi) { unsigned r; asm volatile("v_cvt_pk_bf16_f32 %0, %1, %2" : "=v"(r) : "v"(lo), "v"(hi)); return r; }
__device__ __forceinline__ float bf_lo(unsigned w) { return __uint_as_float(w << 16); }
__device__ __forceinline__ float bf_hi(unsigned w) { return __uint_as_float(w & 0xffff0000u); }
__device__ __forceinline__ float wave_sum(float v) {
#pragma unroll
    for (int o = 1; o < 64; o <<= 1) v += __shfl_xor(v, o);
    return v;
}
__device__ __forceinline__ float silu_f(float x) { return x / (1.0f + __expf(-x)); }
__device__ __forceinline__ float gelu_tanh(float x) {
    const float z = 0.7978845608028654f * (x + 0.044715f * x * x * x);
    return x * __builtin_amdgcn_rcpf(1.0f + __builtin_amdgcn_exp2f(-2.0f * LOG2E * z));
}

__device__ __forceinline__ void p0_ada(LAS unsigned char* lds, const float* adaw, const float* adab, const float* cctx, const float* cs, float* mod, int tid, int wave, int lane) {
    LAS float* red = (LAS float*)lds;
    for (int it = blockIdx.x; it < 1536; it += gridDim.x) {
        const int l = it / 768, r = it % 768, cb = r >> 4, ks = r & 15;
        const float* W = adaw + (size_t)l * 2048 * 12288 + cb * 256 + lane * 4;
        const int k0 = ks * 128 + wave * 16;
        f32x4 a0 = {0.f, 0.f, 0.f, 0.f}, a1 = a0, a2 = a0;
#pragma unroll 8
        for (int i = 0; i < 16; ++i) {
            const int k = k0 + i;
            const f32x4 w = *(const f32x4*)(W + (size_t)k * 12288);
            const float s0 = silu_f(cctx[k]), s1 = silu_f(cs[k]), s2 = silu_f(cs[2048 + k]);
            a0 += w * s0; a1 += w * s1; a2 += w * s2;
        }
        *(LAS f32x4*)(red + (wave * 3 + 0) * 256 + lane * 4) = a0;
        *(LAS f32x4*)(red + (wave * 3 + 1) * 256 + lane * 4) = a1;
        *(LAS f32x4*)(red + (wave * 3 + 2) * 256 + lane * 4) = a2;
        __syncthreads();
        for (int idx = tid; idx < 768; idx += NTHR) {
            const int cond = idx >> 8, col = idx & 255;
            float s = 0.f;
#pragma unroll
            for (int w = 0; w < 8; ++w) s += red[(w * 3 + cond) * 256 + col];
            if (ks == 0) s += adab[l * 12288 + cb * 256 + col];
            atomicAdd(mod + (size_t)(l * 3 + cond) * 12288 + cb * 256 + col, s);
        }
        __syncthreads();
    }
}
__device__ __forceinline__ void p0_transpose_item(const float* W, int K, int N, bf16* WT, LAS float* scr, int item, int lane) {
    const int nblk = N / 32, kb = item / nblk, nb = item % nblk, k0 = 64 * kb, n0 = 32 * nb;
#pragma unroll 8
    for (int i = 0; i < 32; ++i) { const int kk = 2 * i + (lane >> 5); scr[kk * 33 + (lane & 31)] = W[(size_t)(k0 + kk) * N + n0 + (lane & 31)]; }
    LDS_WAIT(); asm volatile("" ::: "memory");
    const int c = lane & 7;
#pragma unroll
    for (int j = 0; j < 4; ++j) { const int n = (lane >> 3) + 8 * j; const LAS float* s = scr + (8 * c) * 33 + n;
        v4u o; o.x = pk2(s[0 * 33], s[1 * 33]); o.y = pk2(s[2 * 33], s[3 * 33]); o.z = pk2(s[4 * 33], s[5 * 33]); o.w = pk2(s[6 * 33], s[7 * 33]);
        *(GAS v4u*)(WT + (size_t)(n0 + n) * K + k0 + 8 * c) = o; }
    LDS_WAIT(); asm volatile("" ::: "memory");
}
__device__ __forceinline__ void p0_weights(LAS unsigned char* lds, unsigned char* ws, int gw, int NGW, int wave, int lane) {
    LAS float* scr = (LAS float*)(lds + wave * 16384);
    constexpr int I_QKV = 32 * 192, I_SQ = 32 * 64, I_UP = 32 * 344, I_DN = 86 * 64;
    constexpr int NITEMS = I_QKV + 4 * I_SQ + 2 * I_UP + 2 * I_DN;
    for (int it = gw; it < NITEMS; it += NGW) {
        int r = it;
        if (r < I_QKV) { p0_transpose_item(ARG_IN(I_WQKV), D, 3 * D, (bf16*)(ws + WS_WQKV), scr, r, lane); continue; } r -= I_QKV;
        if (r < I_SQ) { p0_transpose_item(ARG_IN(I_WO), D, D, (bf16*)(ws + WS_WO), scr, r, lane); continue; } r -= I_SQ;
        if (r < I_SQ) { p0_transpose_item(ARG_IN(I_WIN), D, D, (bf16*)(ws + WS_WIN), scr, r, lane); continue; } r -= I_SQ;
        if (r < I_SQ) { p0_transpose_item(ARG_IN(I_WGATE), D, D, (bf16*)(ws + WS_WGATE), scr, r, lane); continue; } r -= I_SQ;
        if (r < I_SQ) { p0_transpose_item(ARG_IN(I_WOUT), D, D, (bf16*)(ws + WS_WOUT), scr, r, lane); continue; } r -= I_SQ;
        if (r < I_UP) { p0_transpose_item(ARG_IN(I_WUP), D, F2, (bf16*)(ws + WS_WUP0), scr, r, lane); continue; } r -= I_UP;
        if (r < I_UP) { p0_transpose_item(ARG_IN(I_WUP) + (size_t)D * F2, D, F2, (bf16*)(ws + WS_WUP1), scr, r, lane); continue; } r -= I_UP;
        if (r < I_DN) { p0_transpose_item(ARG_IN(I_WDN), FF, D, (bf16*)(ws + WS_WDN0), scr, r, lane); continue; } r -= I_DN;
        p0_transpose_item(ARG_IN(I_WDN) + (size_t)FF * D, FF, D, (bf16*)(ws + WS_WDN1), scr, r, lane);
    }
}
__device__ __forceinline__ void p0_cache(const float* ck, const float* cv, bf16* KC, bf16* VTC, int gtid, int NGT) {
    for (int i = gtid; i < 2 * 512 * 256; i += NGT) {
        const size_t e = (size_t)i * 8;
        const f32x4 a = *(const f32x4*)(ck + e), b = *(const f32x4*)(ck + e + 4);
        v4u o; o.x = pk2(a.x, a.y); o.y = pk2(a.z, a.w); o.z = pk2(b.x, b.y); o.w = pk2(b.z, b.w);
        *(v4u*)(KC + e) = o;
        const f32x4 c = *(const f32x4*)(cv + e), d = *(const f32x4*)(cv + e + 4);
        const int bt = i >> 8, col = (i & 255) * 8, bb = bt >> 9, t = bt & 511, h = col >> 7, d0 = col & 127;
        bf16* p = VTC + ((size_t)((bb * 16 + h) * 128 + d0)) * 512 + (t & ~15) + pg8::perm16(t & 15);
        p[0] = (bf16)f2bf(c.x); p[512] = (bf16)f2bf(c.y); p[1024] = (bf16)f2bf(c.z); p[1536] = (bf16)f2bf(c.w);
        p[2048] = (bf16)f2bf(d.x); p[2560] = (bf16)f2bf(d.y); p[3072] = (bf16)f2bf(d.z); p[3584] = (bf16)f2bf(d.w);
    }
}

__device__ __forceinline__ void norm_rows(const float* xa, const float* xb, const float* g, const float* modl, int jshift, int jscale, bf16* out, int gw, int NGW, int lane) {
    for (int m = gw; m < M; m += NGW) {
        const float* xr = (m < MP ? xa : xb) + (size_t)m * D + lane * 4;
        f32x4 v[8]; float ss = 0.f;
#pragma unroll
        for (int j = 0; j < 8; ++j) { v[j] = *(const f32x4*)(xr + 256 * j); ss += (v[j].x * v[j].x + v[j].y * v[j].y) + (v[j].z * v[j].z + v[j].w * v[j].w); }
        const float rstd = 1.0f / sqrtf(wave_sum(ss) * (1.0f / D) + NORM_EPS);
        const int cond = m < MP ? 0 : 1 + ((m - MP) >> 10);
        const float* sh = modl + (size_t)cond * 12288 + jshift * 2048 + lane * 4;
        const float* sc = modl + (size_t)cond * 12288 + jscale * 2048 + lane * 4;
        bf16* orow = out + (size_t)m * D + lane * 4;
#pragma unroll
        for (int j = 0; j < 8; ++j) {
            const f32x4 gg = *(const f32x4*)(g + lane * 4 + 256 * j), s1 = *(const f32x4*)(sc + 256 * j), s0 = *(const f32x4*)(sh + 256 * j);
            const f32x4 o = v[j] * rstd * gg * (s1 + 1.0f) + s0;
            u32x2 w; w.x = pk2(o.x, o.y); w.y = pk2(o.z, o.w);
            *(u32x2*)(orow + 256 * j) = w;
        }
    }
}
__device__ __forceinline__ void final_norm_rows(const float* x, const float* g, float* out, int gw, int NGW, int lane) {
    for (int m = gw; m < M; m += NGW) {
        const float* xr = x + (size_t)m * D + lane * 4;
        f32x4 v[8]; float ss = 0.f;
#pragma unroll
        for (int j = 0; j < 8; ++j) { v[j] = *(const f32x4*)(xr + 256 * j); ss += (v[j].x * v[j].x + v[j].y * v[j].y) + (v[j].z * v[j].z + v[j].w * v[j].w); }
        const float rstd = 1.0f / sqrtf(wave_sum(ss) * (1.0f / D) + NORM_EPS);
        float* orow = out + (size_t)m * D + lane * 4;
#pragma unroll
        for (int j = 0; j < 8; ++j) { const f32x4 gg = *(const f32x4*)(g + lane * 4 + 256 * j); *(f32x4*)(orow + 256 * j) = v[j] * rstd * gg; }
    }
}

__device__ __forceinline__ void load8(const bf16* p, float (&o)[8]) {
    const v4u w = *(const v4u*)p;
    o[0] = bf_lo(w.x); o[1] = bf_hi(w.x); o[2] = bf_lo(w.y); o[3] = bf_hi(w.y); o[4] = bf_lo(w.z); o[5] = bf_hi(w.z); o[6] = bf_lo(w.w); o[7] = bf_hi(w.w);
}
__device__ __forceinline__ void conv_gate(const bf16* up, const float* cw, const float* cb, bf16* act, int gtid, int NGT) {
    constexpr int NCH = FF / 8;
    for (int it = gtid; it < (M / 32) * NCH; it += NGT) {
        const int rb = it / NCH, ch = it % NCH, f0 = ch * 8, m0 = rb * 32;
        float w0g[8], w1g[8], w2g[8], bg[8], w0v[8], w1v[8], w2v[8], bv[8];
#pragma unroll
        for (int e = 0; e < 8; ++e) { w0g[e] = cw[f0 + e]; w1g[e] = cw[F2 + f0 + e]; w2g[e] = cw[2 * F2 + f0 + e]; bg[e] = cb[f0 + e];
            w0v[e] = cw[FF + f0 + e]; w1v[e] = cw[F2 + FF + f0 + e]; w2v[e] = cw[2 * F2 + FF + f0 + e]; bv[e] = cb[FF + f0 + e]; }
        const int seqlen = m0 < MP ? SEQ : DSEQ, pos0 = m0 < MP ? (m0 & (SEQ - 1)) : ((m0 - MP) & (DSEQ - 1));
        float pg[8], pv[8], cg[8], cv[8], ng[8], nv[8];
        if (pos0 == 0) {
#pragma unroll
            for (int e = 0; e < 8; ++e) { pg[e] = 0.f; pv[e] = 0.f; }
        } else { load8(up + (size_t)(m0 - 1) * F2 + f0, pg); load8(up + (size_t)(m0 - 1) * F2 + FF + f0, pv); }
        load8(up + (size_t)m0 * F2 + f0, cg); load8(up + (size_t)m0 * F2 + FF + f0, cv);
        for (int i = 0; i < 32; ++i) {
            const int m = m0 + i;
            if (pos0 + i + 1 >= seqlen) {
#pragma unroll
                for (int e = 0; e < 8; ++e) { ng[e] = 0.f; nv[e] = 0.f; }
            } else { load8(up + (size_t)(m + 1) * F2 + f0, ng); load8(up + (size_t)(m + 1) * F2 + FF + f0, nv); }
            float o[8];
#pragma unroll
            for (int e = 0; e < 8; ++e) {
                const float zg = w0g[e] * pg[e] + w1g[e] * cg[e] + w2g[e] * ng[e] + bg[e];
                const float zv = w0v[e] * pv[e] + w1v[e] * cv[e] + w2v[e] * nv[e] + bv[e];
                o[e] = zg * __builtin_amdgcn_rcpf(1.0f + __builtin_amdgcn_exp2f(-LOG2E * zg)) * zv;
                pg[e] = cg[e]; pv[e] = cv[e]; cg[e] = ng[e]; cv[e] = nv[e];
            }
            v4u w; w.x = pk2(o[0], o[1]); w.y = pk2(o[2], o[3]); w.z = pk2(o[4], o[5]); w.w = pk2(o[6], o[7]);
            *(v4u*)(act + (size_t)m * FF + f0) = w;
        }
    }
}

__device__ __forceinline__ f32x16 mfma32(bf16x8 a, bf16x8 b, f32x16 c) { return __builtin_amdgcn_mfma_f32_32x32x16_bf16(a, b, c, 0, 0, 0); }
template <bool WIN>
__device__ __forceinline__ void attn_chunk(const bf16* Kc, const bf16* VTc, int vts, const bf16x8 (&qf)[8], f32x16 (&o)[4], float& m_run, float& l_run, int lane,
                                           const LAS float* rpbL, int wq, int drb, int kk0) {
    const int r32 = lane & 31, hi = lane >> 5;
    f32x16 s[2];
#pragma unroll
    for (int kb = 0; kb < 2; ++kb) {
#pragma unroll
        for (int r = 0; r < 16; ++r) s[kb][r] = 0.f;
        const bf16* kp = Kc + (size_t)(32 * kb + r32) * D + 8 * hi;
#pragma unroll
        for (int st = 0; st < 8; ++st) { const bf16x8 kf = *(const bf16x8*)(kp + 16 * st); s[kb] = mfma32(kf, qf[st], s[kb]); }
    }
    if (WIN) {
        const int cs = min(max(wq - 8, 0), 48);
        const LAS float* tb = rpbL + (drb + (kk0 >> 6) + 7) * 31 + 15 - wq;
#pragma unroll
        for (int kb = 0; kb < 2; ++kb) {
#pragma unroll
            for (int r = 0; r < 16; ++r) {
                const int wk = 32 * kb + (r & 3) + 8 * (r >> 2) + 4 * hi;
                const bool ok = (wk >= cs) && (wk < cs + 16);
                const float b = tb[ok ? wk : wq];
                s[kb][r] = ok ? s[kb][r] + b : -1e30f;
            }
        }
    }
    float mx = s[0][0];
#pragma unroll
    for (int kb = 0; kb < 2; ++kb)
#pragma unroll
        for (int r = 0; r < 16; ++r) mx = fmaxf(mx, s[kb][r]);
    mx = fmaxf(mx, __shfl_xor(mx, 32));
    const float m_new = fmaxf(m_run, mx);
    const float alpha = __builtin_amdgcn_exp2f(m_run - m_new);
    m_run = m_new;
    float ls = 0.f;
#pragma unroll
    for (int kb = 0; kb < 2; ++kb)
#pragma unroll
        for (int r = 0; r < 16; ++r) { const float p = __builtin_amdgcn_exp2f(s[kb][r] - m_new); s[kb][r] = p; ls += p; }
    l_run = l_run * alpha + ls;
#pragma unroll
    for (int db = 0; db < 4; ++db)
#pragma unroll
        for (int r = 0; r < 16; ++r) o[db][r] *= alpha;
#pragma unroll
    for (int kb = 0; kb < 2; ++kb)
#pragma unroll
        for (int s2 = 0; s2 < 2; ++s2) {
            v4u pw; pw.x = cvtpk(s[kb][8 * s2 + 0], s[kb][8 * s2 + 1]); pw.y = cvtpk(s[kb][8 * s2 + 2], s[kb][8 * s2 + 3]); pw.z = cvtpk(s[kb][8 * s2 + 4], s[kb][8 * s2 + 5]); pw.w = cvtpk(s[kb][8 * s2 + 6], s[kb][8 * s2 + 7]);
            const bf16x8 pf = __builtin_bit_cast(bf16x8, pw);
            const bf16* vp = VTc + (size_t)r32 * vts + 32 * kb + 16 * s2 + 8 * hi;
#pragma unroll
            for (int db = 0; db < 4; ++db) { const bf16x8 vf = *(const bf16x8*)(vp + (size_t)(32 * db) * vts); o[db] = mfma32(vf, pf, o[db]); }
        }
}
__device__ __forceinline__ void attn_store(const f32x16 (&o)[4], float l_run, bf16* Orow  , int lane) {
    const int hi = lane >> 5;
    const float lt = l_run + __shfl_xor(l_run, 32);
    const float inv = 1.0f / lt;
#pragma unroll
    for (int db = 0; db < 4; ++db)
#pragma unroll
        for (int rg = 0; rg < 4; ++rg) {
            u32x2 w; w.x = cvtpk(o[db][4 * rg + 0] * inv, o[db][4 * rg + 1] * inv); w.y = cvtpk(o[db][4 * rg + 2] * inv, o[db][4 * rg + 3] * inv);
            *(u32x2*)(Orow + 32 * db + 8 * rg + 4 * hi) = w;
        }
}
__device__ __forceinline__ void attn_phase(LAS unsigned char* lds, const bf16* Qb, const bf16* Kb, const bf16* VTp, const bf16* VTs, const bf16* KC, const bf16* VTC, bf16* Ob, const float* rpb, int tid, int wave, int lane) {
    const int r32 = lane & 31, hi = lane >> 5;
    LAS float* rpbL = (LAS float*)lds;
    const int G = gridDim.x, nlat = G / 2 < 128 ? G / 2 : 128;
    if ((int)blockIdx.x < nlat) {
        for (int un = blockIdx.x; un < 128; un += nlat) {
            const int b = un >> 6, h = (un >> 2) & 15, rg4 = un & 3;
            __syncthreads();
            for (int i = tid; i < 465; i += NTHR) rpbL[i] = rpb[h * 465 + i] * LOG2E;
            __syncthreads();
            const int r = 4 * rg4 + (wave >> 1), wq0 = 32 * (wave & 1), start = min(max(r - 4, 0), 8);
            const int qrow = MP + b * DSEQ + r * 64 + wq0 + r32;
            bf16x8 qf[8];
#pragma unroll
            for (int st = 0; st < 8; ++st) qf[st] = *(const bf16x8*)(Qb + (size_t)qrow * D + h * HD + 16 * st + 8 * hi);
            f32x16 o[4];
#pragma unroll
            for (int db = 0; db < 4; ++db)
#pragma unroll
                for (int rr = 0; rr < 16; ++rr) o[db][rr] = 0.f;
            float m_run = -1e30f, l_run = 0.f;
            const bf16* Kc0 = KC + (size_t)(b * PAST) * D + h * HD; const bf16* Vc0 = VTC + (size_t)((b * 16 + h) * 128) * PAST;
            for (int c = 0; c < 8; ++c) attn_chunk<false>(Kc0 + (size_t)(64 * c) * D, Vc0 + 64 * c, PAST, qf, o, m_run, l_run, lane, rpbL, 0, 0, 0);
            const bf16* Kw0 = Kb + (size_t)(MP + b * DSEQ + start * 64) * D + h * HD; const bf16* Vw0 = VTs + (size_t)((b * 16 + h) * 128) * DSEQ + start * 64;
            for (int c = 0; c < 8; ++c) attn_chunk<true>(Kw0 + (size_t)(64 * c) * D, Vw0 + 64 * c, DSEQ, qf, o, m_run, l_run, lane, rpbL, wq0 + r32, start - r, 64 * c);
            attn_store(o, l_run, Ob + (size_t)qrow * D + h * HD, lane);
        }
    } else {
        const int nctx = G - nlat;
        for (int un = blockIdx.x - nlat; un < 512; un += nctx) {
            const int b = un >> 4, h = un & 15;
            const int qrow = b * SEQ + 32 * wave + r32;
            bf16x8 qf[8];
#pragma unroll
            for (int st = 0; st < 8; ++st) qf[st] = *(const bf16x8*)(Qb + (size_t)qrow * D + h * HD + 16 * st + 8 * hi);
            f32x16 o[4];
#pragma unroll
            for (int db = 0; db < 4; ++db)
#pragma unroll
                for (int rr = 0; rr < 16; ++rr) o[db][rr] = 0.f;
            float m_run = -1e30f, l_run = 0.f;
            const bf16* K0 = Kb + (size_t)(b * SEQ) * D + h * HD; const bf16* V0 = VTp + (size_t)((b * 16 + h) * 128) * SEQ;
            for (int c = 0; c < 4; ++c) attn_chunk<false>(K0 + (size_t)(64 * c) * D, V0 + 64 * c, SEQ, qf, o, m_run, l_run, lane, rpbL, 0, 0, 0);
            attn_store(o, l_run, Ob + (size_t)qrow * D + h * HD, lane);
        }
    }
}

constexpr int S5_SLD = 264, S5_HLD = 264;
constexpr int S5_SL_OFF = 0, S5_HIN_OFF = 64 * S5_SLD * 4;
__device__ __forceinline__ void cpow(float are, float aim, float dt, int e, float& pr, float& pi) {
    const float fe = (float)e, mag = __expf(are * dt * fe);
    float ang = aim * dt * fe; const float k = rintf(ang * 0.15915494309189535f);
    ang = fmaf(-k, 6.28318548202514648f, ang); ang = fmaf(-k, -1.74845553146e-7f, ang);
    pr = mag * __cosf(ang); pi = mag * __sinf(ang);
}
__device__ __forceinline__ void s5w_gen(LAS unsigned char* lds, bf16* S5W, int tid) {
    LAS float* pwr = (LAS float*)lds; LAS float* pwi = pwr + 17 * 128; LAS float* bbr = pwi + 17 * 128; LAS float* bbi = bbr + 2048; LAS float* ccr = bbi + 2048; LAS float* cci = ccr + 2048; LAS float* KF = cci + 2048;
    const float* are = ARG_IN(I_ARE); const float* aim = ARG_IN(I_AIM); const float* ldt = ARG_IN(I_LOGDT); const float* bre = ARG_IN(I_BRE); const float* bim = ARG_IN(I_BIM); const float* cre = ARG_IN(I_CRE); const float* cim = ARG_IN(I_CIM); const float* sd = ARG_IN(I_SD);
    for (int it = blockIdx.x; it < NG * 3; it += gridDim.x) {
        const int g = it / 3, part = it % 3;
        __syncthreads();
        if (tid < 128) {
            const int dir = tid >> 6, p = tid & 63;
            const float ar = are[(dir * NG + g) * SP + p], ai = aim[(dir * NG + g) * SP + p], dt = __expf(ldt[dir * NG + g]);
            for (int e = 0; e <= 16; ++e) { float pr, pi; cpow(ar, ai, dt, e, pr, pi); pwr[e * 128 + tid] = pr; pwi[e * 128 + tid] = pi; }
            float a1r, a1i; cpow(ar, ai, dt, 1, a1r, a1i);
            const float den = ar * ar + ai * ai, nr = a1r - 1.0f, ni = a1i;
            const float cfr = (nr * ar + ni * ai) / den, cfi = (ni * ar - nr * ai) / den;
            for (int c = 0; c < 16; ++c) { const float br = bre[((size_t)(dir * NG + g) * SP + p) * GC + c], bi = bim[((size_t)(dir * NG + g) * SP + p) * GC + c];
                bbr[tid * 16 + c] = cfr * br - cfi * bi; bbi[tid * 16 + c] = cfr * bi + cfi * br; }
        }
        for (int i = tid; i < 2048; i += NTHR) { const int dir = i >> 10, c = (i >> 6) & 15, p = i & 63; ccr[i] = cre[((size_t)(dir * NG + g) * GC + c) * SP + p]; cci[i] = cim[((size_t)(dir * NG + g) * GC + c) * SP + p]; }
        __syncthreads();
        bf16* Wt = S5W + ((size_t)g * 3 + part) * 65536;
        if (part == 0) {
            for (int i = tid; i < 8192; i += NTHR) {
                const int n = i >> 5, k0 = (i & 31) * 8, dir = n >> 7, ri = (n >> 6) & 1, p = n & 63, s = k0 >> 4, c0 = k0 & 15, e = dir ? s : 15 - s, sp = dir * 64 + p;
                const float pr = pwr[e * 128 + sp], pi = pwi[e * 128 + sp]; float v[8];
#pragma unroll
                for (int q = 0; q < 8; ++q) { const float br = bbr[sp * 16 + c0 + q], bi = bbi[sp * 16 + c0 + q]; v[q] = ri ? (pr * bi + pi * br) : (pr * br - pi * bi); }
                v4u o; o.x = pk2(v[0], v[1]); o.y = pk2(v[2], v[3]); o.z = pk2(v[4], v[5]); o.w = pk2(v[6], v[7]);
                *(v4u*)(Wt + (size_t)n * 256 + k0) = o;
            }
        } else if (part == 1) {
            for (int i = tid; i < 8192; i += NTHR) {
                const int n = i >> 5, k0 = (i & 31) * 8, t = n >> 4, c = n & 15, dir = k0 >> 7, ri = (k0 >> 6) & 1, p0 = k0 & 63, e = dir ? 16 - t : t + 1; float v[8];
#pragma unroll
                for (int q = 0; q < 8; ++q) { const int sp = dir * 64 + p0 + q; const float pr = pwr[e * 128 + sp], pi = pwi[e * 128 + sp], cr = ccr[(dir * 16 + c) * 64 + p0 + q], ci = cci[(dir * 16 + c) * 64 + p0 + q];
                    v[q] = ri ? -(cr * pi + ci * pr) : (cr * pr - ci * pi); }
                v4u o; o.x = pk2(v[0], v[1]); o.y = pk2(v[2], v[3]); o.z = pk2(v[4], v[5]); o.w = pk2(v[6], v[7]);
                *(v4u*)(Wt + (size_t)n * 256 + k0) = o;
            }
        } else {
            for (int i = tid; i < 31 * 256; i += NTHR) {
                const int tau = i / 256 - 15, c = (i >> 4) & 15, cp = i & 15; float acc = 0.f;
                if (tau >= 0) { const int e = tau;
                    for (int p = 0; p < 64; ++p) { const float pr = pwr[e * 128 + p], pi = pwi[e * 128 + p], br = bbr[p * 16 + cp], bi = bbi[p * 16 + cp], cr = ccr[c * 64 + p], ci = cci[c * 64 + p];
                        acc += cr * (pr * br - pi * bi) - ci * (pr * bi + pi * br); } }
                if (tau <= 0) { const int e = -tau;
                    for (int p = 0; p < 64; ++p) { const float pr = pwr[e * 128 + 64 + p], pi = pwi[e * 128 + 64 + p], br = bbr[(64 + p) * 16 + cp], bi = bbi[(64 + p) * 16 + cp], cr = ccr[(16 + c) * 64 + p], ci = cci[(16 + c) * 64 + p];
                        acc += cr * (pr * br - pi * bi) - ci * (pr * bi + pi * br); } }
                if (tau == 0 && c == cp) acc += sd[g * 16 + c];
                KF[i] = acc;
            }
            __syncthreads();
            for (int i = tid; i < 8192; i += NTHR) {
                const int n = i >> 5, k0 = (i & 31) * 8, t = n >> 4, c = n & 15, s = k0 >> 4, c0 = k0 & 15; float v[8];
#pragma unroll
                for (int q = 0; q < 8; ++q) v[q] = KF[(t - s + 15) * 256 + c * 16 + c0 + q];
                v4u o; o.x = pk2(v[0], v[1]); o.y = pk2(v[2], v[3]); o.z = pk2(v[4], v[5]); o.w = pk2(v[6], v[7]);
                *(v4u*)(Wt + (size_t)n * 256 + k0) = o;
            }
        }
    }
}
__device__ __forceinline__ void s5_phase(LAS unsigned char* lds, const bf16* U, const bf16* S5W, bf16* Y, float* out, int tid, int wave, int lane) {
    LAS float* Sl = (LAS float*)(lds + S5_SL_OFF); LAS bf16* Hin = (LAS bf16*)(lds + S5_HIN_OFF);
    const int r32 = lane & 31, hi = lane >> 5;
    for (int un = blockIdx.x; un < NG * 10; un += gridDim.x) {
        const int g = un & 127, rb = un >> 7;
        const int tok0 = rb * 1024;
        const bf16* WSt = S5W + ((size_t)g * 3 + 0) * 65536; const bf16* WHt = S5W + ((size_t)g * 3 + 1) * 65536; const bf16* WKt = S5W + ((size_t)g * 3 + 2) * 65536;
        const bf16* Ug = U + (size_t)tok0 * D + g * 16 + 8 * hi;
        {
            f32x16 acc[2];
#pragma unroll
            for (int mb = 0; mb < 2; ++mb)
#pragma unroll
                for (int r = 0; r < 16; ++r) acc[mb][r] = 0.f;
            const bf16* bp = WSt + (size_t)(32 * wave + r32) * 256 + 8 * hi;
#pragma unroll 4
            for (int st = 0; st < 16; ++st) {
                const bf16x8 bfr = *(const bf16x8*)(bp + 16 * st);
#pragma unroll
                for (int mb = 0; mb < 2; ++mb) { const bf16x8 afr = *(const bf16x8*)(Ug + (size_t)((32 * mb + r32) * 16 + st) * D); acc[mb] = mfma32(afr, bfr, acc[mb]); }
            }
#pragma unroll
            for (int mb = 0; mb < 2; ++mb)
#pragma unroll
                for (int r = 0; r < 16; ++r) Sl[(32 * mb + (r & 3) + 8 * (r >> 2) + 4 * hi) * S5_SLD + 32 * wave + r32] = acc[mb][r];
        }
        __syncthreads();
        {
            const bool prompt = rb < 8;
            const int dir = (tid >> 6) & 1, p = tid & 63, bi = tid >> 7;
            if (prompt || tid < 128) {
                const float ar = ARG_IN(I_ARE)[(dir * NG + g) * SP + p], ai = ARG_IN(I_AIM)[(dir * NG + g) * SP + p], dt = __expf(ARG_IN(I_LOGDT)[dir * NG + g]);
                float a16r, a16i; cpow(ar, ai, dt, 16, a16r, a16i);
                float hr = 0.f, hi_ = 0.f; const int nc = prompt ? 16 : 64, row0 = prompt ? bi * 16 : 0;
                if (!prompt) { const size_t si = ((size_t)((rb - 8) * 2 + dir) * NG + g) * SP + p; hr = ARG_IN(I_SRE)[si]; hi_ = ARG_IN(I_SIM)[si]; }
                const int cre_ = dir * 128 + p, cim_ = dir * 128 + 64 + p;
                for (int c = 0; c < nc; ++c) {
                    const int row = row0 + (dir ? nc - 1 - c : c);
                    Hin[row * S5_HLD + cre_] = (bf16)f2bf(hr); Hin[row * S5_HLD + cim_] = (bf16)f2bf(hi_);
                    const float sr = Sl[row * S5_SLD + cre_], si = Sl[row * S5_SLD + cim_];
                    const float nr = a16r * hr - a16i * hi_ + sr, ni = a16r * hi_ + a16i * hr + si;
                    hr = nr; hi_ = ni;
                }
                if (prompt) { const size_t so = ((size_t)((rb * 4 + bi) * 2 + dir) * NG + g) * SP + p; out[O_SRE + so] = hr; out[O_SIM + so] = hi_; }
            }
        }
        __syncthreads();
        {
            f32x16 acc[2];
#pragma unroll
            for (int mb = 0; mb < 2; ++mb)
#pragma unroll
                for (int r = 0; r < 16; ++r) acc[mb][r] = 0.f;
            const bf16* bk = WKt + (size_t)(32 * wave + r32) * 256 + 8 * hi; const bf16* bh = WHt + (size_t)(32 * wave + r32) * 256 + 8 * hi;
#pragma unroll 4
            for (int st = 0; st < 16; ++st) {
                const bf16x8 bfr = *(const bf16x8*)(bk + 16 * st);
#pragma unroll
                for (int mb = 0; mb < 2; ++mb) { const bf16x8 afr = *(const bf16x8*)(Ug + (size_t)((32 * mb + r32) * 16 + st) * D); acc[mb] = mfma32(afr, bfr, acc[mb]); }
            }
#pragma unroll 4
            for (int st = 0; st < 16; ++st) {
                const bf16x8 bfr = *(const bf16x8*)(bh + 16 * st);
#pragma unroll
                for (int mb = 0; mb < 2; ++mb) { const bf16x8 afr = *(const LAS bf16x8*)(Hin + (32 * mb + r32) * S5_HLD + 16 * st + 8 * hi); acc[mb] = mfma32(afr, bfr, acc[mb]); }
            }
            const int t = 2 * wave + (r32 >> 4), c = lane & 15;
            bf16* yp = Y + (size_t)(tok0 + t) * D + g * 16 + c;
#pragma unroll
            for (int mb = 0; mb < 2; ++mb)
#pragma unroll
                for (int r = 0; r < 16; ++r) { const int row = 32 * mb + (r & 3) + 8 * (r >> 2) + 4 * hi; yp[(size_t)(row * 16) * D] = (bf16)f2bf(gelu_tanh(acc[mb][r])); }
        }
        __syncthreads();
    }
}
#ifndef DBG_CHECKS
#define DBG_CHECKS 0
#endif
constexpr int N_PHASES = 19;
struct Args { const float* in[N_IN]; float* out; unsigned char* ws; int ph_lo, ph_hi, use_bar, pad; };
__global__ void __launch_bounds__(NTHR, 2) mega_fwd(Args args) {
    extern __shared__ __attribute__((aligned(16))) unsigned char lds_raw[];
    LAS unsigned char* lds = (LAS unsigned char*)lds_raw;
    { const int t0 = threadIdx.x; for (int u = t0; u < (LDS_BYTES - LDSCTL_OFF) / 4; u += NTHR) ((LAS unsigned*)(lds + LDSCTL_OFF))[u] = 0u; }
    __syncthreads();
    if (ARG_I32(2)) (void)xcd_barrier_post((unsigned*)((gu32*)(ARG_WS() + WS_CTL) + CW_BAR), (volatile LAS unsigned*)(lds + MISC_OFF) + 8);
#define PH_IDS() int tid = threadIdx.x; asm volatile("" : "+v"(tid)); const int lane = tid & 63, wave = __builtin_amdgcn_readfirstlane(tid >> 6), G = gridDim.x; \
    const int gw = blockIdx.x * NWAVES + wave, NGW = G * NWAVES, gtid = blockIdx.x * NTHR + tid, NGT = G * NTHR; (void)lane; (void)gw; (void)NGW; (void)gtid; (void)NGT; (void)G
#define ws ARG_WS()
#define out ARG_OUT()
#define mod ((float*)(ARG_WS() + WS_MOD))
#define HB ((bf16*)(ARG_WS() + WS_HB))
#define X1 ((float*)(ARG_WS() + WS_X1))
#define IN(k) (ARG_I32(0) <= (k) && (k) < ARG_I32(1))
#define SEAM(k) do { if (IN(k) && IN((k) + 1)) { XcdBarrier bar_; bar_.bar = (unsigned*)((gu32*)(ARG_WS() + WS_CTL) + CW_BAR); bar_.x = xb_xcc_id(); bar_.st = (volatile LAS unsigned*)(lds + MISC_OFF) + 8; xcd_barrier(bar_); } } while (0)
#define xs_off (ARG_IN(I_XS) - (size_t)MP * D)

    if (IN(0)) { PH_IDS();
        p0_ada(lds, ARG_IN(I_ADAW), ARG_IN(I_ADAB), ARG_IN(I_CCTX), ARG_IN(I_C), mod, tid, wave, lane);
        p0_weights(lds, ws, gw, NGW, wave, lane);
        p0_cache(ARG_IN(I_CK), ARG_IN(I_CV), (bf16*)(ws + WS_KC), (bf16*)(ws + WS_VTC), gtid, NGT);
    }
    SEAM(0);
#pragma unroll
    for (int l = 0; l < 2; ++l) {
        const int pb = l == 0 ? 1 : 9;
        const float* modl = mod + (size_t)l * 3 * 12288;
        if (IN(pb)) { PH_IDS();
            norm_rows(l == 0 ? ARG_IN(I_XP) : X1, l == 0 ? xs_off : X1, ARG_IN(I_N1G) + l * D, modl, 0, 1, HB, gw, NGW, lane);
            if (l == 1) s5w_gen(lds, (bf16*)(ws + WS_S5W), tid);
        }
        SEAM(pb);
        if (l == 0) {
            if (IN(2)) { PH_IDS();
                pg8::Gemm g{HB, (const bf16*)(ws + WS_WQKV), M, 3 * D, D}; pg8::StaticOrder S; S.init(M, 3 * D, G, (int)blockIdx.x);
                pg8::EpiQKV E{(bf16*)(ws + WS_Q), (bf16*)(ws + WS_K), (bf16*)(ws + WS_VTP), (bf16*)(ws + WS_VTS), out + O_NK, out + O_NV, C2};
                pg8::gemm_phase<pg8::EpiQKV, pg8::StaticOrder, true, true>(lds, g, S, E);
            }
            SEAM(2);
            if (IN(3)) { PH_IDS(); attn_phase(lds, (const bf16*)(ws + WS_Q), (const bf16*)(ws + WS_K), (const bf16*)(ws + WS_VTP), (const bf16*)(ws + WS_VTS), (const bf16*)(ws + WS_KC), (const bf16*)(ws + WS_VTC), (bf16*)(ws + WS_O), ARG_IN(I_RPB), tid, wave, lane); }
            SEAM(3);
            if (IN(4)) { PH_IDS();
                pg8::Gemm g{(const bf16*)(ws + WS_O), (const bf16*)(ws + WS_WO), M, D, D}; pg8::StaticOrder S; S.init(M, D, G, (int)blockIdx.x);
                pg8::EpiRes E{ARG_IN(I_XP), xs_off, X1, modl + 2 * 2048};
                pg8::gemm_phase<pg8::EpiRes, pg8::StaticOrder, true, true>(lds, g, S, E);
            }
            SEAM(4);
        } else {
            if (IN(10)) { PH_IDS();
                pg8::Gemm g{HB, (const bf16*)(ws + WS_WIN), M, D, D}; pg8::StaticOrder S; S.init(M, D, G, (int)blockIdx.x);
                pg8::EpiBf16<0> E{(bf16*)(ws + WS_U), D, nullptr, 0, 0, 1.f};
                pg8::gemm_phase<pg8::EpiBf16<0>, pg8::StaticOrder, true, true>(lds, g, S, E);
            }
            SEAM(10);
            if (IN(11)) { PH_IDS(); s5_phase(lds, (const bf16*)(ws + WS_U), (const bf16*)(ws + WS_S5W), (bf16*)(ws + WS_Y), out, tid, wave, lane); }
            SEAM(11);
            if (IN(12)) { PH_IDS();
                pg8::Gemm g{(const bf16*)(ws + WS_Y), (const bf16*)(ws + WS_WGATE), M, D, D}; pg8::StaticOrder S; S.init(M, D, G, (int)blockIdx.x);
                pg8::EpiGate E{(const bf16*)(ws + WS_Y), (bf16*)(ws + WS_Y2)};
                pg8::gemm_phase<pg8::EpiGate, pg8::StaticOrder, true, true>(lds, g, S, E);
            }
            SEAM(12);
            if (IN(13)) { PH_IDS();
                pg8::Gemm g{(const bf16*)(ws + WS_Y2), (const bf16*)(ws + WS_WOUT), M, D, D}; pg8::StaticOrder S; S.init(M, D, G, (int)blockIdx.x);
                pg8::EpiRes E{X1, X1, X1, modl + 2 * 2048};
                pg8::gemm_phase<pg8::EpiRes, pg8::StaticOrder, true, true>(lds, g, S, E);
            }
            SEAM(13);
        }
        const int fb = l == 0 ? 5 : 14;
        if (IN(fb)) { PH_IDS(); norm_rows(X1, X1, ARG_IN(I_N2G) + l * D, modl, 3, 4, HB, gw, NGW, lane); }
        SEAM(fb);
        if (IN(fb + 1)) { PH_IDS();
            pg8::Gemm g{HB, (const bf16*)(ws + (l == 0 ? WS_WUP0 : WS_WUP1)), M, F2, D}; pg8::StaticOrder S; S.init(M, F2, G, (int)blockIdx.x);
            pg8::EpiBf16<0> E{(bf16*)(ws + WS_UP), F2, nullptr, 0, 0, 1.f};
            pg8::gemm_phase<pg8::EpiBf16<0>, pg8::StaticOrder, true, true>(lds, g, S, E);
        }
        SEAM(fb + 1);
        if (IN(fb + 2)) { PH_IDS(); conv_gate((const bf16*)(ws + WS_UP), ARG_IN(I_CONVW) + (size_t)l * 3 * F2, ARG_IN(I_CONVB) + (size_t)l * F2, (bf16*)(ws + WS_ACT), gtid, NGT); }
        SEAM(fb + 2);
        if (IN(fb + 3)) { PH_IDS();
            pg8::Gemm g{(const bf16*)(ws + WS_ACT), (const bf16*)(ws + (l == 0 ? WS_WDN0 : WS_WDN1)), M, D, FF}; pg8::StaticOrder S; S.init(M, D, G, (int)blockIdx.x);
            pg8::EpiRes E{X1, X1, X1, modl + 5 * 2048};
            pg8::gemm_phase<pg8::EpiRes, pg8::StaticOrder, true, true>(lds, g, S, E);
        }
        SEAM(fb + 3);
    }
    if (IN(18)) { PH_IDS(); final_norm_rows(X1, ARG_IN(I_FG), out + O_Y, gw, NGW, lane); }
#undef IN
#undef SEAM
#undef ws
#undef out
#undef mod
#undef HB
#undef X1
#undef xs_off
}
#if DBG_CHECKS
constexpr size_t WS_XBK = WS_END;
__device__ __forceinline__ unsigned hashu(unsigned x) { x ^= x >> 16; x *= 0x7feb352dU; x ^= x >> 15; x *= 0x846ca68bU; x ^= x >> 16; return x; }
__device__ __forceinline__ float bff(bf16 v) { return __uint_as_float((unsigned)v << 16); }
__device__ __forceinline__ void dacc(float* dbg, int stage, float got, float ref) { const float d = got - ref; atomicAdd(dbg + 2 * stage, d * d); atomicAdd(dbg + 2 * stage + 1, ref * ref); }
__device__ __forceinline__ float dotbf(const bf16* a, const bf16* b, int K) { float s = 0.f; for (int k = 0; k < K; ++k) s += bff(a[k]) * bff(b[k]); return s; }

__global__ void chk_mod(const float* adaw, const float* adab, const float* cctx, const float* cs, const float* mod, float* dbg) {
    const unsigned id = blockIdx.x * blockDim.x + threadIdx.x, hsh = hashu(id * 7919u + 13u);
    const int l = hsh & 1, cond = (hsh >> 1) % 3, n = (hsh >> 8) % 12288;
    const float* cv = cond == 0 ? cctx : cs + (cond - 1) * 2048;
    float s = adab[l * 12288 + n];
    for (int k = 0; k < 2048; ++k) s += silu_f(cv[k]) * adaw[((size_t)l * 2048 + k) * 12288 + n];
    dacc(dbg, 0, mod[(size_t)(l * 3 + cond) * 12288 + n], s);
}
__global__ void chk_wt(const float* W, const bf16* WT, int K, int N, float* dbg) {
    const unsigned id = blockIdx.x * blockDim.x + threadIdx.x, hsh = hashu(id * 7919u + 17u), h2 = hashu(hsh + 99u);
    const int k = hsh % K, n = h2 % N;
    dacc(dbg, 1, bff(WT[(size_t)n * K + k]), bff((bf16)f2bf(W[(size_t)k * N + n])));
}
__global__ void chk_cache(const float* ck, const float* cv, const bf16* KC, const bf16* VTC, float* dbg) {
    const unsigned id = blockIdx.x * blockDim.x + threadIdx.x, hsh = hashu(id * 7919u + 19u);
    const int i = hsh % (2 * 512 * 2048), bt = i >> 11, col = i & 2047, b = bt >> 9, t = bt & 511, h = col >> 7, d = col & 127;
    dacc(dbg, 2, bff(KC[i]), ck[i]);
    dacc(dbg, 2, bff(VTC[((size_t)((b * 16 + h) * 128 + d)) * 512 + (t & ~15) + pg8::perm16(t & 15)]), cv[i]);
}
__global__ void chk_norm(const float* xa, const float* xb, int xb_sub, const float* g, const float* modl, int jshift, int jscale, const bf16* out, float* dbg, int stage) {
    const unsigned id = blockIdx.x * blockDim.x + threadIdx.x, hsh = hashu(id * 7919u + 23u + stage), h2 = hashu(hsh + 5u);
    const int m = hsh % M, n = h2 % D;
    const float* xr = m < MP ? xa + (size_t)m * D : xb + (size_t)(m - xb_sub) * D;
    float ss = 0.f; for (int k = 0; k < D; ++k) ss += xr[k] * xr[k];
    const float rstd = 1.0f / sqrtf(ss / D + NORM_EPS); const int cond = m < MP ? 0 : 1 + ((m - MP) >> 10);
    const float ref = xr[n] * rstd * g[n] * (1.0f + modl[cond * 12288 + jscale * 2048 + n]) + modl[cond * 12288 + jshift * 2048 + n];
    dacc(dbg, stage, bff(out[(size_t)m * D + n]), ref);
}
__global__ void chk_final(const float* x, const float* g, const float* out, float* dbg, int stage) {
    const unsigned id = blockIdx.x * blockDim.x + threadIdx.x, hsh = hashu(id * 7919u + 29u), h2 = hashu(hsh + 5u);
    const int m = hsh % M, n = h2 % D; const float* xr = x + (size_t)m * D;
    float ss = 0.f; for (int k = 0; k < D; ++k) ss += xr[k] * xr[k];
    dacc(dbg, stage, out[(size_t)m * D + n], xr[n] / sqrtf(ss / D + NORM_EPS) * g[n]);
}
__global__ void chk_qkv(const bf16* HB, const bf16* Wt, const bf16* Q, const bf16* K, const bf16* VTp, const bf16* VTs, const float* nk, const float* nv, float* dbg) {
    const unsigned id = blockIdx.x * blockDim.x + threadIdx.x, hsh = hashu(id * 7919u + 31u), h2 = hashu(hsh + 5u);
    const int m = hsh % M, n = h2 % (3 * D), sec = n / D, col = n % D;
    const float acc = dotbf(HB + (size_t)m * D, Wt + (size_t)n * D, D);
    if (sec == 0) dacc(dbg, 4, bff(Q[(size_t)m * D + col]), acc * C2);
    else if (sec == 1) { dacc(dbg, 4, bff(K[(size_t)m * D + col]), acc); if (m < MP) dacc(dbg, 4, nk[(size_t)m * D + col], acc); }
    else { const int h = col >> 7, d = col & 127; float got;
        if (m < MP) { const int b = m >> 8, t = m & 255; got = bff(VTp[((size_t)((b * 16 + h) * 128 + d)) * 256 + (t & ~15) + pg8::perm16(t & 15)]); dacc(dbg, 4, nv[(size_t)m * D + col], acc); }
        else { const int rs = m - MP, b = rs >> 10, t = rs & 1023; got = bff(VTs[((size_t)((b * 16 + h) * 128 + d)) * 1024 + (t & ~15) + pg8::perm16(t & 15)]); }
        dacc(dbg, 4, got, acc); }
}
__global__ void chk_attn(const bf16* Q, const bf16* Kb, const bf16* VTp, const bf16* VTs, const bf16* KC, const bf16* VTC, const float* rpb, const bf16* O, float* dbg) {
    const unsigned id = blockIdx.x * blockDim.x + threadIdx.x, hsh = hashu(id * 7919u + 37u), h2 = hashu(hsh + 5u);
    int m = hsh % M; if (id & 1) m = MP + (hsh % MS);
    const int h = h2 & 15, d = (h2 >> 4) & 127;
    const bf16* q = Q + (size_t)m * D + h * HD;
    float mx = -1e30f, l = 0.f, o = 0.f;
    auto step = [&](float lg, float v) { const float mn = fmaxf(mx, lg), a = exp2f(mx - mn), p = exp2f(lg - mn); l = l * a + p; o = o * a + p * v; mx = mn; };
    if (m < MP) { const int b = m >> 8;
        for (int t = 0; t < 256; ++t) step(dotbf(q, Kb + (size_t)(b * 256 + t) * D + h * HD, HD), bff(VTp[((size_t)((b * 16 + h) * 128 + d)) * 256 + (t & ~15) + pg8::perm16(t & 15)]));
    } else { const int rs = m - MP, b = rs >> 10, pos = rs & 1023, r = pos >> 6, wq = pos & 63, start = min(max(r - 4, 0), 8), cs = min(max(wq - 8, 0), 48);
        for (int j = 0; j < 8; ++j) for (int wk = cs; wk < cs + 16; ++wk) { const int t = (start + j) * 64 + wk;
            const float lg = dotbf(q, Kb + (size_t)(MP + b * 1024 + t) * D + h * HD, HD) + rpb[(h * 15 + (start + j - r + 7)) * 31 + (wk - wq + 15)] * LOG2E;
            step(lg, bff(VTs[((size_t)((b * 16 + h) * 128 + d)) * 1024 + (t & ~15) + pg8::perm16(t & 15)])); }
        for (int t = 0; t < 512; ++t) step(dotbf(q, KC + (size_t)(b * 512 + t) * D + h * HD, HD), bff(VTC[((size_t)((b * 16 + h) * 128 + d)) * 512 + (t & ~15) + pg8::perm16(t & 15)]));
    }
    dacc(dbg, 5, bff(O[(size_t)m * D + h * HD + d]), o / l);
}
__global__ void chk_res(const bf16* A, const bf16* Bt, int K, const float* baseP, const float* baseS, int bs_sub, const float* gate, const float* out, float* dbg, int stage) {
    const unsigned id = blockIdx.x * blockDim.x + threadIdx.x, hsh = hashu(id * 7919u + 41u + stage), h2 = hashu(hsh + 5u);
    const int m = hsh % M, n = h2 % D, cond = m < MP ? 0 : 1 + ((m - MP) >> 10);
    const float acc = dotbf(A + (size_t)m * K, Bt + (size_t)n * K, K);
    const float ref = (m < MP ? baseP[(size_t)m * D + n] : baseS[(size_t)(m - bs_sub) * D + n]) + gate[cond * 12288 + n] * acc;
    dacc(dbg, stage, out[(size_t)m * D + n], ref);
}
__global__ void chk_gemm_bf(const bf16* A, const bf16* Bt, int K, int N, const bf16* O, float* dbg, int stage) {
    const unsigned id = blockIdx.x * blockDim.x + threadIdx.x, hsh = hashu(id * 7919u + 43u + stage), h2 = hashu(hsh + 5u);
    const int m = hsh % M, n = h2 % N;
    dacc(dbg, stage, bff(O[(size_t)m * N + n]), dotbf(A + (size_t)m * K, Bt + (size_t)n * K, K));
}
__global__ void chk_gate(const bf16* Y, const bf16* Bt, const bf16* Y2, float* dbg, int stage) {
    const unsigned id = blockIdx.x * blockDim.x + threadIdx.x, hsh = hashu(id * 7919u + 47u), h2 = hashu(hsh + 5u);
    const int m = hsh % M, n = h2 % D;
    const float z = dotbf(Y + (size_t)m * D, Bt + (size_t)n * D, D);
    dacc(dbg, stage, bff(Y2[(size_t)m * D + n]), bff(Y[(size_t)m * D + n]) / (1.0f + expf(-z)));
}
__global__ void chk_conv(const bf16* up, const float* cw, const float* cb, const bf16* act, float* dbg, int stage) {
    const unsigned id = blockIdx.x * blockDim.x + threadIdx.x, hsh = hashu(id * 7919u + 53u + stage), h2 = hashu(hsh + 5u);
    int m = hsh % M; const int f = h2 % FF;
    if ((id & 7) == 0) m = (m & ~255);
    if ((id & 7) == 1) m = (m | 255);
    const int seqlen = m < MP ? SEQ : DSEQ, pos = m < MP ? (m & 255) : ((m - MP) & 1023);
    float z[2];
    for (int q = 0; q < 2; ++q) { const int c = f + q * FF;
        const float a = pos > 0 ? bff(up[(size_t)(m - 1) * F2 + c]) : 0.f, b = bff(up[(size_t)m * F2 + c]), d = pos + 1 < seqlen ? bff(up[(size_t)(m + 1) * F2 + c]) : 0.f;
        z[q] = cw[c] * a + cw[F2 + c] * b + cw[2 * F2 + c] * d + cb[c]; }
    dacc(dbg, stage, bff(act[(size_t)m * FF + f]), z[0] / (1.0f + expf(-z[0])) * z[1]);
}
struct S5P { const float* p[8]; };
__global__ void chk_s5(const bf16* U, S5P inp, const float* sre, const float* sim, const bf16* Y, const float* out, float* dbg, int stage) {
    const float* are = inp.p[0]; const float* aim = inp.p[1]; const float* ldt = inp.p[2]; const float* bre = inp.p[3]; const float* bim = inp.p[4]; const float* cre = inp.p[5]; const float* cim = inp.p[6]; const float* sd = inp.p[7];
    const int wv = (blockIdx.x * blockDim.x + threadIdx.x) >> 6, p = threadIdx.x & 63;
    const unsigned hsh = hashu(wv * 7919u + 59u), h2 = hashu(hsh + 5u);
    const bool stchk = (wv & 3) == 3;
    int m = hsh % M; if (wv & 1) m = MP + (hsh % MS);
    if (stchk) m = hsh % MP;
    const int ch = h2 % D, g = ch >> 4, c = ch & 15;
    const int L = m < MP ? SEQ : DSEQ, tokbase = m < MP ? (m & ~255) : MP + ((m - MP) & ~1023), t = m - tokbase;
    float ysum = 0.f;
    for (int dir = 0; dir < 2; ++dir) {
        const double ar = are[(dir * NG + g) * SP + p], ai = aim[(dir * NG + g) * SP + p], dt = exp((double)ldt[dir * NG + g]);
        const double mag = exp(ar * dt), abr = mag * cos(ai * dt), abi = mag * sin(ai * dt), den = ar * ar + ai * ai, nr = abr - 1.0;
        const double cfr = (nr * ar + abi * ai) / den, cfi = (abi * ar - nr * ai) / den;
        float bbr[16], bbi[16];
#pragma unroll
        for (int q = 0; q < 16; ++q) { const double br = bre[((size_t)(dir * NG + g) * SP + p) * GC + q], bi = bim[((size_t)(dir * NG + g) * SP + p) * GC + q]; bbr[q] = (float)(cfr * br - cfi * bi); bbi[q] = (float)(cfr * bi + cfi * br); }
        float hr = 0.f, hi = 0.f;
        if (m >= MP) { const size_t si = ((size_t)(((m - MP) >> 10) * 2 + dir) * NG + g) * SP + p; hr = sre[si]; hi = sim[si]; }
        const int tend = stchk ? (dir ? 0 : L - 1) : t;
        for (int s = dir ? L - 1 : 0; dir ? s >= tend : s <= tend; s += dir ? -1 : 1) {
            float ur = 0.f, ui = 0.f;
#pragma unroll
            for (int q = 0; q < 16; ++q) { const float u = bff(U[(size_t)(tokbase + s) * D + g * 16 + q]); ur += bbr[q] * u; ui += bbi[q] * u; }
            const float n_r = (float)abr * hr - (float)abi * hi + ur, n_i = (float)abr * hi + (float)abi * hr + ui; hr = n_r; hi = n_i;
        }
        if (stchk) { const size_t so = ((size_t)((m >> 8) * 2 + dir) * NG + g) * SP + p; dacc(dbg, stage + 1, out[O_SRE + so], hr); dacc(dbg, stage + 1, out[O_SIM + so], hi); }
        ysum += hr * cre[((size_t)(dir * NG + g) * GC + c) * SP + p] - hi * cim[((size_t)(dir * NG + g) * GC + c) * SP + p];
    }
    if (!stchk) {
        float y = wave_sum(ysum) + sd[ch] * bff(U[(size_t)m * D + ch]);
        if (p == 0) { const float z = 0.7978845608028654f * (y + 0.044715f * y * y * y); dacc(dbg, stage, bff(Y[(size_t)m * D + ch]), 0.5f * y * (1.0f + tanhf(z))); }
    }
}
constexpr int DBG_NSTAGE = 22;
__device__ const float DBG_TOL[DBG_NSTAGE] = {1e-9f, 1e-12f, 2e-5f, 2e-5f, 2e-5f, 1e-4f, 1e-9f, 2e-5f, 2e-5f, 3e-5f, 1e-9f, 2e-5f, 2e-5f, 3e-4f, 3e-4f, 3e-5f, 1e-9f, 2e-5f, 2e-5f, 3e-5f, 1e-9f, 1e-9f};
__global__ void dbg_report(const float* dbg, float* out, size_t nout, int force_stage) {
    __shared__ float code;
    if (threadIdx.x == 0) {
        float cv = 0.f;
        for (int s = 0; s < DBG_NSTAGE; ++s) {
            const float num = dbg[2 * s], den = dbg[2 * s + 1]; const float r = num / den;
            const bool bad = !(r <= DBG_TOL[s]) || !(den > 0.f);
            if ((force_stage < 0 && bad) || s == force_stage) {
                float lg = (r == r && r > 0.f) ? log10f(r) : (r == 0.f ? -8.f : 3.f); lg = fminf(fmaxf(lg, -8.f), 2.f);
                float mant = 1.0f + (lg + 8.0f) * 0.85f; if (!(r == r) || !(den > 0.f)) mant = 9.9f;
                cv = mant * powf(10.f, (float)(s + 3)); break; }
        }
        code = cv;
    }
    __syncthreads();
    const float cv = code;
    if (cv != 0.f) { for (size_t i = (size_t)blockIdx.x * blockDim.x + threadIdx.x; i < nout; i += (size_t)gridDim.x * blockDim.x) out[i] = (i == 0) ? cv : 0.f; }
}
#endif
#ifndef DBG_CHECKS
#define DBG_CHECKS 0
#endif
#ifndef N_LAUNCHES
#define N_LAUNCHES 1
#endif
#ifndef DBG_FORCE_STAGE
#define DBG_FORCE_STAGE (-1)
#endif
__global__ void err_code_kernel(float* o, float v) { if (threadIdx.x == 0 && blockIdx.x == 0) o[0] = v; }
extern "C" void kernel_launch(void* const* d_in, const int* in_sizes, int n_in, void* d_out, int out_size, void* d_ws, size_t ws_size, hipStream_t stream) {
    static int grid = 0;
    if (grid == 0) {
        size_t need = WS_END; if (DBG_CHECKS) need += (size_t)M * D * 4;
        if (n_in != N_IN || (size_t)out_size != O_END || ws_size < need) { fprintf(stderr, "kernel_launch: shape mismatch: n_in %d, out %d (want %zu), ws %zu (need %zu); nothing launched\n", n_in, out_size, (size_t)O_END, ws_size, need); grid = -1; return; }
        int dev = 0, cus = 0, per_cu = 0;
        if (hipGetDevice(&dev) != hipSuccess || hipDeviceGetAttribute(&cus, hipDeviceAttributeMultiprocessorCount, dev) != hipSuccess) { fprintf(stderr, "kernel_launch: device query failed\n"); grid = -1; return; }
        if (hipFuncSetAttribute((const void*)mega_fwd, hipFuncAttributeMaxDynamicSharedMemorySize, LDS_BYTES) != hipSuccess) { fprintf(stderr, "kernel_launch: hipFuncSetAttribute failed\n"); grid = -1; return; }
        if (hipOccupancyMaxActiveBlocksPerMultiprocessor(&per_cu, (const void*)mega_fwd, NTHR, LDS_BYTES) != hipSuccess || per_cu < 1) fprintf(stderr, "kernel_launch: note: occupancy query reports %d workgroups per CU\n", per_cu);
        (void)hipGetLastError();
        grid = cus;
    }
    if (grid < 0) { if (out_size > 0) hipLaunchKernelGGL(err_code_kernel, dim3(1), dim3(64), 0, stream, (float*)d_out, 7.7e37f); return; }
    unsigned char* ws = (unsigned char*)d_ws;
    (void)hipMemsetAsync(ws + WS_CTL, 0, CTL_ZERO_BYTES, stream);
    Args a{};
    for (int i = 0; i < N_IN; ++i) a.in[i] = (const float*)d_in[i];
    a.out = (float*)d_out; a.ws = ws;
#if !DBG_CHECKS
    if (N_LAUNCHES == 1) { a.ph_lo = 0; a.ph_hi = N_PHASES; a.use_bar = 1; hipLaunchKernelGGL(mega_fwd, dim3(grid), dim3(NTHR), LDS_BYTES, stream, a); }
    else for (int p = 0; p < N_PHASES; ++p) { a.ph_lo = p; a.ph_hi = p + 1; a.use_bar = 0; hipLaunchKernelGGL(mega_fwd, dim3(grid), dim3(NTHR), LDS_BYTES, stream, a); }
#else
    float* dbg = (float*)(ws + WS_DBG); float* out = (float*)d_out; const float* const* in = (const float* const*)a.in;
    float* mod = (float*)(ws + WS_MOD); bf16* HB = (bf16*)(ws + WS_HB); float* X1 = (float*)(ws + WS_X1); float* XBK = (float*)(ws + WS_XBK);
    const dim3 cg(32), cb(256);
    for (int p = 0; p < N_PHASES; ++p) {
        if (p == 8 || p == 13 || p == 17) (void)hipMemcpyAsync(XBK, X1, (size_t)M * D * 4, hipMemcpyDeviceToDevice, stream);
        a.ph_lo = p; a.ph_hi = p + 1; a.use_bar = 0; hipLaunchKernelGGL(mega_fwd, dim3(grid), dim3(NTHR), LDS_BYTES, stream, a);
        const int l = p >= 9 ? 1 : 0; const float* modl = mod + (size_t)l * 3 * 12288;
        switch (p) {
        case 0:
            hipLaunchKernelGGL(chk_mod, cg, cb, 0, stream, a.in[I_ADAW], a.in[I_ADAB], a.in[I_CCTX], a.in[I_C], mod, dbg);
            hipLaunchKernelGGL(chk_wt, cg, cb, 0, stream, a.in[I_WQKV], (const bf16*)(ws + WS_WQKV), D, 3 * D, dbg);
            hipLaunchKernelGGL(chk_wt, cg, cb, 0, stream, a.in[I_WO], (const bf16*)(ws + WS_WO), D, D, dbg);
            hipLaunchKernelGGL(chk_wt, cg, cb, 0, stream, a.in[I_WIN], (const bf16*)(ws + WS_WIN), D, D, dbg);
            hipLaunchKernelGGL(chk_wt, cg, cb, 0, stream, a.in[I_WGATE], (const bf16*)(ws + WS_WGATE), D, D, dbg);
            hipLaunchKernelGGL(chk_wt, cg, cb, 0, stream, a.in[I_WOUT], (const bf16*)(ws + WS_WOUT), D, D, dbg);
            hipLaunchKernelGGL(chk_wt, cg, cb, 0, stream, a.in[I_WUP], (const bf16*)(ws + WS_WUP0), D, F2, dbg);
            hipLaunchKernelGGL(chk_wt, cg, cb, 0, stream, a.in[I_WUP] + (size_t)D * F2, (const bf16*)(ws + WS_WUP1), D, F2, dbg);
            hipLaunchKernelGGL(chk_wt, cg, cb, 0, stream, a.in[I_WDN], (const bf16*)(ws + WS_WDN0), FF, D, dbg);
            hipLaunchKernelGGL(chk_wt, cg, cb, 0, stream, a.in[I_WDN] + (size_t)FF * D, (const bf16*)(ws + WS_WDN1), FF, D, dbg);
            hipLaunchKernelGGL(chk_cache, cg, cb, 0, stream, a.in[I_CK], a.in[I_CV], (const bf16*)(ws + WS_KC), (const bf16*)(ws + WS_VTC), dbg);
            break;
        case 1: hipLaunchKernelGGL(chk_norm, cg, cb, 0, stream, a.in[I_XP], a.in[I_XS], (int)MP, a.in[I_N1G], modl, 0, 1, (const bf16*)HB, dbg, 3); break;
        case 2: hipLaunchKernelGGL(chk_qkv, cg, cb, 0, stream, (const bf16*)HB, (const bf16*)(ws + WS_WQKV), (const bf16*)(ws + WS_Q), (const bf16*)(ws + WS_K), (const bf16*)(ws + WS_VTP), (const bf16*)(ws + WS_VTS), (const float*)(out + O_NK), (const float*)(out + O_NV), dbg); break;
        case 3: hipLaunchKernelGGL(chk_attn, cg, cb, 0, stream, (const bf16*)(ws + WS_Q), (const bf16*)(ws + WS_K), (const bf16*)(ws + WS_VTP), (const bf16*)(ws + WS_VTS), (const bf16*)(ws + WS_KC), (const bf16*)(ws + WS_VTC), a.in[I_RPB], (const bf16*)(ws + WS_O), dbg); break;
        case 4: hipLaunchKernelGGL(chk_res, cg, cb, 0, stream, (const bf16*)(ws + WS_O), (const bf16*)(ws + WS_WO), D, a.in[I_XP], a.in[I_XS], (int)MP, modl + 2 * 2048, (const float*)X1, dbg, 6); break;
        case 5: hipLaunchKernelGGL(chk_norm, cg, cb, 0, stream, (const float*)X1, (const float*)X1, 0, a.in[I_N2G], modl, 3, 4, (const bf16*)HB, dbg, 7); break;
        case 6: hipLaunchKernelGGL(chk_gemm_bf, cg, cb, 0, stream, (const bf16*)HB, (const bf16*)(ws + WS_WUP0), D, F2, (const bf16*)(ws + WS_UP), dbg, 8); break;
        case 7: hipLaunchKernelGGL(chk_conv, cg, cb, 0, stream, (const bf16*)(ws + WS_UP), a.in[I_CONVW], a.in[I_CONVB], (const bf16*)(ws + WS_ACT), dbg, 9); break;
        case 8: hipLaunchKernelGGL(chk_res, cg, cb, 0, stream, (const bf16*)(ws + WS_ACT), (const bf16*)(ws + WS_WDN0), FF, (const float*)XBK, (const float*)XBK, 0, modl + 5 * 2048, (const float*)X1, dbg, 10); break;
        case 9: hipLaunchKernelGGL(chk_norm, cg, cb, 0, stream, (const float*)X1, (const float*)X1, 0, a.in[I_N1G] + D, modl, 0, 1, (const bf16*)HB, dbg, 11); break;
        case 10: hipLaunchKernelGGL(chk_gemm_bf, cg, cb, 0, stream, (const bf16*)HB, (const bf16*)(ws + WS_WIN), D, D, (const bf16*)(ws + WS_U), dbg, 12); break;
        case 11: { S5P sp; sp.p[0] = a.in[I_ARE]; sp.p[1] = a.in[I_AIM]; sp.p[2] = a.in[I_LOGDT]; sp.p[3] = a.in[I_BRE]; sp.p[4] = a.in[I_BIM]; sp.p[5] = a.in[I_CRE]; sp.p[6] = a.in[I_CIM]; sp.p[7] = a.in[I_SD];
            hipLaunchKernelGGL(chk_s5, dim3(128), cb, 0, stream, (const bf16*)(ws + WS_U), sp, a.in[I_SRE], a.in[I_SIM], (const bf16*)(ws + WS_Y), (const float*)out, dbg, 13); } break;
        case 12: hipLaunchKernelGGL(chk_gate, cg, cb, 0, stream, (const bf16*)(ws + WS_Y), (const bf16*)(ws + WS_WGATE), (const bf16*)(ws + WS_Y2), dbg, 15); break;
        case 13: hipLaunchKernelGGL(chk_res, cg, cb, 0, stream, (const bf16*)(ws + WS_Y2), (const bf16*)(ws + WS_WOUT), D, (const float*)XBK, (const float*)XBK, 0, modl + 2 * 2048, (const float*)X1, dbg, 16); break;
        case 14: hipLaunchKernelGGL(chk_norm, cg, cb, 0, stream, (const float*)X1, (const float*)X1, 0, a.in[I_N2G] + D, modl, 3, 4, (const bf16*)HB, dbg, 17); break;
        case 15: hipLaunchKernelGGL(chk_gemm_bf, cg, cb, 0, stream, (const bf16*)HB, (const bf16*)(ws + WS_WUP1), D, F2, (const bf16*)(ws + WS_UP), dbg, 18); break;
        case 16: hipLaunchKernelGGL(chk_conv, cg, cb, 0, stream, (const bf16*)(ws + WS_UP), a.in[I_CONVW] + (size_t)3 * F2, a.in[I_CONVB] + F2, (const bf16*)(ws + WS_ACT), dbg, 19); break;
        case 17: hipLaunchKernelGGL(chk_res, cg, cb, 0, stream, (const bf16*)(ws + WS_ACT), (const bf16*)(ws + WS_WDN1), FF, (const float*)XBK, (const float*)XBK, 0, modl + 5 * 2048, (const float*)X1, dbg, 20); break;
        case 18: hipLaunchKernelGGL(chk_final, cg, cb, 0, stream, (const float*)X1, a.in[I_FG], (const float*)out, dbg, 21); break;
        }
    }
    hipLaunchKernelGGL(dbg_report, dim3(1024), dim3(256), 0, stream, (const float*)dbg, out, (size_t)O_END, (int)DBG_FORCE_STAGE);
#endif
}
```

```cpp
#define DBG_CHECKS 0
#include <hip/hip_runtime.h>
#include <cstdio>
#include <cstdint>
namespace pg8 {
#define PG8_LAS __attribute__((address_space(3)))
typedef unsigned short bf16_t;
typedef short bf16x8 __attribute__((ext_vector_type(8)));
typedef float f32x4 __attribute__((ext_vector_type(4)));
typedef unsigned u32x4 __attribute__((ext_vector_type(4)));
constexpr int BM = 256, BK = 64, HALF = 128, HTB = HALF * BK * 2  , STAGE_BYTES = 8 * HTB, NXCD = 8, WGM = 8;

__host__ __device__ __forceinline__ int lds_byte(int r, int c) { const int st = (r >> 4) * 2 + (c >> 5), rr = r & 15, cc = c & 31, ob = rr * 64 + cc * 2; return st * 1024 + (ob ^ (((ob >> 9) & 1) << 5)); }
__host__ __device__ __forceinline__ void stage_rc(int b, int& R, int& C) { const int st = b / 1024, sb = b % 1024, swz = sb ^ (((sb >> 9) & 1) << 5); R = (st >> 1) * 16 + swz / 64; C = (st & 1) * 32 + (swz % 64) / 2; }
__host__ __device__ __forceinline__ int perm32(int rho) { const int n = rho >> 4, i = rho & 15; return 8 * (i >> 2) + 4 * n + (i & 3); }

struct Unit { int pm, pn; int k0 = 0, nk = 0, sl = -1; };
struct Gemm { const bf16_t* A; const bf16_t* Bt; int M, N, K; };

struct StaticOrder {
    int nM, nN, nwg, G, c;
    __host__ __device__ void init(int M, int N, int G_, int c_) { nM = M / BM; nN = N / BM; nwg = nM * nN; G = G_; c = c_; }
    __host__ __device__ __forceinline__ bool next(int i, Unit& u) const {
        const long L = (long)i * G + c; if (L >= nwg) return false;
        int wgid = (int)L; { const int q = nwg / NXCD, r = nwg % NXCD, xcd = wgid % NXCD, off = wgid / NXCD; wgid = (xcd < r ? xcd * (q + 1) : r * (q + 1) + (xcd - r) * q) + off; }
        const int nig = WGM * nN, gid = wgid / nig, fm = gid * WGM, gsz = (nM - fm) < WGM ? (nM - fm) : WGM;
        u.pm = fm + ((wgid % nig) % gsz); u.pn = (wgid % nig) / gsz; return true;
    }
    __device__ __forceinline__ void a_ready(const Unit&) const {}
    __device__ __forceinline__ void done(const Unit&) const {}
};

__device__ __forceinline__ unsigned cvt_pk_bf16(float lo, float hi) { unsigned r; asm volatile("v_cvt_pk_bf16_f32 %0, %1, %2" : "=v"(r) : "v"(lo), "v"(hi)); return r; }
typedef float f32x2 __attribute__((ext_vector_type(2)));
__device__ __forceinline__ f32x2 gelu_pk(f32x2 v) {
    const f32x2 av = __builtin_elementwise_abs(v), d = av * 0.2316418882f + 1.0f;
    f32x2 t; t.x = __builtin_amdgcn_rcpf(d.x); t.y = __builtin_amdgcn_rcpf(d.y);
    f32x2 q = t * 0.5307027145f + (-0.7265760135f); q = q * t + 0.7107068705f; q = q * t + (-0.142248368f); q = q * t + 0.127414796f; q = q * t;
    const f32x2 s = (v * v) * (-0.72134752044f);
    f32x2 e; e.x = __builtin_amdgcn_exp2f(s.x); e.y = __builtin_amdgcn_exp2f(s.y);
    const f32x2 m = v * (q * e), r = v - m;
    f32x2 o; o.x = v.x < 0.f ? m.x : r.x; o.y = v.y < 0.f ? m.y : r.y; return o;
}

template <int ACT  > struct EpiBf16 {
    static constexpr bool PERM = true, AFTER_DRAIN = false; static_assert(ACT == 0 || ACT == 1, "EpiBf16: ACT is 0 (none) or 1 (gelu_pk)");
    bf16_t* O; int ldc; const float* bias; int split_cols; size_t split_stride; float scale0;
    __device__ __forceinline__ void operator()(const f32x4 (&acc)[2][2][4][2], const Unit& u, int wr, int wc, int fr, int fq) const {
        const int row0 = u.pm * BM + wr * 64 + fr; int colt = u.pn * BM; bf16_t* base = O;
        float sc = 1.f; if (split_cols) { const int t = colt / split_cols; base += (size_t)t * split_stride; colt -= t * split_cols; if (t == 0) sc = scale0; }
        const int col0 = colt + wc * 32 + 8 * fq, bcol0 = u.pn * BM + wc * 32 + 8 * fq;
        f32x4 bv[2][2];
#pragma unroll
        for (int bj = 0; bj < 2; ++bj)
#pragma unroll
            for (int n = 0; n < 2; ++n) bv[bj][n] = bias ? *(const f32x4*)(bias + bcol0 + bj * HALF + 4 * n) : (f32x4){0.f, 0.f, 0.f, 0.f};
#pragma unroll
        for (int ai = 0; ai < 2; ++ai)
#pragma unroll
            for (int m = 0; m < 4; ++m) { bf16_t* rowp = base + (size_t)(row0 + ai * HALF + m * 16) * ldc + col0;
#pragma unroll
                for (int bj = 0; bj < 2; ++bj) { f32x4 v0 = acc[ai][bj][m][0] + bv[bj][0], v1 = acc[ai][bj][m][1] + bv[bj][1];
                    if (ACT == 1) { f32x2 a = gelu_pk((f32x2){v0[0], v0[1]}), b = gelu_pk((f32x2){v0[2], v0[3]}), c = gelu_pk((f32x2){v1[0], v1[1]}), d = gelu_pk((f32x2){v1[2], v1[3]});
                        v0 = (f32x4){a.x, a.y, b.x, b.y}; v1 = (f32x4){c.x, c.y, d.x, d.y}; }
                    v0 = v0 * sc; v1 = v1 * sc; u32x4 w; w.x = cvt_pk_bf16(v0[0], v0[1]); w.y = cvt_pk_bf16(v0[2], v0[3]); w.z = cvt_pk_bf16(v1[0], v1[1]); w.w = cvt_pk_bf16(v1[2], v1[3]);
                    *(u32x4*)(rowp + bj * HALF) = w; } }
    }
};

typedef unsigned u32x2 __attribute__((ext_vector_type(2)));
__host__ __device__ __forceinline__ int perm16(int ko) { return 8 * ((ko >> 2) & 1) + (ko & 3) + 4 * (ko >> 3); }


constexpr size_t KF_SAMPLE = (size_t)32 * 16 * 256 * 128, KF_CACHE = KF_SAMPLE + (size_t)2 * 16 * 1024 * 128, KF_TOTAL = KF_CACHE + (size_t)2 * 16 * 512 * 128;
__host__ __device__ __forceinline__ size_t kf_off(int t, int d) { return (((size_t)((t >> 5) * 8 + (d >> 4)) * 64 + ((d >> 3) & 1) * 32 + (t & 31)) * 8 + (d & 7)); }
__host__ __device__ __forceinline__ size_t vtf_off(int t, int d) { const int ko32 = t & 31, ko = ko32 & 15; return ((((size_t)((t >> 5) * 2 + (ko32 >> 4)) * 4 + (d >> 5)) * 64 + ((ko >> 2) & 1) * 32 + (d & 31)) * 8 + (ko & 3) + 4 * (ko >> 3)); }
__host__ __device__ __forceinline__ size_t seq_base_row(int row, int h, int& t) { if (row < 8192) { t = row & 255; return (size_t)((row >> 8) * 16 + h) * 256 * 128; } const int rs = row - 8192; t = rs & 1023; return KF_SAMPLE + (size_t)((rs >> 10) * 16 + h) * 1024 * 128; }
__host__ __device__ __forceinline__ size_t seq_base_cache(int b, int h) { return KF_CACHE + (size_t)(b * 16 + h) * 512 * 128; }

struct EpiQKV {
    static constexpr bool PERM = true, AFTER_DRAIN = false, PERM_A = true;
    bf16_t* Q; bf16_t* Kf; bf16_t* VTf; float* nk; float* nv; float c2;
    __device__ __forceinline__ void operator()(const f32x4 (&acc)[2][2][4][2], const Unit& u, int wr, int wc, int fr, int fq) const {
        const int sec = u.pn >> 3, colt = (u.pn & 7) * BM;
        const int row0 = u.pm * BM + wr * 64 + 4 * fr, col0 = colt + wc * 32 + 8 * fq;
        const bool prompt = u.pm < 32;
        if (sec < 2) {
#pragma unroll
            for (int ai = 0; ai < 2; ++ai)
#pragma unroll
                for (int m = 0; m < 4; ++m) {
                    const int row = row0 + ai * HALF + m;
#pragma unroll
                    for (int bj = 0; bj < 2; ++bj) {
                        f32x4 v0 = acc[ai][bj][m][0], v1 = acc[ai][bj][m][1];
                        const int col = col0 + bj * HALF;
                        const size_t off = (size_t)row * 2048 + col;
                        if (sec == 0) {
                            v0 = v0 * c2; v1 = v1 * c2;
                            u32x4 w; w.x = cvt_pk_bf16(v0[0], v0[1]); w.y = cvt_pk_bf16(v0[2], v0[3]); w.z = cvt_pk_bf16(v1[0], v1[1]); w.w = cvt_pk_bf16(v1[2], v1[3]);
                            *(u32x4*)(Q + off) = w;
                        } else {
                            u32x4 w; w.x = cvt_pk_bf16(v0[0], v0[1]); w.y = cvt_pk_bf16(v0[2], v0[3]); w.z = cvt_pk_bf16(v1[0], v1[1]); w.w = cvt_pk_bf16(v1[2], v1[3]);
                            int t; const size_t sb = seq_base_row(row, col >> 7, t);
                            *(u32x4*)(Kf + sb + kf_off(t, col & 127)) = w;
                            if (prompt) { *(f32x4*)(nk + off) = v0; *(f32x4*)(nk + off + 4) = v1; }
                        }
                    }
                }
        } else {
#pragma unroll
            for (int ai = 0; ai < 2; ++ai)
#pragma unroll
                for (int bj = 0; bj < 2; ++bj) {
                    const int col = col0 + bj * HALF, rowq = row0 + ai * HALF;
                    if (prompt) {
#pragma unroll
                        for (int m = 0; m < 4; ++m) { const size_t off = (size_t)(rowq + m) * 2048 + col; *(f32x4*)(nv + off) = acc[ai][bj][m][0]; *(f32x4*)(nv + off + 4) = acc[ai][bj][m][1]; }
                    }
                    int t; const size_t sb = seq_base_row(rowq, col >> 7, t);
                    bf16_t* p = VTf + sb + vtf_off(t, col & 127);
#pragma unroll
                    for (int n = 0; n < 2; ++n)
#pragma unroll
                        for (int e2 = 0; e2 < 4; ++e2) {
                            u32x2 w; w.x = cvt_pk_bf16(acc[ai][bj][0][n][e2], acc[ai][bj][1][n][e2]); w.y = cvt_pk_bf16(acc[ai][bj][2][n][e2], acc[ai][bj][3][n][e2]);
                            *(u32x2*)(p + (4 * n + e2) * 8) = w;
                        }
                }
        }
    }
};

struct EpiRes {
    static constexpr bool PERM = false, AFTER_DRAIN = false;
    const float* baseP; const float* baseS; float* out; const float* gate;
    __device__ __forceinline__ void operator()(const f32x4 (&acc)[2][2][4][2], const Unit& u, int wr, int wc, int fr, int fq) const {
        const int cond = u.pm < 32 ? 0 : 1 + ((u.pm - 32) >> 2);
        const float* g = gate + cond * 12288; const float* base = u.pm < 32 ? baseP : baseS;
        const int row0 = u.pm * BM + wr * 64 + fr, col0 = u.pn * BM + wc * 32 + 4 * fq;
        f32x4 gv[2][2];
#pragma unroll
        for (int bj = 0; bj < 2; ++bj)
#pragma unroll
            for (int n = 0; n < 2; ++n) gv[bj][n] = *(const f32x4*)(g + col0 + bj * HALF + n * 16);
#pragma unroll
        for (int ai = 0; ai < 2; ++ai)
#pragma unroll
            for (int m = 0; m < 4; ++m) { const size_t off = (size_t)(row0 + ai * HALF + m * 16) * 2048 + col0;
#pragma unroll
                for (int bj = 0; bj < 2; ++bj)
#pragma unroll
                    for (int n = 0; n < 2; ++n) { const f32x4 bs = *(const f32x4*)(base + off + bj * HALF + n * 16); *(f32x4*)(out + off + bj * HALF + n * 16) = bs + gv[bj][n] * acc[ai][bj][m][n]; }
                if (m & 1) asm volatile("" ::: "memory"); }
    }
};

struct EpiGate {
    static constexpr bool PERM = true, AFTER_DRAIN = false;
    const bf16_t* Y; bf16_t* Y2;
    __device__ __forceinline__ void operator()(const f32x4 (&acc)[2][2][4][2], const Unit& u, int wr, int wc, int fr, int fq) const {
        const int row0 = u.pm * BM + wr * 64 + fr, col0 = u.pn * BM + wc * 32 + 8 * fq;
#pragma unroll
        for (int ai = 0; ai < 2; ++ai)
#pragma unroll
            for (int m = 0; m < 4; ++m) {
#pragma unroll
                for (int bj = 0; bj < 2; ++bj) {
                    const size_t off = (size_t)(row0 + ai * HALF + m * 16) * 2048 + col0 + bj * HALF;
                    const u32x4 yv = *(const u32x4*)(Y + off);
                    const f32x4 z0 = acc[ai][bj][m][0], z1 = acc[ai][bj][m][1];
                    float y[8], o[8];
                    y[0] = __uint_as_float(yv.x << 16); y[1] = __uint_as_float(yv.x & 0xffff0000u); y[2] = __uint_as_float(yv.y << 16); y[3] = __uint_as_float(yv.y & 0xffff0000u);
                    y[4] = __uint_as_float(yv.z << 16); y[5] = __uint_as_float(yv.z & 0xffff0000u); y[6] = __uint_as_float(yv.w << 16); y[7] = __uint_as_float(yv.w & 0xffff0000u);
#pragma unroll
                    for (int e = 0; e < 4; ++e) { o[e] = y[e] * __builtin_amdgcn_rcpf(1.0f + __builtin_amdgcn_exp2f(-1.4426950408889634f * z0[e])); o[4 + e] = y[4 + e] * __builtin_amdgcn_rcpf(1.0f + __builtin_amdgcn_exp2f(-1.4426950408889634f * z1[e])); }
                    u32x4 w; w.x = cvt_pk_bf16(o[0], o[1]); w.y = cvt_pk_bf16(o[2], o[3]); w.z = cvt_pk_bf16(o[4], o[5]); w.w = cvt_pk_bf16(o[6], o[7]);
                    *(u32x4*)(Y2 + off) = w;
                }
            }
    }
};


struct TailOrder {
    int G, c, q, r;
    __host__ __device__ void init(int K, int G_, int c_) { G = G_; c = c_; const int pairs = K / (2 * BK); q = pairs / 4; r = pairs % 4; }
    __host__ __device__ __forceinline__ bool next(int i, Unit& u) const {
        const int L = i * G + c; if (L >= 512) return false;
        const int Lf = L < 256 ? L : 255, w = (Lf % NXCD) * 32 + Lf / NXCD, nig = WGM * 8, fm = (w / nig) * WGM;
        const int fpm = fm + ((w % nig) % WGM), fpn = (w % nig) / WGM;
        const int j = L < 256 ? 0 : L - 256, tile = j >> 2, s = j & 3;
        const bool isf = L < 256;
        u.pm = isf ? fpm : 32 + (tile >> 3); u.pn = isf ? fpn : (tile & 7); u.sl = isf ? -1 : s;
        u.k0 = isf ? 0 : 2 * (s * q + (s < r ? s : r)); u.nk = isf ? 0 : 2 * (q + (s < r ? 1 : 0)); return true;
    }
    __device__ __forceinline__ void a_ready(const Unit&) const {}
    __device__ __forceinline__ void done(const Unit&) const {}
};
struct EpiRes2 {
    static constexpr bool PERM = false, AFTER_DRAIN = false;
    const float* baseP; float* out; const float* gate; float* slab;
    __device__ __forceinline__ void operator()(const f32x4 (&acc)[2][2][4][2], const Unit& u, int wr, int wc, int fr, int fq) const {
        const int row0 = u.pm * BM + wr * 64 + fr, col0 = u.pn * BM + wc * 32 + 4 * fq;
        if (u.sl < 0) {
            f32x4 gv[2][2];
#pragma unroll
            for (int bj = 0; bj < 2; ++bj)
#pragma unroll
                for (int n = 0; n < 2; ++n) gv[bj][n] = *(const f32x4*)(gate + col0 + bj * HALF + n * 16);
#pragma unroll
            for (int ai = 0; ai < 2; ++ai)
#pragma unroll
                for (int m = 0; m < 4; ++m) { const size_t off = (size_t)(row0 + ai * HALF + m * 16) * 2048 + col0;
#pragma unroll
                    for (int bj = 0; bj < 2; ++bj)
#pragma unroll
                        for (int n = 0; n < 2; ++n) { const f32x4 bs = *(const f32x4*)(baseP + off + bj * HALF + n * 16); *(f32x4*)(out + off + bj * HALF + n * 16) = bs + gv[bj][n] * acc[ai][bj][m][n]; }
                    if (m & 1) asm volatile("" ::: "memory"); }
        } else {
            float* sp = slab + (size_t)u.sl * 2048 * 2048;
#pragma unroll
            for (int ai = 0; ai < 2; ++ai)
#pragma unroll
                for (int m = 0; m < 4; ++m) { const size_t off = (size_t)(row0 - 8192 + ai * HALF + m * 16) * 2048 + col0;
#pragma unroll
                    for (int bj = 0; bj < 2; ++bj)
#pragma unroll
                        for (int n = 0; n < 2; ++n) *(f32x4*)(sp + off + bj * HALF + n * 16) = acc[ai][bj][m][n]; }
        }
    }
};


template <bool BASE_F32>
struct EpiRes3 {
    static constexpr bool PERM = true, AFTER_DRAIN = false;
    const void* baseP; bf16_t* out; const float* gate; bf16_t* slab;
    __device__ __forceinline__ void operator()(const f32x4 (&acc)[2][2][4][2], const Unit& u, int wr, int wc, int fr, int fq) const {
        const int row0 = u.pm * BM + wr * 64 + fr, col0 = u.pn * BM + wc * 32 + 8 * fq;
        if (u.sl < 0) {
            f32x4 gv[2][2];
#pragma unroll
            for (int bj = 0; bj < 2; ++bj)
#pragma unroll
                for (int n = 0; n < 2; ++n) gv[bj][n] = *(const f32x4*)(gate + col0 + bj * HALF + n * 4);
            if constexpr (!BASE_F32) {
                u32x4 bv[2][4][2];
#pragma unroll
                for (int ai = 0; ai < 2; ++ai)
#pragma unroll
                    for (int m = 0; m < 4; ++m)
#pragma unroll
                        for (int bj = 0; bj < 2; ++bj) bv[ai][m][bj] = *(const u32x4*)((const bf16_t*)baseP + (size_t)(row0 + ai * HALF + m * 16) * 2048 + col0 + bj * HALF);
                asm volatile("" ::: "memory");
#pragma unroll
                for (int ai = 0; ai < 2; ++ai)
#pragma unroll
                    for (int m = 0; m < 4; ++m) { const size_t off = (size_t)(row0 + ai * HALF + m * 16) * 2048 + col0;
#pragma unroll
                        for (int bj = 0; bj < 2; ++bj) { const u32x4 b = bv[ai][m][bj];
                            const f32x4 b0 = (f32x4){__uint_as_float(b.x << 16), __uint_as_float(b.x & 0xffff0000u), __uint_as_float(b.y << 16), __uint_as_float(b.y & 0xffff0000u)};
                            const f32x4 b1 = (f32x4){__uint_as_float(b.z << 16), __uint_as_float(b.z & 0xffff0000u), __uint_as_float(b.w << 16), __uint_as_float(b.w & 0xffff0000u)};
                            const f32x4 o0 = b0 + gv[bj][0] * acc[ai][bj][m][0], o1 = b1 + gv[bj][1] * acc[ai][bj][m][1];
                            u32x4 w; w.x = cvt_pk_bf16(o0[0], o0[1]); w.y = cvt_pk_bf16(o0[2], o0[3]); w.z = cvt_pk_bf16(o1[0], o1[1]); w.w = cvt_pk_bf16(o1[2], o1[3]);
                            *(u32x4*)(out + off + bj * HALF) = w; } }
            } else {
#pragma unroll
            for (int ai = 0; ai < 2; ++ai)
#pragma unroll
                for (int m = 0; m < 4; ++m) { const size_t off = (size_t)(row0 + ai * HALF + m * 16) * 2048 + col0;
#pragma unroll
                    for (int bj = 0; bj < 2; ++bj) {
                        const f32x4 b0 = *(const f32x4*)((const float*)baseP + off + bj * HALF), b1 = *(const f32x4*)((const float*)baseP + off + bj * HALF + 4);
                        const f32x4 o0 = b0 + gv[bj][0] * acc[ai][bj][m][0], o1 = b1 + gv[bj][1] * acc[ai][bj][m][1];
                        u32x4 w; w.x = cvt_pk_bf16(o0[0], o0[1]); w.y = cvt_pk_bf16(o0[2], o0[3]); w.z = cvt_pk_bf16(o1[0], o1[1]); w.w = cvt_pk_bf16(o1[2], o1[3]);
                        *(u32x4*)(out + off + bj * HALF) = w; }
                    if (m & 1) asm volatile("" ::: "memory"); }
            }
        } else {
            bf16_t* sp = slab + (size_t)u.sl * 2048 * 2048;
#pragma unroll
            for (int ai = 0; ai < 2; ++ai)
#pragma unroll
                for (int m = 0; m < 4; ++m) { const size_t off = (size_t)(row0 - 8192 + ai * HALF + m * 16) * 2048 + col0;
#pragma unroll
                    for (int bj = 0; bj < 2; ++bj) { const f32x4 v0 = acc[ai][bj][m][0], v1 = acc[ai][bj][m][1];
                        u32x4 w; w.x = cvt_pk_bf16(v0[0], v0[1]); w.y = cvt_pk_bf16(v0[2], v0[3]); w.z = cvt_pk_bf16(v1[0], v1[1]); w.w = cvt_pk_bf16(v1[2], v1[3]);
                        *(u32x4*)(sp + off + bj * HALF) = w; } }
        }
    }
};

struct EpiNull {
    static constexpr bool PERM = true, AFTER_DRAIN = false;
    __device__ __forceinline__ void operator()(const f32x4 (&acc)[2][2][4][2], const Unit& u, int wr, int wc, int fr, int fq) const {
#pragma unroll
        for (int a = 0; a < 2; ++a)
#pragma unroll
            for (int b = 0; b < 2; ++b)
#pragma unroll
                for (int m = 0; m < 4; ++m)
#pragma unroll
                    for (int n = 0; n < 2; ++n) asm volatile("" :: "v"(acc[a][b][m][n]));
    }
};

__host__ __device__ __forceinline__ size_t s5u_off(int m, int col) { const int g = col >> 4, hi = (col >> 3) & 1, rb = m >> 10, rem = m & 1023, row = rem >> 4, s = rem & 15, mb = row >> 5, r32 = row & 31;
    return ((((size_t)(g * 10 + rb) * 2 + mb) * 16 + s) * 64 + hi * 32 + r32) * 8 + (col & 7); }
struct EpiU {
    static constexpr bool PERM = true, AFTER_DRAIN = false;
    bf16_t* U;
    __device__ __forceinline__ void operator()(const f32x4 (&acc)[2][2][4][2], const Unit& u, int wr, int wc, int fr, int fq) const {
        const int row0 = u.pm * BM + wr * 64 + fr, col0 = u.pn * BM + wc * 32 + 8 * fq;
#pragma unroll
        for (int ai = 0; ai < 2; ++ai)
#pragma unroll
            for (int m = 0; m < 4; ++m)
#pragma unroll
                for (int bj = 0; bj < 2; ++bj) {
                    const f32x4 v0 = acc[ai][bj][m][0], v1 = acc[ai][bj][m][1];
                    u32x4 w; w.x = cvt_pk_bf16(v0[0], v0[1]); w.y = cvt_pk_bf16(v0[2], v0[3]); w.z = cvt_pk_bf16(v1[0], v1[1]); w.w = cvt_pk_bf16(v1[2], v1[3]);
                    *(u32x4*)(U + s5u_off(row0 + ai * HALF + m * 16, col0 + bj * HALF)) = w;
                }
    }
};

__host__ __device__ __forceinline__ int upw_row(int n) { return n < 5504 ? 256 * (n >> 7) + (n & 127) : 256 * ((n - 5504) >> 7) + 128 + ((n - 5504) & 127); }
__device__ __forceinline__ float dpp_ror1(float v) { return __int_as_float(__builtin_amdgcn_update_dpp(0, __float_as_int(v), 0x121, 0xF, 0xF, true)); }
__device__ __forceinline__ float dpp_ror15(float v) { return __int_as_float(__builtin_amdgcn_update_dpp(0, __float_as_int(v), 0x12F, 0xF, 0xF, true)); }
struct UpOrder {
    int G, c;
    __host__ __device__ void init(int G_, int c_) { G = G_; c = c_; }
    __host__ __device__ __forceinline__ bool next(int i, Unit& u) const {
        int strip = -1, k = 0, p = -1;
        if (G == 256) {
            if (c < 86) { if (i < 4) { strip = c; k = i; } else if (i < 7) p = (i - 4) * 86 + c; }
            else { const int q = 258 + (c - 86) + i * 170; if (q < 1376) p = q; }
        } else {
            const int ns = c < 86 ? (86 - c + G - 1) / G : 0;
            if (i < 4 * ns) { strip = c + (i >> 2) * G; k = i & 3; } else { const int q = c + (i - 4 * ns) * G; if (q < 1376) p = q; }
        }
        const bool isS = strip >= 0;
        u.pm = isS ? 32 + 4 * (strip / 43) + k : (p & 31); u.pn = isS ? strip % 43 : (p >> 5);
        return isS || p >= 0;
    }
    __device__ __forceinline__ void a_ready(const Unit&) const {}
    __device__ __forceinline__ void done(const Unit&) const {}
};
struct EpiConv {
    static constexpr bool PERM = true, AFTER_DRAIN = false, PERM_A = true;
    bf16_t* ACT; const float* cw; const float* cb; PG8_LAS float* X;
    __device__ __forceinline__ void operator()(const f32x4 (&acc)[2][2][4][2], const Unit& u, int wr, int wc, int fr, int fq) const {
        const int cl = wc * 32 + 8 * fq;
        const bool sample = u.pm >= 32; const int k = (u.pm - 32) & 3;
        const bool has_prev = sample && k > 0, has_next = sample && k < 3;
        PG8_LAS float* SVw = X + 2048 + (k & 1) * 512; const PG8_LAS float* SVr = X + 2048 + ((k & 1) ^ 1) * 512;
        const int f0 = u.pn * HALF + cl;
        f32x4 cwv[2][8];
        { const int f4 = f0;
            cwv[0][0] = *(const f32x4*)(cw + f4); cwv[0][1] = *(const f32x4*)(cw + 11008 + f4); cwv[0][2] = *(const f32x4*)(cw + 22016 + f4); cwv[0][3] = *(const f32x4*)(cb + f4);
            cwv[0][4] = *(const f32x4*)(cw + 5504 + f4); cwv[0][5] = *(const f32x4*)(cw + 11008 + 5504 + f4); cwv[0][6] = *(const f32x4*)(cw + 22016 + 5504 + f4); cwv[0][7] = *(const f32x4*)(cb + 5504 + f4); }
        if (fr == 0 || fr == 15) {
            const int fl = fr == 0 ? 0 : 1;
#pragma unroll
            for (int ai = 0; ai < 2; ++ai)
#pragma unroll
                for (int bj = 0; bj < 2; ++bj)
#pragma unroll
                    for (int n = 0; n < 2; ++n) *(PG8_LAS f32x4*)(X + ((2 * ai + wr) * 2 + fl) * 256 + bj * HALF + cl + 4 * n) = fr == 0 ? acc[ai][bj][0][n] : acc[ai][bj][3][n];
        }
        asm volatile("s_waitcnt lgkmcnt(0)" ::: "memory"); __builtin_amdgcn_s_barrier(); asm volatile("" ::: "memory");
        const size_t rowb = (size_t)u.pm * BM + wr * 64 + 4 * fr;
#pragma unroll
        for (int n = 0; n < 2; ++n) {
            const int f4 = f0 + 4 * n;
            const f32x4 w0g = cwv[n][0], w1g = cwv[n][1], w2g = cwv[n][2], bg = cwv[n][3], w0v = cwv[n][4], w1v = cwv[n][5], w2v = cwv[n][6], bv = cwv[n][7];
            const f32x4 z4 = {0.f, 0.f, 0.f, 0.f};
            if (has_prev && wr == 1 && fr == 15) {
                const f32x4 pg = *(const PG8_LAS f32x4*)(SVr + cl + 4 * n), pv = *(const PG8_LAS f32x4*)(SVr + HALF + cl + 4 * n), cg = *(const PG8_LAS f32x4*)(SVr + 256 + cl + 4 * n), cv = *(const PG8_LAS f32x4*)(SVr + 256 + HALF + cl + 4 * n);
                const f32x4 ng = *(const PG8_LAS f32x4*)(X + cl + 4 * n), nv = *(const PG8_LAS f32x4*)(X + HALF + cl + 4 * n);
                const f32x4 zg = w0g * pg + w1g * cg + w2g * ng + bg, zv = w0v * pv + w1v * cv + w2v * nv + bv;
                float o[4];
#pragma unroll
                for (int e2 = 0; e2 < 4; ++e2) o[e2] = zg[e2] * __builtin_amdgcn_rcpf(1.0f + __builtin_amdgcn_exp2f(-1.4426950408889634f * zg[e2])) * zv[e2];
                u32x2 w; w.x = cvt_pk_bf16(o[0], o[1]); w.y = cvt_pk_bf16(o[2], o[3]);
                *(u32x2*)(ACT + ((size_t)u.pm * BM - 1) * 5504 + f4) = w;
            }
#pragma unroll
            for (int ai = 0; ai < 2; ++ai) {
                const int q = 2 * ai + wr;
                if (n == 0 && ai == 1) { const int f4 = f0 + 4;
                    cwv[1][0] = *(const f32x4*)(cw + f4); cwv[1][1] = *(const f32x4*)(cw + 11008 + f4); cwv[1][2] = *(const f32x4*)(cw + 22016 + f4); cwv[1][3] = *(const f32x4*)(cb + f4);
                    cwv[1][4] = *(const f32x4*)(cw + 5504 + f4); cwv[1][5] = *(const f32x4*)(cw + 11008 + 5504 + f4); cwv[1][6] = *(const f32x4*)(cw + 22016 + 5504 + f4); cwv[1][7] = *(const f32x4*)(cb + 5504 + f4); }
                const f32x4 hpg = q > 0 ? *(const PG8_LAS f32x4*)(X + ((q - 1) * 2 + 1) * 256 + cl + 4 * n) : (has_prev ? *(const PG8_LAS f32x4*)(SVr + 256 + cl + 4 * n) : z4);
                const f32x4 hpv = q > 0 ? *(const PG8_LAS f32x4*)(X + ((q - 1) * 2 + 1) * 256 + HALF + cl + 4 * n) : (has_prev ? *(const PG8_LAS f32x4*)(SVr + 256 + HALF + cl + 4 * n) : z4);
                const f32x4 hng = q < 3 ? *(const PG8_LAS f32x4*)(X + ((q + 1) * 2 + 0) * 256 + cl + 4 * n) : z4, hnv = q < 3 ? *(const PG8_LAS f32x4*)(X + ((q + 1) * 2 + 0) * 256 + HALF + cl + 4 * n) : z4;
                const bool deferred = has_next && ai == 1 && wr == 1 && fr == 15;
                u32x2 ow[4];
#pragma unroll
                for (int p = 0; p < 2; ++p) {
                    const f32x2 x0 = p ? acc[ai][0][0][n].hi : acc[ai][0][0][n].lo, x1 = p ? acc[ai][0][1][n].hi : acc[ai][0][1][n].lo, x2 = p ? acc[ai][0][2][n].hi : acc[ai][0][2][n].lo, x3 = p ? acc[ai][0][3][n].hi : acc[ai][0][3][n].lo;
                    const f32x2 y0 = p ? acc[ai][1][0][n].hi : acc[ai][1][0][n].lo, y1 = p ? acc[ai][1][1][n].hi : acc[ai][1][1][n].lo, y2 = p ? acc[ai][1][2][n].hi : acc[ai][1][2][n].lo, y3 = p ? acc[ai][1][3][n].hi : acc[ai][1][3][n].lo;
                    const f32x2 hpg2 = p ? hpg.hi : hpg.lo, hpv2 = p ? hpv.hi : hpv.lo, hng2 = p ? hng.hi : hng.lo, hnv2 = p ? hnv.hi : hnv.lo;
                    f32x2 pg, pv, ng, nv;
                    pg.x = dpp_ror1(x3.x); pg.y = dpp_ror1(x3.y); pv.x = dpp_ror1(y3.x); pv.y = dpp_ror1(y3.y); ng.x = dpp_ror15(x0.x); ng.y = dpp_ror15(x0.y); nv.x = dpp_ror15(y0.x); nv.y = dpp_ror15(y0.y);
                    pg.x = fr == 0 ? hpg2.x : pg.x; pg.y = fr == 0 ? hpg2.y : pg.y; pv.x = fr == 0 ? hpv2.x : pv.x; pv.y = fr == 0 ? hpv2.y : pv.y;
                    ng.x = fr == 15 ? hng2.x : ng.x; ng.y = fr == 15 ? hng2.y : ng.y; nv.x = fr == 15 ? hnv2.x : nv.x; nv.y = fr == 15 ? hnv2.y : nv.y;
                    const f32x2 a0 = p ? w0g.hi : w0g.lo, a1 = p ? w1g.hi : w1g.lo, a2 = p ? w2g.hi : w2g.lo, ab = p ? bg.hi : bg.lo, c0 = p ? w0v.hi : w0v.lo, c1 = p ? w1v.hi : w1v.lo, c2 = p ? w2v.hi : w2v.lo, cbb = p ? bv.hi : bv.lo;
                    f32x2 zg[4], zv[4];
                    zg[0] = __builtin_elementwise_fma(pg, a0, __builtin_elementwise_fma(x1, a2, __builtin_elementwise_fma(x0, a1, ab)));
                    zg[1] = __builtin_elementwise_fma(x0, a0, __builtin_elementwise_fma(x2, a2, __builtin_elementwise_fma(x1, a1, ab)));
                    zg[2] = __builtin_elementwise_fma(x1, a0, __builtin_elementwise_fma(x3, a2, __builtin_elementwise_fma(x2, a1, ab)));
                    zg[3] = __builtin_elementwise_fma(x2, a0, __builtin_elementwise_fma(ng, a2, __builtin_elementwise_fma(x3, a1, ab)));
                    zv[0] = __builtin_elementwise_fma(pv, c0, __builtin_elementwise_fma(y1, c2, __builtin_elementwise_fma(y0, c1, cbb)));
                    zv[1] = __builtin_elementwise_fma(y0, c0, __builtin_elementwise_fma(y2, c2, __builtin_elementwise_fma(y1, c1, cbb)));
                    zv[2] = __builtin_elementwise_fma(y1, c0, __builtin_elementwise_fma(y3, c2, __builtin_elementwise_fma(y2, c1, cbb)));
                    zv[3] = __builtin_elementwise_fma(y2, c0, __builtin_elementwise_fma(nv, c2, __builtin_elementwise_fma(y3, c1, cbb)));
#pragma unroll
                    for (int m = 0; m < 4; ++m) {
                        const f32x2 ea = zg[m] * -1.4426950408889634f; f32x2 ex; ex.x = __builtin_amdgcn_exp2f(ea.x); ex.y = __builtin_amdgcn_exp2f(ea.y);
                        const f32x2 dn = ex + 1.0f; f32x2 rc; rc.x = __builtin_amdgcn_rcpf(dn.x); rc.y = __builtin_amdgcn_rcpf(dn.y);
                        const f32x2 o2 = (zg[m] * zv[m]) * rc;
                        const unsigned pk = cvt_pk_bf16(o2.x, o2.y); if (p == 0) ow[m].x = pk; else ow[m].y = pk;
                    }
                }
                if (ai == 1) { if (deferred) { *(PG8_LAS f32x4*)(SVw + cl + 4 * n) = acc[1][0][2][n]; *(PG8_LAS f32x4*)(SVw + HALF + cl + 4 * n) = acc[1][1][2][n]; *(PG8_LAS f32x4*)(SVw + 256 + cl + 4 * n) = acc[1][0][3][n]; *(PG8_LAS f32x4*)(SVw + 256 + HALF + cl + 4 * n) = acc[1][1][3][n]; } }
#pragma unroll
                for (int m = 0; m < 4; ++m) if (!(deferred && m == 3)) *(u32x2*)(ACT + (rowb + ai * HALF + m) * 5504 + f4) = ow[m];
            }
        }
    }
};
template <class E, class = void> struct epi_perm_a { static constexpr bool v = false; };
template <class E> struct epi_perm_a<E, decltype((void)E::PERM_A)> { static constexpr bool v = E::PERM_A; };
template <class Epi, class Sched, bool ALIGN_EPI = false, bool SP2 = false>
__device__ __forceinline__ void gemm_phase(PG8_LAS unsigned char* lds, const Gemm g, const Sched& S, const Epi& E, const int tid) {
    const int wid = __builtin_amdgcn_readfirstlane(tid >> 6), lane = tid & 63, wr = wid >> 2, wc = wid & 3, fr = lane & 15, fq = lane >> 4;
    const int K = g.K, nt = K / BK;
    unsigned voffA[2], voffB[2];
#pragma unroll
    for (int i = 0; i < 2; ++i) { int R, C; stage_rc(tid * 16 + i * 8192, R, C); const int Rb = Epi::PERM ? ((R & ~31) + perm32(R & 31)) : R;
        const int Ra = epi_perm_a<Epi>::v ? ((R & 64) + 4 * (R & 15) + ((R >> 4) & 3)) : R;
        voffA[i] = (unsigned)(Ra * K + C) * 2u; voffB[i] = (unsigned)(Rb * K + C) * 2u; }
    const size_t kstep = (size_t)(BK * 2);
    const size_t hstep = (size_t)HALF * K * 2;
    const size_t tstep = 2 * hstep;
    const unsigned ldsw = (unsigned)wid * 1024u;
    const int aoff = lds_byte(wr * 64 + fr, fq * 8), boff = lds_byte(wc * 32 + fr, fq * 8);
#define PG8_SA(b, h) (((b) * 2 + (h)) * HTB)
#define PG8_SB(b, h) ((4 + (b) * 2 + (h)) * HTB)
#define PG8_STAGE(bufoff, gbase, voff) do { _Pragma("unroll") for (int _i = 0; _i < 2; ++_i) \
        __builtin_amdgcn_global_load_lds((const unsigned*)((const char*)(gbase) + (voff)[_i]), (PG8_LAS unsigned*)(lds + (bufoff) + ldsw + _i * 8192), 16, 0, 0); } while (0)
#define PG8_LDA(dst, b, h) do { _Pragma("unroll") for (int m = 0; m < 4; ++m) _Pragma("unroll") for (int k = 0; k < 2; ++k) dst[m][k] = *(const PG8_LAS bf16x8*)(lds + PG8_SA(b, h) + aoff + m * 2048 + k * 1024); } while (0)
#define PG8_LDB(dst, b, h) do { _Pragma("unroll") for (int n = 0; n < 2; ++n) _Pragma("unroll") for (int k = 0; k < 2; ++k) dst[n][k] = *(const PG8_LAS bf16x8*)(lds + PG8_SB(b, h) + boff + n * 2048 + k * 1024); } while (0)
#define PG8_MMA(ai, bj, At, Bt) do { __builtin_amdgcn_s_setprio(1); _Pragma("unroll") for (int m = 0; m < 4; ++m) _Pragma("unroll") for (int n = 0; n < 2; ++n) _Pragma("unroll") for (int k = 0; k < 2; ++k) \
        acc[ai][bj][m][n] = __builtin_amdgcn_mfma_f32_16x16x32_bf16(Bt[n][k], At[m][k], acc[ai][bj][m][n], 0, 0, 0); __builtin_amdgcn_s_setprio(0); } while (0)
#define PG8_WAIT_V(n) asm volatile("s_waitcnt vmcnt(" #n ")" ::: "memory")
#define PG8_WAIT_L(n) asm volatile("s_waitcnt lgkmcnt(" #n ")" ::: "memory")
#define PG8_BAR __builtin_amdgcn_s_barrier()
#define PG8_SCHED __builtin_amdgcn_sched_barrier(0)
    Unit cur, nxt; int ui = 0;
    if (!S.next(0, cur)) return;
    f32x4 acc[2][2][4][2];
#pragma unroll
    for (int a = 0; a < 2; ++a)
#pragma unroll
        for (int b = 0; b < 2; ++b)
#pragma unroll
            for (int m = 0; m < 4; ++m)
#pragma unroll
                for (int n = 0; n < 2; ++n) acc[a][b][m][n] = (f32x4){0.f, 0.f, 0.f, 0.f};
    bf16x8 At[4][2], B0[2][2], B1[2][2];
    const char* cA = (const char*)g.A + (size_t)cur.pm * tstep + (size_t)cur.k0 * kstep; const char* cB = (const char*)g.Bt + (size_t)cur.pn * tstep + (size_t)cur.k0 * kstep;
    S.a_ready(cur);
    if constexpr (SP2) {
        PG8_STAGE(PG8_SB(0, 0), cB, voffB); PG8_STAGE(PG8_SB(0, 1), cB + hstep, voffB); PG8_STAGE(PG8_SA(0, 0), cA, voffA); PG8_STAGE(PG8_SA(0, 1), cA + hstep, voffA);
        if (wr == 1) PG8_BAR;
        PG8_WAIT_V(2); PG8_BAR;
        PG8_STAGE(PG8_SB(1, 0), cB + kstep, voffB); PG8_STAGE(PG8_SA(1, 0), cA + kstep, voffA); PG8_STAGE(PG8_SB(1, 1), cB + hstep + kstep, voffB);
        PG8_WAIT_V(6); PG8_BAR;
    } else {
        PG8_STAGE(PG8_SB(0, 0), cB, voffB); PG8_STAGE(PG8_SA(0, 0), cA, voffA); PG8_STAGE(PG8_SB(0, 1), cB + hstep, voffB); PG8_STAGE(PG8_SA(0, 1), cA + hstep, voffA);
        if (wr == 1) PG8_BAR;
        PG8_WAIT_V(4); PG8_BAR;
        PG8_STAGE(PG8_SB(1, 0), cB + kstep, voffB); PG8_STAGE(PG8_SA(1, 0), cA + kstep, voffA); PG8_STAGE(PG8_SB(1, 1), cB + hstep + kstep, voffB);
        PG8_WAIT_V(6); PG8_BAR;
    }
    for (;;) {
        const bool has_next = S.next(ui + 1, nxt);
        const char* nA = has_next ? (const char*)g.A + (size_t)nxt.pm * tstep + (size_t)nxt.k0 * kstep : cA; const char* nB = has_next ? (const char*)g.Bt + (size_t)nxt.pn * tstep + (size_t)nxt.k0 * kstep : cB;
        const int cnt = cur.nk ? cur.nk : nt;
        for (int t = 0; t < cnt; t += 2) {
            const bool last = (t == cnt - 2);
            const char* a1 = cA + (size_t)(t + 1) * kstep;
            const char* a2 = last ? nA : cA + (size_t)(t + 2) * kstep; const char* b2 = last ? nB : cB + (size_t)(t + 2) * kstep;
            const char* a3 = a2 + kstep; const char* b3 = b2 + kstep;
            if (last && has_next) S.a_ready(nxt);
            if constexpr (SP2) {
            PG8_LDB(B0, 0, 0); PG8_LDB(B1, 0, 1); PG8_SCHED; PG8_LDA(At, 0, 0); PG8_STAGE(PG8_SA(1, 1), a1 + hstep, voffA);
            PG8_WAIT_V(8); PG8_WAIT_L(0); PG8_BAR; PG8_MMA(0, 0, At, B0); PG8_MMA(0, 1, At, B1); PG8_BAR; PG8_SCHED;
            PG8_LDA(At, 0, 1); PG8_STAGE(PG8_SB(0, 0), b2, voffB); PG8_STAGE(PG8_SB(0, 1), b2 + hstep, voffB); PG8_STAGE(PG8_SA(0, 0), a2, voffA);
            PG8_WAIT_V(8); PG8_WAIT_L(0); PG8_BAR; PG8_MMA(1, 0, At, B0); PG8_MMA(1, 1, At, B1); PG8_BAR; PG8_SCHED;
            PG8_LDB(B0, 1, 0); PG8_LDB(B1, 1, 1); PG8_SCHED; PG8_LDA(At, 1, 0); PG8_STAGE(PG8_SA(0, 1), a2 + hstep, voffA);
            PG8_WAIT_V(8); PG8_WAIT_L(0); PG8_BAR; PG8_MMA(0, 0, At, B0); PG8_MMA(0, 1, At, B1); PG8_BAR; PG8_SCHED;
            PG8_LDA(At, 1, 1); PG8_STAGE(PG8_SB(1, 0), b3, voffB); PG8_STAGE(PG8_SB(1, 1), b3 + hstep, voffB); PG8_STAGE(PG8_SA(1, 0), a3, voffA);
            PG8_WAIT_V(8); PG8_WAIT_L(0); PG8_BAR; PG8_MMA(1, 0, At, B0); PG8_MMA(1, 1, At, B1); PG8_BAR; PG8_SCHED;
            } else {
            PG8_LDB(B0, 0, 0); PG8_SCHED; PG8_LDA(At, 0, 0); PG8_STAGE(PG8_SA(1, 1), a1 + hstep, voffA);
            PG8_WAIT_L(8); PG8_BAR; PG8_WAIT_L(0); PG8_MMA(0, 0, At, B0); PG8_BAR; PG8_SCHED;
            PG8_LDB(B1, 0, 1); PG8_STAGE(PG8_SB(0, 0), b2, voffB);
            PG8_BAR; PG8_WAIT_L(0); PG8_MMA(0, 1, At, B1); PG8_BAR;
            PG8_LDA(At, 0, 1); PG8_STAGE(PG8_SA(0, 0), a2, voffA);
            PG8_BAR; PG8_WAIT_L(0); PG8_MMA(1, 0, At, B0); PG8_BAR; PG8_SCHED;
            PG8_STAGE(PG8_SB(0, 1), b2 + hstep, voffB);
            PG8_WAIT_V(6); PG8_BAR; PG8_MMA(1, 1, At, B1); PG8_BAR;
            PG8_LDB(B0, 1, 0); PG8_SCHED; PG8_LDA(At, 1, 0); PG8_STAGE(PG8_SA(0, 1), a2 + hstep, voffA);
            PG8_WAIT_L(8); PG8_BAR; PG8_WAIT_L(0); PG8_MMA(0, 0, At, B0); PG8_BAR; PG8_SCHED;
            PG8_LDB(B1, 1, 1); PG8_STAGE(PG8_SB(1, 0), b3, voffB);
            PG8_BAR; PG8_WAIT_L(0); PG8_MMA(0, 1, At, B1); PG8_BAR;
            PG8_LDA(At, 1, 1); PG8_STAGE(PG8_SA(1, 0), a3, voffA);
            PG8_BAR; PG8_WAIT_L(0); PG8_MMA(1, 0, At, B0); PG8_BAR; PG8_SCHED;
            PG8_STAGE(PG8_SB(1, 1), b3 + hstep, voffB);
            PG8_WAIT_V(6); PG8_BAR; PG8_MMA(1, 1, At, B1); PG8_BAR;
            }
        }
        if constexpr (ALIGN_EPI) { if (wr == 0) PG8_BAR; }
        if constexpr (!Epi::AFTER_DRAIN) { E(acc, cur, wr, wc, fr, fq); S.done(cur); }
        if (!has_next) break;
#pragma unroll
        for (int a = 0; a < 2; ++a)
#pragma unroll
            for (int b = 0; b < 2; ++b)
#pragma unroll
                for (int m = 0; m < 4; ++m)
#pragma unroll
                    for (int n = 0; n < 2; ++n) acc[a][b][m][n] = (f32x4){0.f, 0.f, 0.f, 0.f};
        cur = nxt; cA = nA; cB = nB; ++ui;
        if constexpr (ALIGN_EPI) { if (wr == 1) PG8_BAR; }
    }
    PG8_WAIT_V(0);
    if constexpr (!ALIGN_EPI) { if (wr == 0) PG8_BAR; }
    PG8_BAR;
    if constexpr (Epi::AFTER_DRAIN) { E.fused(acc, cur, wr, wc, fr, fq, lds, wid, lane); S.done(cur); }
#undef PG8_SA
#undef PG8_SB
#undef PG8_STAGE
#undef PG8_LDA
#undef PG8_LDB
#undef PG8_MMA
#undef PG8_WAIT_V
#undef PG8_WAIT_L
#undef PG8_BAR
#undef PG8_SCHED
}
}
#define GAS __attribute__((address_space(1)))
#define LAS __attribute__((address_space(3)))
typedef unsigned short bf16;
typedef unsigned v4u __attribute__((ext_vector_type(4)));
typedef float f32x4 __attribute__((ext_vector_type(4)));
typedef short bf16x8 __attribute__((ext_vector_type(8)));
typedef GAS unsigned gu32;
typedef GAS unsigned long long gu64;
#define RLX_AGENT __ATOMIC_RELAXED, __HIP_MEMORY_SCOPE_AGENT
#define LDS_WAIT() asm volatile("s_waitcnt lgkmcnt(0)" ::: "memory")
#define VM_WAIT() asm volatile("s_waitcnt vmcnt(0)" ::: "memory")
__device__ __forceinline__ unsigned long long rt() { return __builtin_amdgcn_s_memrealtime(); }
__device__ __forceinline__ unsigned f2bf(float f) { unsigned u = __builtin_bit_cast(unsigned, f); return (u + 0x7fffu + ((u >> 16) & 1u)) >> 16; }
__device__ __forceinline__ unsigned pk2(float lo, float hi) { return f2bf(lo) | (f2bf(hi) << 16); }

#define XB_TMO      128
#define XB_XCNT(j)  (256  + 64 * (j))
#define XB_XSUB(j)  (1280 + 64 * (j))
#define XB_XGEN(j)  (2304 + 64 * (j))
#define XB_TOP      3328
#define XB_TOPGEN   3392
#define XCD_BAR_WORDS 3456
#define XB_SPIN_CAP (1u << 18)

__device__ __forceinline__ unsigned xb_ld(unsigned* p)              { return __hip_atomic_load(p, __ATOMIC_RELAXED, __HIP_MEMORY_SCOPE_AGENT); }
__device__ __forceinline__ unsigned xb_add(unsigned* p, unsigned v) { return __hip_atomic_fetch_add(p, v, __ATOMIC_RELAXED, __HIP_MEMORY_SCOPE_AGENT); }
__device__ __forceinline__ unsigned xb_xcc_id() { return (unsigned)__builtin_amdgcn_s_getreg((3 << 11) | 20) & 0xFu; }
#define XB_SPIN(cond, bar) do { unsigned _sp = 0; while (cond) { __builtin_amdgcn_s_sleep(1); \
    if ((++_sp & 255u) == 0u) { if (xb_ld(&(bar)[XB_TMO])) break; if (_sp > XB_SPIN_CAP) { atomicAdd(&(bar)[XB_TMO], 1u); break; } } } } while (0)

struct XcdBarrier {
    unsigned* bar; unsigned x;
    volatile LAS unsigned* st;
};

__device__ __forceinline__ XcdBarrier xcd_barrier_post(unsigned* bar, volatile LAS unsigned* st) {
    XcdBarrier b; b.bar = bar; b.x = xb_xcc_id(); b.st = st;
    if (threadIdx.x == 0) (void)xb_add(&bar[XB_XCNT(b.x)], 1u);
    return b;
}
__device__ __forceinline__ void xcd_barrier_complete(unsigned* bar, unsigned x, unsigned& nloc, unsigned& nx) {
    const unsigned G = gridDim.x * gridDim.y * gridDim.z;
    unsigned sum, cnt, mine, sp = 0u;
    for (;;) {
        sum = 0u; cnt = 0u; mine = 0u;
#pragma unroll
        for (unsigned j = 0; j < 16; ++j) { const unsigned c = xb_ld(&bar[XB_XCNT(j)]); sum += c; cnt += (c > 0u) ? 1u : 0u; mine = (j == x) ? c : mine; }
        if (sum == G) break;
        __builtin_amdgcn_s_sleep(1);
        if ((++sp & 255u) == 0u) { if (xb_ld(&bar[XB_TMO])) break; if (sp > XB_SPIN_CAP) { atomicAdd(&bar[XB_TMO], 1u); break; } }
    }
    nloc = mine > 0u ? mine : 1u; nx = cnt > 0u ? cnt : 1u;
}

__device__ __forceinline__ void xcd_barrier(const XcdBarrier& b) {
    asm volatile("s_waitcnt vmcnt(0)" ::: "memory");
    __syncthreads();
    if (threadIdx.x == 0) {
        unsigned* bar = b.bar;
        __builtin_amdgcn_s_waitcnt(0);
        unsigned nloc = b.st[0], nx = b.st[1];
        if (nloc == 0u) { xcd_barrier_complete(bar, b.x, nloc, nx); b.st[0] = nloc; b.st[1] = nx; }
        const unsigned old = xb_add(&bar[XB_XSUB(b.x)], 1u);
        const unsigned gen = old / nloc;
        if (old + 1u == (gen + 1u) * nloc) {
            __builtin_amdgcn_fence(__ATOMIC_RELEASE, "agent");
            asm volatile("s_waitcnt vmcnt(0)" ::: "memory");
            const unsigned og = xb_add(&bar[XB_TOP], 1u);
            const unsigned tg = og / nx;
            if (og + 1u == (tg + 1u) * nx) xb_add(&bar[XB_TOPGEN], 1u);
            else XB_SPIN(xb_ld(&bar[XB_TOPGEN]) == tg, bar);
            __builtin_amdgcn_fence(__ATOMIC_ACQUIRE, "agent");
            xb_add(&bar[XB_XGEN(b.x)], 1u);
            asm volatile("s_waitcnt vmcnt(0)" ::: "memory");
        } else {
            XB_SPIN(xb_ld(&bar[XB_XGEN(b.x)]) == gen, bar);
            __builtin_amdgcn_fence(__ATOMIC_ACQUIRE, "agent");
            asm volatile("s_waitcnt vmcnt(0)" ::: "memory");
        }
    }
    __syncthreads();
}
constexpr int D = 2048, NH = 16, HD = 128, FF = 5504, F2 = 11008, MP = 8192, MS = 2048, M = 10240;
constexpr int SEQ = 256, DSEQ = 1024, PAST = 512, NG = 128, GC = 16, SP = 64;
constexpr float NORM_EPS = 1e-6f;
constexpr float LOG2E = 1.4426950408889634f;
constexpr float C2 = 0.08838834764831845f * 1.4426950408889634f;
constexpr int NWAVES = 8, NTHR = 512;
enum { I_XP = 0, I_XS, I_CK, I_CV, I_SRE, I_SIM, I_C, I_CCTX, I_ADAW, I_ADAB, I_N1G, I_N2G, I_WQKV, I_RPB, I_WO, I_WIN, I_ARE, I_AIM, I_LOGDT, I_BRE, I_BIM, I_CRE, I_CIM, I_SD, I_WGATE, I_WOUT, I_WUP, I_CONVW, I_CONVB, I_WDN, I_FG, N_IN };

struct Args;
typedef const __attribute__((address_space(4))) unsigned char* kseg_t;
__device__ __forceinline__ const float* ARG_IN(int i) { kseg_t k = (kseg_t)__builtin_amdgcn_kernarg_segment_ptr(); return *(const float* const volatile __attribute__((address_space(4)))*)(k + 8 * i); }
__device__ __forceinline__ float* ARG_OUT() { kseg_t k = (kseg_t)__builtin_amdgcn_kernarg_segment_ptr(); return *(float* const volatile __attribute__((address_space(4)))*)(k + 8 * N_IN); }
__device__ __forceinline__ int ARG_I32(int i) { kseg_t k = (kseg_t)__builtin_amdgcn_kernarg_segment_ptr(); return *(const volatile __attribute__((address_space(4))) int*)(k + 8 * N_IN + 16 + 4 * i); }
__device__ __forceinline__ unsigned char* ARG_WS() { kseg_t k = (kseg_t)__builtin_amdgcn_kernarg_segment_ptr(); return *(unsigned char* const volatile __attribute__((address_space(4)))*)(k + 8 * N_IN + 8); }
constexpr size_t O_Y = 0, O_NK = (size_t)M * D, O_NV = O_NK + (size_t)MP * D, O_SRE = O_NV + (size_t)MP * D, O_SIM = O_SRE + 32 * 2 * 128 * 64, O_END = O_SIM + 32 * 2 * 128 * 64;

constexpr size_t MiB = 1u << 20, KiB = 1u << 10;
constexpr size_t WS_CTL = 0, CTL_ZERO_BYTES = 1 * MiB;
constexpr size_t WS_MOD = 256 * KiB;
constexpr size_t WS_DBG = 768 * KiB;
constexpr size_t WS_WQKV = 1 * MiB, WS_WO = 25 * MiB, WS_WIN = 33 * MiB, WS_WGATE = 41 * MiB, WS_WOUT = 49 * MiB;
constexpr size_t WS_WUP0 = 57 * MiB, WS_WUP1 = 100 * MiB, WS_WDN0 = 143 * MiB, WS_WDN1 = 143 * MiB + 22016 * KiB;
constexpr size_t WS_X1 = 186 * MiB, WS_HB = 266 * MiB, WS_S = 306 * MiB;
constexpr size_t WS_Q = WS_S, WS_KF = WS_S + 40 * MiB, WS_VTF = WS_S + 84 * MiB, WS_O = WS_S + 128 * MiB;
constexpr size_t WS_UP = WS_S, WS_ACT = WS_S + 215 * MiB;
constexpr size_t WS_U = WS_S, WS_Y = WS_S + 40 * MiB, WS_Y2 = WS_S + 80 * MiB, WS_S5W = WS_S + 120 * MiB;
constexpr size_t WS_SLAB = WS_S + 323 * MiB;
constexpr size_t WS_END = WS_SLAB + 64 * MiB;
static_assert(WS_WDN1 + (size_t)D * FF * 2 <= WS_X1 && WS_WUP0 + (size_t)F2 * D * 2 <= WS_WUP1 && WS_WUP1 + (size_t)F2 * D * 2 <= WS_WDN0 && WS_WDN0 + (size_t)D * FF * 2 <= WS_WDN1, "weight map");
static_assert(WS_UP + (size_t)M * F2 * 2 <= WS_ACT && WS_ACT + (size_t)M * FF * 2 <= WS_END && WS_O + (size_t)M * D * 2 <= WS_END && WS_S5W + (size_t)NG * 3 * 131072 <= WS_END, "scratch map");
constexpr int CW_BAR = 4096;

constexpr int RING_BYTES = 131072, LDSCTL_OFF = RING_BYTES, MISC_OFF = LDSCTL_OFF + 320, XCH_OFF = LDSCTL_OFF + 1024  , KFB_OFF = XCH_OFF  , LDS_BYTES = 155648;

typedef float f32x16 __attribute__((ext_vector_type(16)));
typedef unsigned u32x2 __attribute__((ext_vector_type(2)));
__device__ __forceinline__ unsigned cvtpk(float lo, float hi) { unsigned r; asm volatile("v_cvt_pk_bf16_f32 %0, %1, %2" : "=v"(r) : "v"(lo), "v"(hi)); return r; }
__device__ __forceinline__ float bf_lo(unsigned w) { return __uint_as_float(w << 16); }
__device__ __forceinline__ float bf_hi(unsigned w) { return __uint_as_float(w & 0xffff0000u); }
__device__ __forceinline__ float wave_sum(float v) {
#pragma unroll
    for (int o = 1; o < 64; o <<= 1) v += __shfl_xor(v, o);
    return v;
}
__device__ __forceinline__ float silu_f(float x) { return x / (1.0f + __expf(-x)); }
__device__ __forceinline__ float gelu_tanh(float x) {
    const float z = 0.7978845608028654f * (x + 0.044715f * x * x * x);
    return x * __builtin_amdgcn_rcpf(1.0f + __builtin_amdgcn_exp2f(-2.0f * LOG2E * z));
}

__device__ __forceinline__ void p0_ada(LAS unsigned char* lds, const float* adaw, const float* adab, const float* cctx, const float* cs, float* mod, int tid, int wave, int lane) {
    LAS float* red = (LAS float*)lds;
    for (int it = blockIdx.x; it < 1536; it += gridDim.x) {
        const int l = it / 768, r = it % 768, cb = r >> 4, ks = r & 15;
        const float* W = adaw + (size_t)l * 2048 * 12288 + cb * 256 + lane * 4;
        const int k0 = ks * 128 + wave * 16;
        f32x4 a0 = {0.f, 0.f, 0.f, 0.f}, a1 = a0, a2 = a0;
        f32x4 wv[16];
#pragma unroll
        for (int i = 0; i < 16; ++i) wv[i] = *(const f32x4*)(W + (size_t)(k0 + i) * 12288);
#pragma unroll
        for (int i = 0; i < 16; ++i) {
            const int k = k0 + i;
            const float s0 = silu_f(cctx[k]), s1 = silu_f(cs[k]), s2 = silu_f(cs[2048 + k]);
            a0 += wv[i] * s0; a1 += wv[i] * s1; a2 += wv[i] * s2;
        }
        *(LAS f32x4*)(red + (wave * 3 + 0) * 256 + lane * 4) = a0;
        *(LAS f32x4*)(red + (wave * 3 + 1) * 256 + lane * 4) = a1;
        *(LAS f32x4*)(red + (wave * 3 + 2) * 256 + lane * 4) = a2;
        __syncthreads();
        for (int idx = tid; idx < 768; idx += NTHR) {
            const int cond = idx >> 8, col = idx & 255;
            float s = 0.f;
#pragma unroll
            for (int w = 0; w < 8; ++w) s += red[(w * 3 + cond) * 256 + col];
            if (ks == 0) s += adab[l * 12288 + cb * 256 + col];
            atomicAdd(mod + (size_t)(l * 3 + cond) * 12288 + cb * 256 + col, s);
        }
        __syncthreads();
    }
}
template <bool UPW = false>
__device__ __forceinline__ void p0_transpose_item(const float* W, int K, int N, bf16* WT, LAS float* scr, int item, int lane) {
    const int nblk = N / 32, kb = item / nblk, nb = item % nblk, k0 = 64 * kb, n0 = 32 * nb, r0 = UPW ? pg8::upw_row(n0) : n0;
    f32x4 v[8];
#pragma unroll
    for (int i = 0; i < 8; ++i) v[i] = *(const f32x4*)(W + (size_t)(k0 + 8 * i + (lane >> 3)) * N + n0 + (lane & 7) * 4);
#pragma unroll
    for (int i = 0; i < 8; ++i) { LAS float* d = scr + (8 * i + (lane >> 3)) * 33 + (lane & 7) * 4; d[0] = v[i].x; d[1] = v[i].y; d[2] = v[i].z; d[3] = v[i].w; }
    LDS_WAIT(); asm volatile("" ::: "memory");
    const int c = lane & 7;
#pragma unroll
    for (int j = 0; j < 4; ++j) { const int n = (lane >> 3) + 8 * j; const LAS float* s = scr + (8 * c) * 33 + n;
        v4u o; o.x = pk2(s[0 * 33], s[1 * 33]); o.y = pk2(s[2 * 33], s[3 * 33]); o.z = pk2(s[4 * 33], s[5 * 33]); o.w = pk2(s[6 * 33], s[7 * 33]);
        *(GAS v4u*)(WT + (size_t)(r0 + n) * K + k0 + 8 * c) = o; }
    LDS_WAIT(); asm volatile("" ::: "memory");
}
__device__ __forceinline__ void p0_weights(LAS unsigned char* lds, unsigned char* ws, int gw, int NGW, int wave, int lane, int it_lo = 0, int it_hi = 47360) {
    LAS float* scr = (LAS float*)(lds + wave * 16384);
    constexpr int I_QKV = 32 * 192, I_SQ = 32 * 64, I_UP = 32 * 344, I_DN = 86 * 64;
    for (int it = it_lo + gw; it < it_hi; it += NGW) {
        int r = it;
        if (r < I_QKV) { p0_transpose_item(ARG_IN(I_WQKV), D, 3 * D, (bf16*)(ws + WS_WQKV), scr, r, lane); continue; } r -= I_QKV;
        if (r < I_SQ) { p0_transpose_item(ARG_IN(I_WO), D, D, (bf16*)(ws + WS_WO), scr, r, lane); continue; } r -= I_SQ;
        if (r < I_SQ) { p0_transpose_item(ARG_IN(I_WIN), D, D, (bf16*)(ws + WS_WIN), scr, r, lane); continue; } r -= I_SQ;
        if (r < I_SQ) { p0_transpose_item(ARG_IN(I_WGATE), D, D, (bf16*)(ws + WS_WGATE), scr, r, lane); continue; } r -= I_SQ;
        if (r < I_SQ) { p0_transpose_item(ARG_IN(I_WOUT), D, D, (bf16*)(ws + WS_WOUT), scr, r, lane); continue; } r -= I_SQ;
        if (r < I_UP) { p0_transpose_item<true>(ARG_IN(I_WUP), D, F2, (bf16*)(ws + WS_WUP0), scr, r, lane); continue; } r -= I_UP;
        if (r < I_UP) { p0_transpose_item<true>(ARG_IN(I_WUP) + (size_t)D * F2, D, F2, (bf16*)(ws + WS_WUP1), scr, r, lane); continue; } r -= I_UP;
        if (r < I_DN) { p0_transpose_item(ARG_IN(I_WDN), FF, D, (bf16*)(ws + WS_WDN0), scr, r, lane); continue; } r -= I_DN;
        p0_transpose_item(ARG_IN(I_WDN) + (size_t)FF * D, FF, D, (bf16*)(ws + WS_WDN1), scr, r, lane);
    }
}
__device__ __forceinline__ void p0_cache(const float* ck, const float* cv, bf16* Kf, bf16* VTf, int gtid, int NGT) {
    for (int i = gtid; i < 2 * 512 * 256; i += NGT) {
        const size_t e = (size_t)i * 8;
        const int bt = i >> 8, col = (i & 255) * 8, bb = bt >> 9, t = bt & 511, h = col >> 7, d0 = col & 127;
        const size_t sb = pg8::seq_base_cache(bb, h);
        const f32x4 a = *(const f32x4*)(ck + e), b = *(const f32x4*)(ck + e + 4);
        const f32x4 c = *(const f32x4*)(cv + e), d = *(const f32x4*)(cv + e + 4);
        v4u o; o.x = pk2(a.x, a.y); o.y = pk2(a.z, a.w); o.z = pk2(b.x, b.y); o.w = pk2(b.z, b.w);
        *(v4u*)(Kf + sb + pg8::kf_off(t, d0)) = o;
        bf16* p = VTf + sb + pg8::vtf_off(t, d0);
        p[0] = (bf16)f2bf(c.x); p[8] = (bf16)f2bf(c.y); p[16] = (bf16)f2bf(c.z); p[24] = (bf16)f2bf(c.w);
        p[32] = (bf16)f2bf(d.x); p[40] = (bf16)f2bf(d.y); p[48] = (bf16)f2bf(d.z); p[56] = (bf16)f2bf(d.w);
    }
}

__device__ __forceinline__ void norm_rows(const float* xa, const float* xb, const float* g, const float* modl, int jshift, int jscale, bf16* out, int gw, int NGW, int lane,
                                          const float* slab = nullptr, const float* gatep = nullptr, float* xw = nullptr) {
    int m = gw; if (m >= M) return;
    f32x4 vn[8];
    { const float* xr = (m < MP ? xa : xb) + (size_t)m * D + lane * 4;
#pragma unroll
      for (int j = 0; j < 8; ++j) vn[j] = *(const f32x4*)(xr + 256 * j); }
    int ccur = -1; f32x4 A[8], B[8];
    while (m < M) {
        f32x4 v[8];
#pragma unroll
        for (int j = 0; j < 8; ++j) v[j] = vn[j];
        const int mn = m + NGW;
        if (mn < M) { const float* xr = (mn < MP ? xa : xb) + (size_t)mn * D + lane * 4;
#pragma unroll
            for (int j = 0; j < 8; ++j) vn[j] = *(const f32x4*)(xr + 256 * j); }
        const int cond = m < MP ? 0 : 1 + ((m - MP) >> 10);
        if (cond != ccur) {
            const float* sh = modl + (size_t)cond * 12288 + jshift * 2048 + lane * 4; const float* sc = modl + (size_t)cond * 12288 + jscale * 2048 + lane * 4;
#pragma unroll
            for (int j = 0; j < 8; ++j) { A[j] = *(const f32x4*)(g + lane * 4 + 256 * j) * (*(const f32x4*)(sc + 256 * j) + 1.0f); B[j] = *(const f32x4*)(sh + 256 * j); }
            ccur = cond;
        }
        if (slab != nullptr && m >= MP) {
            const float* sp = slab + (size_t)(m - MP) * D + lane * 4; const float* gt = gatep + (size_t)cond * 12288 + lane * 4; float* wr = xw + (size_t)m * D + lane * 4;
#pragma unroll
            for (int j = 0; j < 8; ++j) {
                const f32x4 p = (*(const f32x4*)(sp + 256 * j) + *(const f32x4*)(sp + (size_t)2048 * 2048 + 256 * j)) + (*(const f32x4*)(sp + (size_t)2 * 2048 * 2048 + 256 * j) + *(const f32x4*)(sp + (size_t)3 * 2048 * 2048 + 256 * j));
                v[j] = v[j] + *(const f32x4*)(gt + 256 * j) * p; *(f32x4*)(wr + 256 * j) = v[j];
            }
        }
        float ss = 0.f;
#pragma unroll
        for (int j = 0; j < 8; ++j) ss += (v[j].x * v[j].x + v[j].y * v[j].y) + (v[j].z * v[j].z + v[j].w * v[j].w);
        const float rstd = 1.0f / sqrtf(wave_sum(ss) * (1.0f / D) + NORM_EPS);
        bf16* orow = out + (size_t)m * D + lane * 4;
#pragma unroll
        for (int j = 0; j < 8; ++j) {
            const f32x4 o = v[j] * rstd * A[j] + B[j];
            u32x2 w; w.x = pk2(o.x, o.y); w.y = pk2(o.z, o.w);
            *(u32x2*)(orow + 256 * j) = w;
        }
        m = mn;
    }
}
__device__ __forceinline__ void final_norm_rows(float* x, const float* g, float* out, int gw, int NGW, int lane, const float* slab, const float* gate  ) {
    int m = gw; if (m >= M) return;
    f32x4 vn[8], G8[8];
#pragma unroll
    for (int j = 0; j < 8; ++j) { vn[j] = *(const f32x4*)(x + (size_t)m * D + lane * 4 + 256 * j); G8[j] = *(const f32x4*)(g + lane * 4 + 256 * j); }
    while (m < M) {
        float* xr = x + (size_t)m * D + lane * 4;
        f32x4 v[8];
#pragma unroll
        for (int j = 0; j < 8; ++j) v[j] = vn[j];
        const int mn = m + NGW;
        if (mn < M) {
#pragma unroll
            for (int j = 0; j < 8; ++j) vn[j] = *(const f32x4*)(x + (size_t)mn * D + lane * 4 + 256 * j); }
        if (m >= MP) {
            const int cond = 1 + ((m - MP) >> 10);
            const float* sp = slab + (size_t)(m - MP) * D + lane * 4; const float* gt = gate + (size_t)cond * 12288 + lane * 4;
#pragma unroll
            for (int j = 0; j < 8; ++j) {
                const f32x4 p = (*(const f32x4*)(sp + 256 * j) + *(const f32x4*)(sp + (size_t)2048 * 2048 + 256 * j)) + (*(const f32x4*)(sp + (size_t)2 * 2048 * 2048 + 256 * j) + *(const f32x4*)(sp + (size_t)3 * 2048 * 2048 + 256 * j));
                v[j] = v[j] + *(const f32x4*)(gt + 256 * j) * p;
#if DBG_CHECKS
                *(f32x4*)(xr + 256 * j) = v[j];
#endif
            }
        }
        (void)xr;
        float ss = 0.f;
#pragma unroll
        for (int j = 0; j < 8; ++j) ss += (v[j].x * v[j].x + v[j].y * v[j].y) + (v[j].z * v[j].z + v[j].w * v[j].w);
        const float rstd = 1.0f / sqrtf(wave_sum(ss) * (1.0f / D) + NORM_EPS);
        float* orow = out + (size_t)m * D + lane * 4;
#pragma unroll
        for (int j = 0; j < 8; ++j) *(f32x4*)(orow + 256 * j) = v[j] * rstd * G8[j];
        m = mn;
    }
}


__device__ __forceinline__ void unpack8(const v4u w, f32x4& a, f32x4& b) { a = (f32x4){bf_lo(w.x), bf_hi(w.x), bf_lo(w.y), bf_hi(w.y)}; b = (f32x4){bf_lo(w.z), bf_hi(w.z), bf_lo(w.w), bf_hi(w.w)}; }
template <bool SF32>
__device__ __forceinline__ void norm_rows_b(const bf16* x, const float* xs, const float* g, const float* modl, int jshift, int jscale, bf16* out, int gw, int NGW, int lane,
                                            const bf16* slab, const float* gatep, bf16* xw) {
    if (gw >= M) return;
    int m = gw + ((M - 1 - gw) / NGW) * NGW;
    v4u pn[4];
    if (m < MP) { const bf16* xr = x + (size_t)m * D + lane * 8;
#pragma unroll
        for (int j = 0; j < 4; ++j) pn[j] = *(const v4u*)(xr + 512 * j); }
    int ccur = -1; f32x4 A[4][2], B[4][2];
    while (m >= 0) {
        const int mn = m - NGW;
        f32x4 v[4][2];
        const int cond = m < MP ? 0 : 1 + ((m - MP) >> 10);
        if (m >= MP) {
            const bf16* sp = slab + (size_t)(m - MP) * D + lane * 8; const float* gt = gatep + (size_t)cond * 12288 + lane * 8;
            v4u s[4][4];
            if constexpr (SF32) { const float* xr = xs + (size_t)m * D + lane * 8;
#pragma unroll
                for (int j = 0; j < 4; ++j) { v[j][0] = *(const f32x4*)(xr + 512 * j); v[j][1] = *(const f32x4*)(xr + 512 * j + 4); } }
            else { const bf16* xr = x + (size_t)m * D + lane * 8;
#pragma unroll
                for (int j = 0; j < 4; ++j) { const v4u w = *(const v4u*)(xr + 512 * j); unpack8(w, v[j][0], v[j][1]); } }
#pragma unroll
            for (int k = 0; k < 4; ++k)
#pragma unroll
                for (int j = 0; j < 4; ++j) s[k][j] = *(const v4u*)(sp + (size_t)k * 2048 * 2048 + 512 * j);
            if (mn >= 0 && mn < MP) { const bf16* xr = x + (size_t)mn * D + lane * 8;
#pragma unroll
                for (int j = 0; j < 4; ++j) pn[j] = *(const v4u*)(xr + 512 * j); }
            bf16* wr = xw + (size_t)m * D + lane * 8;
#pragma unroll
            for (int j = 0; j < 4; ++j) {
                f32x4 p0, p1, q0, q1; unpack8(s[0][j], p0, p1); unpack8(s[1][j], q0, q1); p0 += q0; p1 += q1; unpack8(s[2][j], q0, q1); f32x4 r0, r1; unpack8(s[3][j], r0, r1); p0 += q0 + r0; p1 += q1 + r1;
                v[j][0] += *(const f32x4*)(gt + 512 * j) * p0; v[j][1] += *(const f32x4*)(gt + 512 * j + 4) * p1;
                v4u o; o.x = cvtpk(v[j][0].x, v[j][0].y); o.y = cvtpk(v[j][0].z, v[j][0].w); o.z = cvtpk(v[j][1].x, v[j][1].y); o.w = cvtpk(v[j][1].z, v[j][1].w);
                *(v4u*)(wr + 512 * j) = o;
                unpack8(o, v[j][0], v[j][1]);
            }
        } else {
#pragma unroll
            for (int j = 0; j < 4; ++j) unpack8(pn[j], v[j][0], v[j][1]);
            if (mn >= 0) { const bf16* xr = x + (size_t)mn * D + lane * 8;
#pragma unroll
                for (int j = 0; j < 4; ++j) pn[j] = *(const v4u*)(xr + 512 * j); }
        }
        if (cond != ccur) {
            const float* sh = modl + (size_t)cond * 12288 + jshift * 2048 + lane * 8; const float* sc = modl + (size_t)cond * 12288 + jscale * 2048 + lane * 8;
#pragma unroll
            for (int j = 0; j < 4; ++j)
#pragma unroll
                for (int h = 0; h < 2; ++h) { A[j][h] = *(const f32x4*)(g + lane * 8 + 512 * j + 4 * h) * (*(const f32x4*)(sc + 512 * j + 4 * h) + 1.0f); B[j][h] = *(const f32x4*)(sh + 512 * j + 4 * h); }
            ccur = cond;
        }
        float ss = 0.f;
#pragma unroll
        for (int j = 0; j < 4; ++j)
#pragma unroll
            for (int h = 0; h < 2; ++h) ss += (v[j][h].x * v[j][h].x + v[j][h].y * v[j][h].y) + (v[j][h].z * v[j][h].z + v[j][h].w * v[j][h].w);
        const float rstd = 1.0f / sqrtf(wave_sum(ss) * (1.0f / D) + NORM_EPS);
        bf16* orow = out + (size_t)m * D + lane * 8;
#pragma unroll
        for (int j = 0; j < 4; ++j) {
            const f32x4 o0 = v[j][0] * rstd * A[j][0] + B[j][0], o1 = v[j][1] * rstd * A[j][1] + B[j][1];
            v4u w; w.x = cvtpk(o0.x, o0.y); w.y = cvtpk(o0.z, o0.w); w.z = cvtpk(o1.x, o1.y); w.w = cvtpk(o1.z, o1.w);
            *(v4u*)(orow + 512 * j) = w;
        }
        m = mn;
    }
}
__device__ __forceinline__ void final_norm_rows_b(const bf16* x, const float* g, float* out, int gw, int NGW, int lane, const bf16* slab, const float* gate  ) {
    if (gw >= M) return;
    int m = gw + ((M - 1 - gw) / NGW) * NGW;
    v4u pn[4]; f32x4 G8[4][2];
#pragma unroll
    for (int j = 0; j < 4; ++j) { G8[j][0] = *(const f32x4*)(g + lane * 8 + 512 * j); G8[j][1] = *(const f32x4*)(g + lane * 8 + 512 * j + 4); }
    { const bf16* xr = x + (size_t)m * D + lane * 8;
#pragma unroll
      for (int j = 0; j < 4; ++j) pn[j] = *(const v4u*)(xr + 512 * j); }
    while (m >= 0) {
        const int mn = m - NGW;
        f32x4 v[4][2];
#pragma unroll
        for (int j = 0; j < 4; ++j) unpack8(pn[j], v[j][0], v[j][1]);
        if (m >= MP) {
            const int cond = 1 + ((m - MP) >> 10);
            const bf16* sp = slab + (size_t)(m - MP) * D + lane * 8; const float* gt = gate + (size_t)cond * 12288 + lane * 8;
            v4u s[4][4];
#pragma unroll
            for (int k = 0; k < 4; ++k)
#pragma unroll
                for (int j = 0; j < 4; ++j) s[k][j] = *(const v4u*)(sp + (size_t)k * 2048 * 2048 + 512 * j);
            if (mn >= 0) { const bf16* xr = x + (size_t)mn * D + lane * 8;
#pragma unroll
                for (int j = 0; j < 4; ++j) pn[j] = *(const v4u*)(xr + 512 * j); }
#pragma unroll
            for (int j = 0; j < 4; ++j) {
                f32x4 p0, p1, q0, q1; unpack8(s[0][j], p0, p1); unpack8(s[1][j], q0, q1); p0 += q0; p1 += q1; unpack8(s[2][j], q0, q1); f32x4 r0, r1; unpack8(s[3][j], r0, r1); p0 += q0 + r0; p1 += q1 + r1;
                v[j][0] += *(const f32x4*)(gt + 512 * j) * p0; v[j][1] += *(const f32x4*)(gt + 512 * j + 4) * p1;
            }
        } else if (mn >= 0) { const bf16* xr = x + (size_t)mn * D + lane * 8;
#pragma unroll
            for (int j = 0; j < 4; ++j) pn[j] = *(const v4u*)(xr + 512 * j); }
        float ss = 0.f;
#pragma unroll
        for (int j = 0; j < 4; ++j)
#pragma unroll
            for (int h = 0; h < 2; ++h) ss += (v[j][h].x * v[j][h].x + v[j][h].y * v[j][h].y) + (v[j][h].z * v[j][h].z + v[j][h].w * v[j][h].w);
        const float rstd = 1.0f / sqrtf(wave_sum(ss) * (1.0f / D) + NORM_EPS);
        float* orow = out + (size_t)m * D + lane * 8;
#pragma unroll
        for (int j = 0; j < 4; ++j) { *(f32x4*)(orow + 512 * j) = v[j][0] * rstd * G8[j][0]; *(f32x4*)(orow + 512 * j + 4) = v[j][1] * rstd * G8[j][1]; }
        m = mn;
    }
}

__device__ __forceinline__ void load8(const bf16* p, float (&o)[8]) {
    const v4u w = *(const v4u*)p;
    o[0] = bf_lo(w.x); o[1] = bf_hi(w.x); o[2] = bf_lo(w.y); o[3] = bf_hi(w.y); o[4] = bf_lo(w.z); o[5] = bf_hi(w.z); o[6] = bf_lo(w.w); o[7] = bf_hi(w.w);
}
__device__ __forceinline__ void conv_gate_s(const bf16* ups, const float* cw, const float* cb, bf16* act, int gtid, int NGT) {
    constexpr int NCH = FF / 8, RB = 8;
    for (int it = gtid; it < (MS / RB) * NCH; it += NGT) {
        const int rb = it / NCH, ch = it % NCH, f0 = ch * 8, r0 = rb * RB, cg = 256 * (f0 >> 7) + (f0 & 127), cv_ = cg + 128;
        float w0g[8], w1g[8], w2g[8], bg[8], w0v[8], w1v[8], w2v[8], bv[8];
#pragma unroll
        for (int e = 0; e < 8; ++e) { w0g[e] = cw[f0 + e]; w1g[e] = cw[F2 + f0 + e]; w2g[e] = cw[2 * F2 + f0 + e]; bg[e] = cb[f0 + e];
            w0v[e] = cw[FF + f0 + e]; w1v[e] = cw[F2 + FF + f0 + e]; w2v[e] = cw[2 * F2 + FF + f0 + e]; bv[e] = cb[FF + f0 + e]; }
        const int pos0 = r0 & (DSEQ - 1);
        float pg[8], pv[8], cg_[8], cv[8], ng[8], nv[8];
        if (pos0 == 0) {
#pragma unroll
            for (int e = 0; e < 8; ++e) { pg[e] = 0.f; pv[e] = 0.f; }
        } else { load8(ups + (size_t)(r0 - 1) * F2 + cg, pg); load8(ups + (size_t)(r0 - 1) * F2 + cv_, pv); }
        load8(ups + (size_t)r0 * F2 + cg, cg_); load8(ups + (size_t)r0 * F2 + cv_, cv);
#pragma unroll
        for (int i = 0; i < RB; ++i) {
            const int r = r0 + i;
            if (pos0 + i + 1 >= DSEQ) {
#pragma unroll
                for (int e = 0; e < 8; ++e) { ng[e] = 0.f; nv[e] = 0.f; }
            } else { load8(ups + (size_t)(r + 1) * F2 + cg, ng); load8(ups + (size_t)(r + 1) * F2 + cv_, nv); }
            float o[8];
#pragma unroll
            for (int e = 0; e < 8; ++e) {
                const float zg = w0g[e] * pg[e] + w1g[e] * cg_[e] + w2g[e] * ng[e] + bg[e];
                const float zv = w0v[e] * pv[e] + w1v[e] * cv[e] + w2v[e] * nv[e] + bv[e];
                o[e] = zg * __builtin_amdgcn_rcpf(1.0f + __builtin_amdgcn_exp2f(-LOG2E * zg)) * zv;
                pg[e] = cg_[e]; pv[e] = cv[e]; cg_[e] = ng[e]; cv[e] = nv[e];
            }
            v4u w; w.x = pk2(o[0], o[1]); w.y = pk2(o[2], o[3]); w.z = pk2(o[4], o[5]); w.w = pk2(o[6], o[7]);
            *(v4u*)(act + (size_t)(MP + r) * FF + f0) = w;
        }
    }
}

__device__ __forceinline__ f32x16 mfma32(bf16x8 a, bf16x8 b, f32x16 c) { return __builtin_amdgcn_mfma_f32_32x32x16_bf16(a, b, c, 0, 0, 0); }
#define LDSR128(dst, a, off) asm volatile("ds_read_b128 %0, %1 offset:%2" : "=v"(dst) : "v"(a), "n"(off))
#define LDSR32(dst, a) asm volatile("ds_read_b32 %0, %1" : "=v"(dst) : "v"(a))
#define LDS_DRAIN() do { asm volatile("s_waitcnt lgkmcnt(0)" ::: "memory"); __builtin_amdgcn_sched_barrier(0); } while (0)
__device__ __forceinline__ void attn_chunk(const LAS unsigned char* kbuf, const LAS unsigned char* vbuf, const bf16x8 (&qf)[8], f32x16 (&o)[4], float& m_run, float& l_run, int lane,
                                           const LAS float* rpbL, bool WIN, int wq, int drb, int jj, bool attend) {
    const int hi = lane >> 5;
    f32x16 s[2];
#pragma unroll
    for (int r = 0; r < 16; ++r) { s[0][r] = 0.f; s[1][r] = 0.f; }
#pragma unroll
    for (int hb = 0; hb < 2; ++hb) {
        bf16x8 kf[8];
#pragma unroll
        for (int q = 0; q < 8; ++q) kf[q] = *(const LAS bf16x8*)(kbuf + (((q >> 2) * 8 + 4 * hb + (q & 3)) * 64 + lane) * 16);
#pragma unroll
        for (int q = 0; q < 4; ++q) { s[0] = mfma32(kf[q], qf[4 * hb + q], s[0]); s[1] = mfma32(kf[4 + q], qf[4 * hb + q], s[1]); }
        __builtin_amdgcn_sched_group_barrier(0x100, 8, 0);
        __builtin_amdgcn_sched_group_barrier(0x008, 8, 0);
    }
    if (WIN) {
        asm volatile("" : "+v"(wq));
        const int cs = attend ? min(max(wq - 8, 0), 48) : 4096;
        const LAS float* tb = rpbL + (attend ? (drb + jj + 7) * 31 + 15 : 15);
#pragma unroll
        for (int kb = 0; kb < 2; ++kb) {
            float bv[16];
#pragma unroll
            for (int r = 0; r < 16; ++r) {
                const int wk = 32 * kb + (r & 3) + 8 * (r >> 2) + 4 * hi, dd = wk - wq;
                const int okm = -(int)((wk >= cs) & (wk < cs + 16));
                bv[r] = tb[dd & okm];
            }
#pragma unroll
            for (int r = 0; r < 16; ++r) {
                const int wk = 32 * kb + (r & 3) + 8 * (r >> 2) + 4 * hi;
                const bool ok = (wk >= cs) && (wk < cs + 16);
                s[kb][r] = ok ? s[kb][r] + bv[r] : -1e30f;
            }
        }
    }
    float mx = s[0][0];
#pragma unroll
    for (int kb = 0; kb < 2; ++kb)
#pragma unroll
        for (int r = 0; r < 16; ++r) mx = fmaxf(mx, s[kb][r]);
    mx = fmaxf(mx, __shfl_xor(mx, 32));
    const float m_new = fmaxf(m_run, mx);
    const float alpha = __builtin_amdgcn_exp2f(m_run - m_new);
    m_run = m_new;
    float ls = 0.f;
#pragma unroll
    for (int kb = 0; kb < 2; ++kb)
#pragma unroll
        for (int r = 0; r < 16; ++r) { const float p = __builtin_amdgcn_exp2f(s[kb][r] - m_new); s[kb][r] = p; ls += p; }
    l_run = l_run * alpha + ls;
#pragma unroll
    for (int db = 0; db < 4; ++db)
#pragma unroll
        for (int r = 0; r < 16; ++r) o[db][r] *= alpha;
#pragma unroll
    for (int kb = 0; kb < 2; ++kb) {
        bf16x8 vf[8];
#pragma unroll
        for (int i = 0; i < 8; ++i) vf[i] = *(const LAS bf16x8*)(vbuf + ((kb * 8 + i) * 64 + lane) * 16);
        bf16x8 pf[2];
#pragma unroll
        for (int s2 = 0; s2 < 2; ++s2) {
            v4u pw; pw.x = cvtpk(s[kb][8 * s2 + 0], s[kb][8 * s2 + 1]); pw.y = cvtpk(s[kb][8 * s2 + 2], s[kb][8 * s2 + 3]); pw.z = cvtpk(s[kb][8 * s2 + 4], s[kb][8 * s2 + 5]); pw.w = cvtpk(s[kb][8 * s2 + 6], s[kb][8 * s2 + 7]);
            pf[s2] = __builtin_bit_cast(bf16x8, pw); }
#pragma unroll
        for (int s2 = 0; s2 < 2; ++s2)
#pragma unroll
            for (int db = 0; db < 4; ++db) o[db] = mfma32(vf[s2 * 4 + db], pf[s2], o[db]);
        __builtin_amdgcn_sched_group_barrier(0x100, 8, 0);
        __builtin_amdgcn_sched_group_barrier(0x008, 8, 0);
    }
}
__device__ __forceinline__ void attn_store(const f32x16 (&o)[4], float l_run, bf16* Orow  , int lane) {
    const int hi = lane >> 5;
    const float lt = l_run + __shfl_xor(l_run, 32);
    const float inv = 1.0f / lt;
#pragma unroll
    for (int db = 0; db < 4; ++db)
#pragma unroll
        for (int rg = 0; rg < 4; ++rg) {
            u32x2 w; w.x = cvtpk(o[db][4 * rg + 0] * inv, o[db][4 * rg + 1] * inv); w.y = cvtpk(o[db][4 * rg + 2] * inv, o[db][4 * rg + 3] * inv);
            *(u32x2*)(Orow + 32 * db + 8 * rg + 4 * hi) = w;
        }
}
__device__ __forceinline__ void attn_issue(LAS unsigned char* buf, const bf16* Kc, const bf16* Vc, int wave, int lane) {
    const unsigned lo = (unsigned)((2 * wave * 64 + lane) * 16);
    const char* kb = (const char*)Kc; const char* vb = (const char*)Vc;
#pragma unroll
    for (int i = 0; i < 2; ++i) {
        __builtin_amdgcn_global_load_lds((const unsigned*)(kb + lo + i * 1024), (LAS unsigned*)(buf + (2 * wave + i) * 1024), 16, 0, 0);
        __builtin_amdgcn_global_load_lds((const unsigned*)(vb + lo + i * 1024), (LAS unsigned*)(buf + 16384 + (2 * wave + i) * 1024), 16, 0, 0);
    }
}
#define ATTN_WAIT_BAR(n) asm volatile("s_waitcnt vmcnt(" #n ") lgkmcnt(0)\n\ts_barrier" ::: "memory")
__device__ __forceinline__ void attn_wait_bar(int ahead) {
    if (ahead >= 3) ATTN_WAIT_BAR(12); else if (ahead == 2) ATTN_WAIT_BAR(8); else if (ahead == 1) ATTN_WAIT_BAR(4); else ATTN_WAIT_BAR(0);
}
__device__ __forceinline__ void attn_phase(LAS unsigned char* lds, const bf16* Qb, const bf16* Kf, const bf16* VTf, bf16* Ob, const float* rpb, int tid, int wave, int lane) {
    const int r32 = lane & 31, hi = lane >> 5;
    LAS float* rpbL = (LAS float*)(lds + XCH_OFF);
    const int G = gridDim.x, nlat = G / 2 < 128 ? G / 2 : 128;
    const bool lat = (int)blockIdx.x < nlat;
    const int ufirst = lat ? (int)blockIdx.x : (int)blockIdx.x - nlat, ustep = lat ? nlat : G - nlat, uend = lat ? 128 : 512;
    for (int un = ufirst; un < uend; un += ustep) {
        const int b = lat ? un >> 6 : un >> 4, h = lat ? (un >> 2) & 15 : un & 15, rg4 = un & 3;
        const int r = 4 * rg4 + (wave >> 1), wq0 = 32 * (wave & 1), start = min(max(r - 4, 0), 8);
        const int jmin = min(max(4 * rg4 - 4, 0), 8), jmax = min(max(4 * rg4 - 1, 0), 8) + 7;
        const int n0 = lat ? 8 : 4, nch = lat ? 8 + (jmax - jmin + 1) : 4;
        const int qrow = lat ? MP + b * DSEQ + r * 64 + wq0 + r32 : b * SEQ + 32 * wave + r32;
        const size_t base0 = lat ? pg8::seq_base_cache(b, h) : (size_t)(b * 16 + h) * 256 * 128, base1 = pg8::KF_SAMPLE + (size_t)(b * 16 + h) * 1024 * 128 + (size_t)jmin * 8192;
        ATTN_WAIT_BAR(0);
        if (lat) for (int i = tid; i < 465; i += NTHR) rpbL[i] = rpb[h * 465 + i] * LOG2E;
        attn_issue(lds, Kf + base0, VTf + base0, wave, lane);
        bf16x8 qf[8];
#pragma unroll
        for (int st = 0; st < 8; ++st) qf[st] = *(const bf16x8*)(Qb + (size_t)qrow * D + h * HD + 16 * st + 8 * hi);
        attn_issue(lds + 32768, Kf + base0 + 8192, VTf + base0 + 8192, wave, lane);
        attn_issue(lds + 65536, Kf + base0 + 16384, VTf + base0 + 16384, wave, lane);
        f32x16 o[4];
#pragma unroll
        for (int db = 0; db < 4; ++db)
#pragma unroll
            for (int rr = 0; rr < 16; ++rr) o[db][rr] = 0.f;
        float m_run = -1e30f, l_run = 0.f;
#pragma unroll 1
        for (int i = 0; i < nch; ++i) {
            attn_wait_bar(min(nch - 1 - i, 2));
            if (i + 3 < nch) { const int n3 = i + 3; const size_t co = n3 < n0 ? base0 + (size_t)n3 * 8192 : base1 + (size_t)(n3 - n0) * 8192;
                attn_issue(lds + (n3 & 3) * 32768, Kf + co, VTf + co, wave, lane); }
            const LAS unsigned char* kb_ = lds + (i & 3) * 32768;
            const int j = jmin + i - n0;
            attn_chunk(kb_, kb_ + 16384, qf, o, m_run, l_run, lane, rpbL, i >= n0, wq0 + r32, start - r, j - start, j >= start && j < start + 8);
        }
        attn_store(o, l_run, Ob + (size_t)qrow * D + h * HD, lane);
    }
}

__device__ __forceinline__ void cpow(float are, float aim, float dt, int e, float& pr, float& pi) {
    const float fe = (float)e, mag = __expf(are * dt * fe);
    float ang = aim * dt * fe; const float k = rintf(ang * 0.15915494309189535f);
    ang = fmaf(-k, 6.28318548202514648f, ang); ang = fmaf(-k, -1.74845553146e-7f, ang);
    pr = mag * __cosf(ang); pi = mag * __sinf(ang);
}
__device__ __forceinline__ void s5w_gen(LAS unsigned char* lds, bf16* S5W, int tid, int rank, int nrank) {
    LAS float* pwr = (LAS float*)lds; LAS float* pwi = pwr + 17 * 128; LAS float* bbr = pwi + 17 * 128; LAS float* bbi = bbr + 2048; LAS float* bbTr = bbi + 2048; LAS float* bbTi = bbTr + 2048;
    LAS float* ccTr = bbTi + 2048; LAS float* ccTi = ccTr + 2048; LAS float* KFT = ccTi + 2048; LAS float* pwT = KFT + 31 * 256;
    const float* are = ARG_IN(I_ARE); const float* aim = ARG_IN(I_AIM); const float* ldt = ARG_IN(I_LOGDT); const float* bre = ARG_IN(I_BRE); const float* bim = ARG_IN(I_BIM); const float* cre = ARG_IN(I_CRE); const float* cim = ARG_IN(I_CIM); const float* sd = ARG_IN(I_SD);
    for (int it = rank; it < 2 * NG; it += nrank) {
        const int g = it >> 1, half = it & 1;
        __syncthreads();
        {
            const int sp = tid & 127, dir = sp >> 6, p = sp & 63, eq = tid >> 7;
            const float ar = are[(dir * NG + g) * SP + p], ai = aim[(dir * NG + g) * SP + p], dt = __expf(ldt[dir * NG + g]);
            for (int e = eq; e <= 16; e += 4) { float pr, pi; cpow(ar, ai, dt, e, pr, pi); pwr[e * 128 + sp] = pr; pwi[e * 128 + sp] = pi; if (e < 16) { pwT[sp * 32 + e] = pr; pwT[sp * 32 + 16 + e] = pi; } }
            float a1r, a1i; cpow(ar, ai, dt, 1, a1r, a1i);
            const float den = ar * ar + ai * ai, nr = a1r - 1.0f, ni = a1i;
            const float cfr = (nr * ar + ni * ai) / den, cfi = (ni * ar - nr * ai) / den;
            const f32x4 b4r = *(const f32x4*)(bre + ((size_t)(dir * NG + g) * SP + p) * GC + eq * 4), b4i = *(const f32x4*)(bim + ((size_t)(dir * NG + g) * SP + p) * GC + eq * 4);
#pragma unroll
            for (int q = 0; q < 4; ++q) { const int c = eq * 4 + q; const float vr = cfr * b4r[q] - cfi * b4i[q], vi = cfr * b4i[q] + cfi * b4r[q];
                bbr[sp * 16 + c] = vr; bbi[sp * 16 + c] = vi; bbTr[c * 128 + sp] = vr; bbTi[c * 128 + sp] = vi; }
        }
        for (int i = tid; i < 2048; i += NTHR) { const int dir = i >> 10, c = (i >> 6) & 15, p = i & 63; ccTr[(dir * 64 + p) * 16 + c] = cre[((size_t)(dir * NG + g) * GC) * SP + (i & 1023)]; ccTi[(dir * 64 + p) * 16 + c] = cim[((size_t)(dir * NG + g) * GC) * SP + (i & 1023)]; }
        __syncthreads();
        bf16* W0 = S5W + ((size_t)g * 3 + 0) * 65536; bf16* W1 = W0 + 65536; bf16* W2 = W1 + 65536;
        if (half == 0) {
            for (int i = tid; i < 8192; i += NTHR) {
                const int n = (i >> 10) * 32 + (i & 31), k0 = ((i >> 6) & 15) * 16 + ((i >> 5) & 1) * 8;
                {
                    const int dir = n >> 7, ri = (n >> 6) & 1, p = n & 63, s = k0 >> 4, c0 = k0 & 15, e = dir ? s : 15 - s, sp = dir * 64 + p;
                    const float pr = pwr[e * 128 + sp], pi = pwi[e * 128 + sp]; float v[8];
#pragma unroll
                    for (int q = 0; q < 8; ++q) { const float br = bbTr[(c0 + q) * 128 + sp], bi = bbTi[(c0 + q) * 128 + sp]; v[q] = ri ? (pr * bi + pi * br) : (pr * br - pi * bi); }
                    v4u o; o.x = pk2(v[0], v[1]); o.y = pk2(v[2], v[3]); o.z = pk2(v[4], v[5]); o.w = pk2(v[6], v[7]);
                    *(v4u*)(W0 + (size_t)i * 8) = o;
                }
                {
                    const int t = n >> 4, c = n & 15, dir = k0 >> 7, ri = (k0 >> 6) & 1, p0 = k0 & 63, e = dir ? 16 - t : t + 1; float v[8];
#pragma unroll
                    for (int q = 0; q < 8; ++q) { const int sp = dir * 64 + p0 + q; const float pr = pwr[e * 128 + sp], pi = pwi[e * 128 + sp], cr = ccTr[sp * 16 + c], ci = ccTi[sp * 16 + c];
                        v[q] = ri ? -(cr * pi + ci * pr) : (cr * pr - ci * pi); }
                    v4u o; o.x = pk2(v[0], v[1]); o.y = pk2(v[2], v[3]); o.z = pk2(v[4], v[5]); o.w = pk2(v[6], v[7]);
                    *(v4u*)(W1 + (size_t)i * 8) = o;
                }
            }
        } else {
            {
                const int dir = tid >> 8, c = (tid >> 4) & 15, cp = tid & 15;
                float acc[16];
#pragma unroll
                for (int e = 0; e < 16; ++e) acc[e] = 0.f;
                for (int p = 0; p < 64; ++p) {
                    const int sp = dir * 64 + p;
                    const float cr = ccTr[sp * 16 + c], ci = ccTi[sp * 16 + c], br = bbr[sp * 16 + cp], bi = bbi[sp * 16 + cp];
                    const float zr = cr * br - ci * bi, zi = cr * bi + ci * br;
                    f32x4 pr4[4], pi4[4];
#pragma unroll
                    for (int q = 0; q < 4; ++q) { pr4[q] = *(const LAS f32x4*)(pwT + sp * 32 + 4 * q); pi4[q] = *(const LAS f32x4*)(pwT + sp * 32 + 16 + 4 * q); }
#pragma unroll
                    for (int e = 0; e < 16; ++e) acc[e] += zr * pr4[e >> 2][e & 3] - zi * pi4[e >> 2][e & 3];
                }
                if (dir == 0) {
#pragma unroll
                    for (int e = 1; e < 16; ++e) KFT[((15 + e) * 16 + cp) * 16 + c] = acc[e];
                    KFT[(15 * 16 + cp) * 16 + c] = acc[0] + (c == cp ? sd[g * 16 + c] : 0.f);
                } else {
#pragma unroll
                    for (int e = 1; e < 16; ++e) KFT[((15 - e) * 16 + cp) * 16 + c] = acc[e];
                }
                __syncthreads();
                if (dir == 1) KFT[(15 * 16 + cp) * 16 + c] += acc[0];
            }
            __syncthreads();
            for (int i = tid; i < 31 * 256; i += NTHR) {
                const int tau = i >> 8, c = (i >> 4) & 15, cp = i & 15;
                W2[i] = (bf16)f2bf(KFT[(tau * 16 + cp) * 16 + c]);
            }
        }
    }
}
constexpr int S5_SL_OFF = 0, S5_HIN_OFF = 65536, S5_UT_OFF = 98304;
#define LDS_BAR() asm volatile("s_waitcnt lgkmcnt(0)\n\ts_barrier" ::: "memory")
__device__ __forceinline__ void s5_phase(LAS unsigned char* lds, const bf16* U, const bf16* S5W, bf16* Y, float* out, int tid, int wave, int lane) {
    LAS float* Sl = (LAS float*)(lds + S5_SL_OFF); LAS bf16* Hin = (LAS bf16*)(lds + S5_HIN_OFF); const LAS unsigned char* Ut = lds + S5_UT_OFF;
    const int r32 = lane & 31, hi = lane >> 5;
    int gcur = -1; float a16r = 0.f, a16i = 0.f;
    bf16x8 bA[16], bB[16];
    if ((int)blockIdx.x < NG * 10) { const bf16* U0 = U + ((size_t)(((int)blockIdx.x & 127) * 10 + ((int)blockIdx.x >> 7)) * 2 * 16 * 64) * 8;
#pragma unroll
        for (int i = 0; i < 4; ++i) { const int piece = 4 * wave + i; __builtin_amdgcn_global_load_lds((const unsigned*)(U0 + (piece * 64 + lane) * 8), (LAS unsigned*)(lds + S5_UT_OFF + piece * 1024), 16, 0, 0); } }
    for (int un = blockIdx.x; un < NG * 10; un += gridDim.x) {
        const int g = un & 127, rb = un >> 7;
        if (g != gcur) { const int dir = (tid >> 6) & 1, p = tid & 63; const float ar = ARG_IN(I_ARE)[(dir * NG + g) * SP + p], ai = ARG_IN(I_AIM)[(dir * NG + g) * SP + p], dt = __expf(ARG_IN(I_LOGDT)[dir * NG + g]);
            cpow(ar, ai, dt, 16, a16r, a16i); gcur = g;
            LDS_BAR();
            { const bf16* kfg = S5W + ((size_t)g * 3 + 2) * 65536; for (int i = tid; i < 31 * 256 / 8; i += NTHR) *(LAS v4u*)(lds + KFB_OFF + i * 16) = *(const v4u*)(kfg + i * 8); }
            { const bf16* WSt = S5W + ((size_t)g * 3 + 0) * 65536 + ((size_t)(wave * 16) * 64 + lane) * 8;
#pragma unroll
              for (int st = 0; st < 16; ++st) { bA[st] = *(const bf16x8*)(WSt + 512 * st); bB[st] = *(const bf16x8*)(WSt + 65536 + 512 * st); } } }
        const int tok0 = rb * 1024;
        if (un == (int)blockIdx.x) asm volatile("s_waitcnt vmcnt(0)" ::: "memory"); else asm volatile("s_waitcnt vmcnt(4)" ::: "memory");
        LDS_BAR();
        {
            f32x16 acc[2];
#pragma unroll
            for (int mb = 0; mb < 2; ++mb)
#pragma unroll
                for (int r = 0; r < 16; ++r) acc[mb][r] = 0.f;
#pragma unroll
            for (int s2 = 0; s2 < 8; ++s2) {
                bf16x8 af[4];
#pragma unroll
                for (int i = 0; i < 4; ++i) af[i] = *(const LAS bf16x8*)(Ut + (((i & 1) * 16 + 2 * s2 + (i >> 1)) * 64 + lane) * 16);
#pragma unroll
                for (int i = 0; i < 4; ++i) acc[i & 1] = mfma32(af[i], bA[2 * s2 + (i >> 1)], acc[i & 1]);
                __builtin_amdgcn_sched_group_barrier(0x100, 4, 0); __builtin_amdgcn_sched_group_barrier(0x008, 4, 0);
            }
#pragma unroll
            for (int mb = 0; mb < 2; ++mb)
#pragma unroll
                for (int r = 0; r < 16; ++r) Sl[(32 * mb + (r & 3) + 8 * (r >> 2) + 4 * hi) * 256 + 32 * wave + r32] = acc[mb][r];
        }
        LDS_BAR();
        {
            const bool prompt = rb < 8;
            const int dir = (tid >> 6) & 1, p = tid & 63, bi = tid >> 7;
            if (prompt || tid < 128) {
                float hr = 0.f, hi_ = 0.f; const int nc = prompt ? 16 : 64, row0 = prompt ? bi * 16 : 0;
                if (!prompt) { const size_t si = ((size_t)((rb - 8) * 2 + dir) * NG + g) * SP + p; hr = ARG_IN(I_SRE)[si]; hi_ = ARG_IN(I_SIM)[si]; }
                const int cre_ = dir * 128 + p, cim_ = dir * 128 + 64 + p;
                const int hre = (cre_ >> 4) * 512 + ((cre_ >> 3) & 1) * 256 + (cre_ & 7), him = (cim_ >> 4) * 512 + ((cim_ >> 3) & 1) * 256 + (cim_ & 7);
                for (int c = 0; c < nc; ++c) {
                    const int row = row0 + (dir ? nc - 1 - c : c), ro = (row >> 5) * 8192 + (row & 31) * 8;
                    Hin[ro + hre] = (bf16)f2bf(hr); Hin[ro + him] = (bf16)f2bf(hi_);
                    const float sr = Sl[row * 256 + cre_], si = Sl[row * 256 + cim_];
                    const float nr = a16r * hr - a16i * hi_ + sr, ni = a16r * hi_ + a16i * hr + si;
                    hr = nr; hi_ = ni;
                }
                if (prompt) { const size_t so = ((size_t)((rb * 4 + bi) * 2 + dir) * NG + g) * SP + p; out[O_SRE + so] = hr; out[O_SIM + so] = hi_; }
            }
        }
        LDS_BAR();
#ifndef S5REP3
#define S5REP3 0
#endif
#pragma unroll
        for (int rp3_ = 0; rp3_ <= S5REP3; ++rp3_) {
            f32x16 acc[2];
#pragma unroll
            for (int mb = 0; mb < 2; ++mb)
#pragma unroll
                for (int r = 0; r < 16; ++r) acc[mb][r] = 0.f;
            const LAS unsigned char* kfl = lds + KFB_OFF + (((2 * wave + (r32 >> 4) + 15) * 256 + (lane & 15) * 16 + 8 * hi) * 2);
#pragma unroll
            for (int s2 = 0; s2 < 8; ++s2) {
                bf16x8 af[4], kf[2];
#pragma unroll
                for (int i = 0; i < 2; ++i) kf[i] = *(const LAS bf16x8*)(kfl - (2 * s2 + i) * 512);
#pragma unroll
                for (int i = 0; i < 4; ++i) af[i] = *(const LAS bf16x8*)(Ut + (((i & 1) * 16 + 2 * s2 + (i >> 1)) * 64 + lane) * 16);
#pragma unroll
                for (int i = 0; i < 4; ++i) acc[i & 1] = mfma32(af[i], kf[i >> 1], acc[i & 1]);
                __builtin_amdgcn_sched_group_barrier(0x100, 6, 0); __builtin_amdgcn_sched_group_barrier(0x008, 4, 0);
            }
            LDS_BAR();
            { const int un1 = un + (int)gridDim.x;
              if (un1 < NG * 10) { const bf16* U1 = U + ((size_t)((un1 & 127) * 10 + (un1 >> 7)) * 2 * 16 * 64) * 8;
#pragma unroll
                for (int i = 0; i < 4; ++i) { const int piece = 4 * wave + i; __builtin_amdgcn_global_load_lds((const unsigned*)(U1 + (piece * 64 + lane) * 8), (LAS unsigned*)(lds + S5_UT_OFF + piece * 1024), 16, 0, 0); } } }
#pragma unroll
            for (int s2 = 0; s2 < 8; ++s2) {
                bf16x8 af[4];
#pragma unroll
                for (int i = 0; i < 4; ++i) af[i] = *(const LAS bf16x8*)(Hin + (((i & 1) * 16 + 2 * s2 + (i >> 1)) * 64 + lane) * 8);
#pragma unroll
                for (int i = 0; i < 4; ++i) acc[i & 1] = mfma32(af[i], bB[2 * s2 + (i >> 1)], acc[i & 1]);
                __builtin_amdgcn_sched_group_barrier(0x100, 4, 0); __builtin_amdgcn_sched_group_barrier(0x008, 4, 0);
            }
            const int t = 2 * wave + (r32 >> 4), c = lane & 15;
            LAS bf16* Yt = (LAS bf16*)(lds + S5_SL_OFF);
#pragma unroll
            for (int mb = 0; mb < 2; ++mb)
#pragma unroll
                for (int r = 0; r < 16; ++r) { const int row = 32 * mb + (r & 3) + 8 * (r >> 2) + 4 * hi; Yt[(row * 16 + t) * 16 + c] = (bf16)f2bf(gelu_tanh(acc[mb][r])); }
        }
        LDS_BAR();
#pragma unroll
        for (int i = 0; i < 4; ++i) { const int p = tid + NTHR * i, tok = p >> 1, hf = p & 1;
            *(v4u*)(Y + (size_t)(tok0 + tok) * D + g * 16 + hf * 8) = *(const LAS v4u*)(lds + S5_SL_OFF + p * 16); }
    }
}
#ifndef DBG_CHECKS
#define DBG_CHECKS 0
#endif
#ifndef XB16
#define XB16 1
#endif
constexpr int N_PHASES = 19;
struct Args { const float* in[N_IN]; float* out; unsigned char* ws; int ph_lo, ph_hi, use_bar, pad; };
__global__ void __launch_bounds__(NTHR, 2) mega_fwd(Args args) {
    extern __shared__ __attribute__((aligned(16))) unsigned char lds_raw[];
    LAS unsigned char* lds = (LAS unsigned char*)lds_raw;
    { const int t0 = threadIdx.x; for (int u = t0; u < (LDS_BYTES - LDSCTL_OFF) / 4; u += NTHR) ((LAS unsigned*)(lds + LDSCTL_OFF))[u] = 0u; }
    __syncthreads();
    if (ARG_I32(2)) (void)xcd_barrier_post((unsigned*)((gu32*)(ARG_WS() + WS_CTL) + CW_BAR), (volatile LAS unsigned*)(lds + MISC_OFF) + 8);
#define PH_IDS() int tid = threadIdx.x; asm volatile("" : "+v"(tid)); int bid = blockIdx.x, G = gridDim.x; asm volatile("" : "+s"(bid), "+s"(G)); LAS unsigned char* lds_p = lds; asm volatile("" : "+s"(lds_p)); const int lane = tid & 63, wave = __builtin_amdgcn_readfirstlane(tid >> 6); \
    const int gw = bid * NWAVES + wave, NGW = G * NWAVES, gtid = bid * NTHR + tid, NGT = G * NTHR; (void)lane; (void)gw; (void)NGW; (void)gtid; (void)NGT; (void)G
#define ws ARG_WS()
#define out ARG_OUT()
#define mod ((float*)(ARG_WS() + WS_MOD))
#define HB ((bf16*)(ARG_WS() + WS_HB))
#define X1 ((float*)(ARG_WS() + WS_X1))
#define X1B ((bf16*)(ARG_WS() + WS_X1))
#define SLABB ((bf16*)(ARG_WS() + WS_SLAB))
#define IN(k) (ARG_I32(0) <= (k) && (k) < ARG_I32(1))
#define SEAM(k) do { if (IN(k) && IN((k) + 1)) { XcdBarrier bar_; bar_.bar = (unsigned*)((gu32*)(ARG_WS() + WS_CTL) + CW_BAR); bar_.x = xb_xcc_id(); bar_.st = (volatile LAS unsigned*)(lds + MISC_OFF) + 8; xcd_barrier(bar_); } } while (0)
#ifndef DEFER_P0
#define DEFER_P0 1
#endif
#ifndef DEFER_UP1
#define DEFER_UP1 1
#endif
#ifndef REP_MASK
#define REP_MASK 0
#endif
#define REPL(k) for (int rep_ = 0; rep_ <= (((unsigned)REP_MASK >> (k)) & 1); ++rep_)
#define xs_off (ARG_IN(I_XS) - (size_t)MP * D)

    if (IN(0)) { PH_IDS();
        p0_ada(lds_p, ARG_IN(I_ADAW), ARG_IN(I_ADAB), ARG_IN(I_CCTX), ARG_IN(I_C), mod, tid, wave, lane);
        const bool defer = DEFER_P0 && G == 256;
        p0_weights(lds_p, ws, gw, NGW, wave, lane, 0, 6144);
        p0_weights(lds_p, ws, gw, NGW, wave, lane, defer ? 8192 : 6144, 25344);
        if (!defer) p0_weights(lds_p, ws, gw, NGW, wave, lane, 25344, 47360);
        else if (!DEFER_UP1) { p0_weights(lds_p, ws, gw, NGW, wave, lane, 25344, 36352); p0_weights(lds_p, ws, gw, NGW, wave, lane, 41856, 47360); }
        p0_cache(ARG_IN(I_CK), ARG_IN(I_CV), (bf16*)(ws + WS_KF), (bf16*)(ws + WS_VTF), gtid, NGT);
    }
    SEAM(0);
#pragma unroll
    for (int l = 0; l < 2; ++l) {
        const int pb = l == 0 ? 1 : 9;
        const float* modl = mod + (size_t)l * 3 * 12288;
        if (IN(pb)) { PH_IDS();
            if (l == 0) REPL(1) norm_rows(ARG_IN(I_XP), xs_off, ARG_IN(I_N1G), modl, 0, 1, HB, gw, NGW, lane);
#if XB16
            else norm_rows_b<false>(X1B, nullptr, ARG_IN(I_N1G) + D, modl, 0, 1, HB, gw, NGW, lane, SLABB, mod + 5 * 2048, X1B);
#else
            else norm_rows(X1, X1, ARG_IN(I_N1G) + D, modl, 0, 1, HB, gw, NGW, lane, (const float*)(ws + WS_SLAB), mod + 5 * 2048, X1);
#endif
            if (l == 1 && G <= 64) s5w_gen(lds_p, (bf16*)(ws + WS_S5W), tid, bid, G);
        }
        SEAM(pb);
        if (l == 0) {
            if (IN(2)) { PH_IDS();
                pg8::Gemm g{HB, (const bf16*)(ws + WS_WQKV), M, 3 * D, D}; pg8::StaticOrder S; S.init(M, 3 * D, G, bid);
                pg8::EpiQKV E{(bf16*)(ws + WS_Q), (bf16*)(ws + WS_KF), (bf16*)(ws + WS_VTF), out + O_NK, out + O_NV, C2};
                pg8::gemm_phase<pg8::EpiQKV, pg8::StaticOrder, true, true>(lds_p, g, S, E, tid);
                if (DEFER_P0 && G == 256 && bid >= 192) p0_weights(lds_p, ws, (bid - 192) * NWAVES + wave, 64 * NWAVES, wave, lane, 6144, 8192);
            }
            SEAM(2);
            if (IN(3)) { PH_IDS(); REPL(3) attn_phase(lds_p, (const bf16*)(ws + WS_Q), (const bf16*)(ws + WS_KF), (const bf16*)(ws + WS_VTF), (bf16*)(ws + WS_O), ARG_IN(I_RPB), tid, wave, lane); }
            SEAM(3);
            if (IN(4)) { PH_IDS();
                pg8::Gemm g{(const bf16*)(ws + WS_O), (const bf16*)(ws + WS_WO), M, D, D}; pg8::TailOrder S; S.init(D, G, bid);
#if XB16
                pg8::EpiRes3<true> E{ARG_IN(I_XP), (pg8::bf16_t*)X1B, modl + 2 * 2048, (pg8::bf16_t*)SLABB};
                pg8::gemm_phase<pg8::EpiRes3<true>, pg8::TailOrder, true, true>(lds_p, g, S, E, tid);
#else
                pg8::EpiRes2 E{ARG_IN(I_XP), X1, modl + 2 * 2048, (float*)(ws + WS_SLAB)};
                pg8::gemm_phase<pg8::EpiRes2, pg8::TailOrder, true, true>(lds_p, g, S, E, tid);
#endif
            }
            SEAM(4);
        } else {
            if (IN(10)) { PH_IDS();
                pg8::Gemm g{HB, (const bf16*)(ws + WS_WIN), M, D, D}; pg8::StaticOrder S; S.init(M, D, G, bid);
                pg8::EpiU E{(bf16*)(ws + WS_U)};
                pg8::gemm_phase<pg8::EpiU, pg8::StaticOrder, true, true>(lds_p, g, S, E, tid);
                if (G > 64 && bid >= 64) s5w_gen(lds_p, (bf16*)(ws + WS_S5W), tid, bid - 64, G - 64);
            }
            SEAM(10);
            if (IN(11)) { PH_IDS(); REPL(11) s5_phase(lds_p, (const bf16*)(ws + WS_U), (const bf16*)(ws + WS_S5W), (bf16*)(ws + WS_Y), out, tid, wave, lane); }
            SEAM(11);
            if (IN(12)) { PH_IDS();
                pg8::Gemm g{(const bf16*)(ws + WS_Y), (const bf16*)(ws + WS_WGATE), M, D, D}; pg8::StaticOrder S; S.init(M, D, G, bid);
                pg8::EpiGate E{(const bf16*)(ws + WS_Y), (bf16*)(ws + WS_Y2)};
                pg8::gemm_phase<pg8::EpiGate, pg8::StaticOrder, true, true>(lds_p, g, S, E, tid);
                if (DEFER_P0 && DEFER_UP1 && G == 256 && bid >= 64) { const int sw = (bid - 64) * NWAVES + wave;
                    p0_weights(lds_p, ws, sw, 192 * NWAVES, wave, lane, 25344, 36352); p0_weights(lds_p, ws, sw, 192 * NWAVES, wave, lane, 41856, 44608); }
            }
            SEAM(12);
            if (IN(13)) { PH_IDS();
                pg8::Gemm g{(const bf16*)(ws + WS_Y2), (const bf16*)(ws + WS_WOUT), M, D, D}; pg8::TailOrder S; S.init(D, G, bid);
#if XB16
                pg8::EpiRes3<false> E{X1B, (pg8::bf16_t*)X1B, modl + 2 * 2048, (pg8::bf16_t*)SLABB};
                pg8::gemm_phase<pg8::EpiRes3<false>, pg8::TailOrder, true, true>(lds_p, g, S, E, tid);
#else
                pg8::EpiRes2 E{X1, X1, modl + 2 * 2048, (float*)(ws + WS_SLAB)};
                pg8::gemm_phase<pg8::EpiRes2, pg8::TailOrder, true, true>(lds_p, g, S, E, tid);
#endif
            }
            SEAM(13);
        }
        const int fb = l == 0 ? 5 : 14;
#if XB16
        if (IN(fb)) { PH_IDS();
            if (l == 0) norm_rows_b<true>(X1B, xs_off, ARG_IN(I_N2G), modl, 3, 4, HB, gw, NGW, lane, SLABB, modl + 2 * 2048, X1B);
            else norm_rows_b<false>(X1B, nullptr, ARG_IN(I_N2G) + D, modl, 3, 4, HB, gw, NGW, lane, SLABB, modl + 2 * 2048, X1B); }
#else
        if (IN(fb)) { PH_IDS(); norm_rows(X1, l == 0 ? xs_off : X1, ARG_IN(I_N2G) + l * D, modl, 3, 4, HB, gw, NGW, lane, (const float*)(ws + WS_SLAB), modl + 2 * 2048, X1); }
#endif
        SEAM(fb);
        if (IN(fb + 1)) { PH_IDS();
            pg8::Gemm g{HB, (const bf16*)(ws + (l == 0 ? WS_WUP0 : WS_WUP1)), M, F2, D}; pg8::UpOrder S; S.init(G, bid);
            pg8::EpiConv E{(bf16*)(ws + WS_ACT), ARG_IN(I_CONVW) + (size_t)l * 3 * F2, ARG_IN(I_CONVB) + (size_t)l * F2, (LAS float*)(lds_p + XCH_OFF)};
#ifdef PROBE_NULLEPI
            if (ARG_I32(3)) { pg8::EpiNull EN; pg8::gemm_phase<pg8::EpiNull, pg8::UpOrder, true, true>(lds_p, g, S, EN, tid); } else
#endif
            pg8::gemm_phase<pg8::EpiConv, pg8::UpOrder, true, true>(lds_p, g, S, E, tid);
            if (DEFER_P0 && G == 256 && bid >= 184) { if (l == 0) p0_weights(lds_p, ws, (bid - 184) * NWAVES + wave, 72 * NWAVES, wave, lane, 36352, 41856); else if (DEFER_UP1) p0_weights(lds_p, ws, (bid - 184) * NWAVES + wave, 72 * NWAVES, wave, lane, 44608, 47360); }
        }
        do { if (IN(fb + 1) && (IN(fb + 2) || IN(fb + 3))) { XcdBarrier bar_; bar_.bar = (unsigned*)((gu32*)(ARG_WS() + WS_CTL) + CW_BAR); bar_.x = xb_xcc_id(); bar_.st = (volatile LAS unsigned*)(lds + MISC_OFF) + 8; xcd_barrier(bar_); } } while (0);
        if (IN(fb + 3)) { PH_IDS();
            pg8::Gemm g{(const bf16*)(ws + WS_ACT), (const bf16*)(ws + (l == 0 ? WS_WDN0 : WS_WDN1)), M, D, FF}; pg8::TailOrder S; S.init(FF, G, bid);
#if XB16
            pg8::EpiRes3<false> E{X1B, (pg8::bf16_t*)X1B, modl + 5 * 2048, (pg8::bf16_t*)SLABB};
            pg8::gemm_phase<pg8::EpiRes3<false>, pg8::TailOrder, true, true>(lds_p, g, S, E, tid);
#else
            pg8::EpiRes2 E{X1, X1, modl + 5 * 2048, (float*)(ws + WS_SLAB)};
            pg8::gemm_phase<pg8::EpiRes2, pg8::TailOrder, true, true>(lds_p, g, S, E, tid);
#endif
        }
        SEAM(fb + 3);
    }
#if XB16
    if (IN(18)) { PH_IDS(); final_norm_rows_b(X1B, ARG_IN(I_FG), out + O_Y, gw, NGW, lane, SLABB, mod + (size_t)3 * 12288 + 5 * 2048); }
#else
    if (IN(18)) { PH_IDS(); REPL(18) final_norm_rows(X1, ARG_IN(I_FG), out + O_Y, gw, NGW, lane, (const float*)(ws + WS_SLAB), mod + (size_t)3 * 12288 + 5 * 2048); }
#endif
#ifdef PROBE_COPY
    if (IN(19)) { PH_IDS(); p0_weights(lds_p, ws, gw, NGW, wave, lane, 0, 47360); }
#endif
#undef IN
#undef SEAM
#undef ws
#undef out
#undef mod
#undef HB
#undef X1
#undef X1B
#undef SLABB
#undef xs_off
}
#if DBG_CHECKS
constexpr size_t WS_XBK = WS_S;
__device__ __forceinline__ unsigned hashu(unsigned x) { x ^= x >> 16; x *= 0x7feb352dU; x ^= x >> 15; x *= 0x846ca68bU; x ^= x >> 16; return x; }
__device__ __forceinline__ float bff(bf16 v) { return __uint_as_float((unsigned)v << 16); }
__device__ __forceinline__ void dacc(float* dbg, int stage, float got, float ref) { const float d = got - ref; atomicAdd(dbg + 2 * stage, d * d); atomicAdd(dbg + 2 * stage + 1, ref * ref); }
__device__ __forceinline__ float dotbf(const bf16* a, const bf16* b, int K) { float s = 0.f; for (int k = 0; k < K; ++k) s += bff(a[k]) * bff(b[k]); return s; }

__global__ void chk_mod(const float* adaw, const float* adab, const float* cctx, const float* cs, const float* mod, float* dbg) {
    const unsigned id = blockIdx.x * blockDim.x + threadIdx.x, hsh = hashu(id * 7919u + 13u);
    const int l = hsh & 1, cond = (hsh >> 1) % 3, n = (hsh >> 8) % 12288;
    const float* cv = cond == 0 ? cctx : cs + (cond - 1) * 2048;
    float s = adab[l * 12288 + n];
    for (int k = 0; k < 2048; ++k) s += silu_f(cv[k]) * adaw[((size_t)l * 2048 + k) * 12288 + n];
    dacc(dbg, 0, mod[(size_t)(l * 3 + cond) * 12288 + n], s);
}
__global__ void chk_wt(const float* W, const bf16* WT, int K, int N, float* dbg, int upw) {
    const unsigned id = blockIdx.x * blockDim.x + threadIdx.x, hsh = hashu(id * 7919u + 17u), h2 = hashu(hsh + 99u);
    const int k = hsh % K, n = h2 % N;
    dacc(dbg, 1, bff(WT[(size_t)(upw ? pg8::upw_row(n) : n) * K + k]), bff((bf16)f2bf(W[(size_t)k * N + n])));
}
__global__ void chk_cache(const float* ck, const float* cv, const bf16* Kf, const bf16* VTf, float* dbg) {
    const unsigned id = blockIdx.x * blockDim.x + threadIdx.x, hsh = hashu(id * 7919u + 19u);
    const int i = hsh % (2 * 512 * 2048), bt = i >> 11, col = i & 2047, b = bt >> 9, t = bt & 511, h = col >> 7, d = col & 127;
    dacc(dbg, 2, bff(Kf[pg8::seq_base_cache(b, h) + pg8::kf_off(t, d)]), ck[i]);
    dacc(dbg, 2, bff(VTf[pg8::seq_base_cache(b, h) + pg8::vtf_off(t, d)]), cv[i]);
}
__global__ void chk_norm(const float* xa, const float* xb, int xb_sub, const float* g, const float* modl, int jshift, int jscale, const bf16* out, float* dbg, int stage) {
    const unsigned id = blockIdx.x * blockDim.x + threadIdx.x, hsh = hashu(id * 7919u + 23u + stage), h2 = hashu(hsh + 5u);
    const int m = hsh % M, n = h2 % D;
    const float* xr = m < MP ? xa + (size_t)m * D : xb + (size_t)(m - xb_sub) * D;
    float ss = 0.f; for (int k = 0; k < D; ++k) ss += xr[k] * xr[k];
    const float rstd = 1.0f / sqrtf(ss / D + NORM_EPS); const int cond = m < MP ? 0 : 1 + ((m - MP) >> 10);
    const float ref = xr[n] * rstd * g[n] * (1.0f + modl[cond * 12288 + jscale * 2048 + n]) + modl[cond * 12288 + jshift * 2048 + n];
    dacc(dbg, stage, bff(out[(size_t)m * D + n]), ref);
}
__global__ void chk_final(const float* x, const float* g, const float* out, float* dbg, int stage) {
    const unsigned id = blockIdx.x * blockDim.x + threadIdx.x, hsh = hashu(id * 7919u + 29u), h2 = hashu(hsh + 5u);
    const int m = hsh % M, n = h2 % D; const float* xr = x + (size_t)m * D;
    float ss = 0.f; for (int k = 0; k < D; ++k) ss += xr[k] * xr[k];
    dacc(dbg, stage, out[(size_t)m * D + n], xr[n] / sqrtf(ss / D + NORM_EPS) * g[n]);
}
__global__ void chk_qkv(const bf16* HB, const bf16* Wt, const bf16* Q, const bf16* Kf, const bf16* VTf, const float* nk, const float* nv, float* dbg) {
    const unsigned id = blockIdx.x * blockDim.x + threadIdx.x, hsh = hashu(id * 7919u + 31u), h2 = hashu(hsh + 5u);
    const int m = hsh % M, n = h2 % (3 * D), sec = n / D, col = n % D, h = col >> 7, d = col & 127;
    const float acc = dotbf(HB + (size_t)m * D, Wt + (size_t)n * D, D);
    int t; const size_t sb = pg8::seq_base_row(m, h, t);
    if (sec == 0) dacc(dbg, 4, bff(Q[(size_t)m * D + col]), acc * C2);
    else if (sec == 1) { dacc(dbg, 4, bff(Kf[sb + pg8::kf_off(t, d)]), acc); if (m < MP) dacc(dbg, 4, nk[(size_t)m * D + col], acc); }
    else { dacc(dbg, 4, bff(VTf[sb + pg8::vtf_off(t, d)]), acc); if (m < MP) dacc(dbg, 4, nv[(size_t)m * D + col], acc); }
}
__device__ __forceinline__ float dotqk(const bf16* q, const bf16* Kf, size_t sb, int t) { float s = 0.f; for (int k = 0; k < HD; ++k) s += bff(q[k]) * bff(Kf[sb + pg8::kf_off(t, k)]); return s; }
__global__ void chk_attn(const bf16* Q, const bf16* Kf, const bf16* VTf, const float* rpb, const bf16* O, float* dbg) {
    const unsigned id = blockIdx.x * blockDim.x + threadIdx.x, hsh = hashu(id * 7919u + 37u), h2 = hashu(hsh + 5u);
    int m = hsh % M; if (id & 1) m = MP + (hsh % MS);
    const int h = h2 & 15, d = (h2 >> 4) & 127;
    const bf16* q = Q + (size_t)m * D + h * HD;
    float mx = -1e30f, l = 0.f, o = 0.f;
    auto step = [&](float lg, float v) { const float mn = fmaxf(mx, lg), a = exp2f(mx - mn), p = exp2f(lg - mn); l = l * a + p; o = o * a + p * v; mx = mn; };
    int tq; const size_t sb = pg8::seq_base_row(m, h, tq);
    if (m < MP) {
        for (int t = 0; t < 256; ++t) step(dotqk(q, Kf, sb, t), bff(VTf[sb + pg8::vtf_off(t, d)]));
    } else { const int b = (m - MP) >> 10, pos = tq, r = pos >> 6, wq = pos & 63, start = min(max(r - 4, 0), 8), cs = min(max(wq - 8, 0), 48);
        for (int j = 0; j < 8; ++j) for (int wk = cs; wk < cs + 16; ++wk) { const int t = (start + j) * 64 + wk;
            step(dotqk(q, Kf, sb, t) + rpb[(h * 15 + (start + j - r + 7)) * 31 + (wk - wq + 15)] * LOG2E, bff(VTf[sb + pg8::vtf_off(t, d)])); }
        const size_t sc = pg8::seq_base_cache(b, h);
        for (int t = 0; t < 512; ++t) step(dotqk(q, Kf, sc, t), bff(VTf[sc + pg8::vtf_off(t, d)]));
    }
    dacc(dbg, 5, bff(O[(size_t)m * D + h * HD + d]), o / l);
}
__global__ void chk_res(const bf16* A, const bf16* Bt, int K, const float* baseP, const float* baseS, int bs_sub, const float* gate, const float* out, float* dbg, int stage) {
    const unsigned id = blockIdx.x * blockDim.x + threadIdx.x, hsh = hashu(id * 7919u + 41u + stage), h2 = hashu(hsh + 5u);
    const int m = hsh % M, n = h2 % D, cond = m < MP ? 0 : 1 + ((m - MP) >> 10);
    const float acc = dotbf(A + (size_t)m * K, Bt + (size_t)n * K, K);
    const float ref = (m < MP ? baseP[(size_t)m * D + n] : baseS[(size_t)(m - bs_sub) * D + n]) + gate[cond * 12288 + n] * acc;
    dacc(dbg, stage, out[(size_t)m * D + n], ref);
}
__global__ void chk_gemm_bf(const bf16* A, const bf16* Bt, int K, int N, const bf16* O, float* dbg, int stage, int ulay) {
    const unsigned id = blockIdx.x * blockDim.x + threadIdx.x, hsh = hashu(id * 7919u + 43u + stage), h2 = hashu(hsh + 5u);
    const int m = hsh % M, n = h2 % N;
    dacc(dbg, stage, bff(O[ulay ? pg8::s5u_off(m, n) : (size_t)m * N + n]), dotbf(A + (size_t)m * K, Bt + (size_t)n * K, K));
}
__global__ void chk_gate(const bf16* Y, const bf16* Bt, const bf16* Y2, float* dbg, int stage) {
    const unsigned id = blockIdx.x * blockDim.x + threadIdx.x, hsh = hashu(id * 7919u + 47u), h2 = hashu(hsh + 5u);
    const int m = hsh % M, n = h2 % D;
    const float z = dotbf(Y + (size_t)m * D, Bt + (size_t)n * D, D);
    dacc(dbg, stage, bff(Y2[(size_t)m * D + n]), bff(Y[(size_t)m * D + n]) / (1.0f + expf(-z)));
}
__global__ void chk_upconv(const bf16* HB, const bf16* WupT, const float* cw, const float* cb, const bf16* act, float* dbg, int stage) {
    const unsigned id = blockIdx.x * blockDim.x + threadIdx.x, hsh = hashu(id * 7919u + 53u + stage), h2 = hashu(hsh + 5u);
    int m = hsh % M; const int f = h2 % FF;
    if ((id & 7) == 0) m = (m & ~255);
    if ((id & 7) == 1) m = (m | 255);
    if ((id & 7) == 2) m = (m & ~63);
    if ((id & 7) == 3) m = (m | 63);
    if ((id & 7) >= 6) m = MP + (hsh % MS);
    const int seqlen = m < MP ? SEQ : DSEQ, pos = m < MP ? (m & 255) : ((m - MP) & 1023);
    float z[2];
    for (int q = 0; q < 2; ++q) { const int c = f + q * FF; const bf16* wrow = WupT + (size_t)pg8::upw_row(c) * D;
        const float a = pos > 0 ? bff((bf16)f2bf(dotbf(HB + (size_t)(m - 1) * D, wrow, D))) : 0.f, b = bff((bf16)f2bf(dotbf(HB + (size_t)m * D, wrow, D))), d = pos + 1 < seqlen ? bff((bf16)f2bf(dotbf(HB + (size_t)(m + 1) * D, wrow, D))) : 0.f;
        z[q] = cw[c] * a + cw[F2 + c] * b + cw[2 * F2 + c] * d + cb[c]; }
    dacc(dbg, stage, bff(act[(size_t)m * FF + f]), z[0] / (1.0f + expf(-z[0])) * z[1]);
}
struct S5P { const float* p[8]; };
__global__ void chk_s5(const bf16* U, S5P inp, const float* sre, const float* sim, const bf16* Y, const float* out, float* dbg, int stage) {
    const float* are = inp.p[0]; const float* aim = inp.p[1]; const float* ldt = inp.p[2]; const float* bre = inp.p[3]; const float* bim = inp.p[4]; const float* cre = inp.p[5]; const float* cim = inp.p[6]; const float* sd = inp.p[7];
    const int wv = (blockIdx.x * blockDim.x + threadIdx.x) >> 6, p = threadIdx.x & 63;
    const unsigned hsh = hashu(wv * 7919u + 59u), h2 = hashu(hsh + 5u);
    const bool stchk = (wv & 3) == 3;
    int m = hsh % M; if (wv & 1) m = MP + (hsh % MS);
    if (stchk) m = hsh % MP;
    const int ch = h2 % D, g = ch >> 4, c = ch & 15;
    const int L = m < MP ? SEQ : DSEQ, tokbase = m < MP ? (m & ~255) : MP + ((m - MP) & ~1023), t = m - tokbase;
    float ysum = 0.f;
    for (int dir = 0; dir < 2; ++dir) {
        const double ar = are[(dir * NG + g) * SP + p], ai = aim[(dir * NG + g) * SP + p], dt = exp((double)ldt[dir * NG + g]);
        const double mag = exp(ar * dt), abr = mag * cos(ai * dt), abi = mag * sin(ai * dt), den = ar * ar + ai * ai, nr = abr - 1.0;
        const double cfr = (nr * ar + abi * ai) / den, cfi = (abi * ar - nr * ai) / den;
        float bbr[16], bbi[16];
#pragma unroll
        for (int q = 0; q < 16; ++q) { const double br = bre[((size_t)(dir * NG + g) * SP + p) * GC + q], bi = bim[((size_t)(dir * NG + g) * SP + p) * GC + q]; bbr[q] = (float)(cfr * br - cfi * bi); bbi[q] = (float)(cfr * bi + cfi * br); }
        float hr = 0.f, hi = 0.f;
        if (m >= MP) { const size_t si = ((size_t)(((m - MP) >> 10) * 2 + dir) * NG + g) * SP + p; hr = sre[si]; hi = sim[si]; }
        const int tend = stchk ? (dir ? 0 : L - 1) : t;
        for (int s = dir ? L - 1 : 0; dir ? s >= tend : s <= tend; s += dir ? -1 : 1) {
            float ur = 0.f, ui = 0.f;
#pragma unroll
            for (int q = 0; q < 16; ++q) { const float u = bff(U[pg8::s5u_off(tokbase + s, g * 16 + q)]); ur += bbr[q] * u; ui += bbi[q] * u; }
            const float n_r = (float)abr * hr - (float)abi * hi + ur, n_i = (float)abr * hi + (float)abi * hr + ui; hr = n_r; hi = n_i;
        }
        if (stchk) { const size_t so = ((size_t)((m >> 8) * 2 + dir) * NG + g) * SP + p; dacc(dbg, stage + 1, out[O_SRE + so], hr); dacc(dbg, stage + 1, out[O_SIM + so], hi); }
        ysum += hr * cre[((size_t)(dir * NG + g) * GC + c) * SP + p] - hi * cim[((size_t)(dir * NG + g) * GC + c) * SP + p];
    }
    if (!stchk) {
        float y = wave_sum(ysum) + sd[ch] * bff(U[pg8::s5u_off(m, ch)]);
        if (p == 0) { const float z = 0.7978845608028654f * (y + 0.044715f * y * y * y); dacc(dbg, stage, bff(Y[(size_t)m * D + ch]), 0.5f * y * (1.0f + tanhf(z))); }
    }
}
constexpr int DBG_NSTAGE = 22;
__device__ const float DBG_TOL[DBG_NSTAGE] = {1e-9f, 1e-12f, 2e-5f, 2e-5f, 2e-5f, 1e-4f, 1e-9f, 2e-5f, 2e-5f, 3e-5f, 1e-9f, 2e-5f, 2e-5f, 3e-4f, 3e-4f, 3e-5f, 1e-9f, 2e-5f, 2e-5f, 3e-5f, 1e-9f, 1e-9f};
__global__ void dbg_report(const float* dbg, float* out, size_t nout, int force_stage) {
    __shared__ float code;
    if (threadIdx.x == 0) {
        float cv = 0.f;
        for (int s = 0; s < DBG_NSTAGE; ++s) {
            const float num = dbg[2 * s], den = dbg[2 * s + 1]; const float r = num / den;
            if (num == 0.f && den == 0.f) continue;
            const bool bad = !(r <= DBG_TOL[s]) || !(den > 0.f);
            if ((force_stage < 0 && bad) || s == force_stage) {
                float lg = (r == r && r > 0.f) ? log10f(r) : (r == 0.f ? -8.f : 3.f); lg = fminf(fmaxf(lg, -8.f), 2.f);
                float mant = 1.0f + (lg + 8.0f) * 0.85f; if (!(r == r) || !(den > 0.f)) mant = 9.9f;
                cv = mant * powf(10.f, (float)(s + 3)); break; }
        }
        code = cv;
    }
    __syncthreads();
    const float cv = code;
    if (cv != 0.f) { for (size_t i = (size_t)blockIdx.x * blockDim.x + threadIdx.x; i < nout; i += (size_t)gridDim.x * blockDim.x) out[i] = (i == 0) ? cv : 0.f; }
}
#endif
#ifndef DBG_CHECKS
#define DBG_CHECKS 0
#endif
#ifndef N_LAUNCHES
#define N_LAUNCHES 1
#endif
#ifndef DBG_FORCE_STAGE
#define DBG_FORCE_STAGE (-1)
#endif
__global__ void err_code_kernel(float* o, float v) { if (threadIdx.x == 0 && blockIdx.x == 0) o[0] = v; }
extern "C" void kernel_launch(void* const* d_in, const int* in_sizes, int n_in, void* d_out, int out_size, void* d_ws, size_t ws_size, hipStream_t stream) {
    static int grid = 0;
    if (grid == 0) {
        size_t need = WS_END;
        if (n_in != N_IN || (size_t)out_size != O_END || ws_size < need) { fprintf(stderr, "kernel_launch: shape mismatch: n_in %d, out %d (want %zu), ws %zu (need %zu); nothing launched\n", n_in, out_size, (size_t)O_END, ws_size, need); grid = -1; return; }
        int dev = 0, cus = 0, per_cu = 0;
        if (hipGetDevice(&dev) != hipSuccess || hipDeviceGetAttribute(&cus, hipDeviceAttributeMultiprocessorCount, dev) != hipSuccess) { fprintf(stderr, "kernel_launch: device query failed\n"); grid = -1; return; }
        if (hipFuncSetAttribute((const void*)mega_fwd, hipFuncAttributeMaxDynamicSharedMemorySize, LDS_BYTES) != hipSuccess) { fprintf(stderr, "kernel_launch: hipFuncSetAttribute failed\n"); grid = -1; return; }
        if (hipOccupancyMaxActiveBlocksPerMultiprocessor(&per_cu, (const void*)mega_fwd, NTHR, LDS_BYTES) != hipSuccess || per_cu < 1) fprintf(stderr, "kernel_launch: note: occupancy query reports %d workgroups per CU\n", per_cu);
        (void)hipGetLastError();
        grid = cus;
    }
    if (grid < 0) { if (out_size > 0) hipLaunchKernelGGL(err_code_kernel, dim3(1), dim3(64), 0, stream, (float*)d_out, 7.7e37f); return; }
    unsigned char* ws = (unsigned char*)d_ws;
    (void)hipMemsetAsync(ws + WS_CTL, 0, CTL_ZERO_BYTES, stream);
    Args a{};
    for (int i = 0; i < N_IN; ++i) a.in[i] = (const float*)d_in[i];
    a.out = (float*)d_out; a.ws = ws;
#if !DBG_CHECKS
    if (N_LAUNCHES == 1) { a.ph_lo = 0; a.ph_hi = N_PHASES; a.use_bar = 1; hipLaunchKernelGGL(mega_fwd, dim3(grid), dim3(NTHR), LDS_BYTES, stream, a); }
    else for (int p = 0; p < N_PHASES; ++p) { a.ph_lo = p; a.ph_hi = p + 1; a.use_bar = 0; hipLaunchKernelGGL(mega_fwd, dim3(grid), dim3(NTHR), LDS_BYTES, stream, a); }
#ifdef PROBE_PHASE
#ifndef PROBE_VARIANT
#define PROBE_VARIANT 0
#endif
    for (int r = 0; r < PROBE_REPS; ++r) { a.ph_lo = PROBE_PHASE; a.ph_hi = PROBE_PHASE + 1; a.use_bar = 0; a.pad = PROBE_VARIANT; hipLaunchKernelGGL(mega_fwd, dim3(grid), dim3(NTHR), LDS_BYTES, stream, a); }
#endif
#ifdef PROBE_COPY
    for (int r = 0; r < PROBE_COPY; ++r) { a.ph_lo = 19; a.ph_hi = 20; a.use_bar = 0; hipLaunchKernelGGL(mega_fwd, dim3(grid), dim3(NTHR), LDS_BYTES, stream, a); }
#endif
#else
    float* dbg = (float*)(ws + WS_DBG); float* out = (float*)d_out; const float* const* in = (const float* const*)a.in;
    float* mod = (float*)(ws + WS_MOD); bf16* HB = (bf16*)(ws + WS_HB); float* X1 = (float*)(ws + WS_X1); float* XBK = (float*)(ws + WS_XBK);
    const dim3 cg(32), cb(256);
    for (int p = 0; p < N_PHASES; ++p) {
        if (p == 8 || p == 13 || p == 17) (void)hipMemcpyAsync(XBK, X1, (size_t)M * D * 4, hipMemcpyDeviceToDevice, stream);
        a.ph_lo = p; a.ph_hi = p + 1; a.use_bar = 0; hipLaunchKernelGGL(mega_fwd, dim3(grid), dim3(NTHR), LDS_BYTES, stream, a);
        const int l = p >= 9 ? 1 : 0; const float* modl = mod + (size_t)l * 3 * 12288;
        switch (p) {
        case 0:
            hipLaunchKernelGGL(chk_mod, cg, cb, 0, stream, a.in[I_ADAW], a.in[I_ADAB], a.in[I_CCTX], a.in[I_C], mod, dbg);
            hipLaunchKernelGGL(chk_wt, cg, cb, 0, stream, a.in[I_WQKV], (const bf16*)(ws + WS_WQKV), D, 3 * D, dbg, 0);
            hipLaunchKernelGGL(chk_wt, cg, cb, 0, stream, a.in[I_WIN], (const bf16*)(ws + WS_WIN), D, D, dbg, 0);
            hipLaunchKernelGGL(chk_wt, cg, cb, 0, stream, a.in[I_WGATE], (const bf16*)(ws + WS_WGATE), D, D, dbg, 0);
            hipLaunchKernelGGL(chk_wt, cg, cb, 0, stream, a.in[I_WOUT], (const bf16*)(ws + WS_WOUT), D, D, dbg, 0);
            hipLaunchKernelGGL(chk_wt, cg, cb, 0, stream, a.in[I_WUP], (const bf16*)(ws + WS_WUP0), D, F2, dbg, 1);
            hipLaunchKernelGGL(chk_cache, cg, cb, 0, stream, a.in[I_CK], a.in[I_CV], (const bf16*)(ws + WS_KF), (const bf16*)(ws + WS_VTF), dbg);
            break;
        case 1: hipLaunchKernelGGL(chk_norm, cg, cb, 0, stream, a.in[I_XP], a.in[I_XS], (int)MP, a.in[I_N1G], modl, 0, 1, (const bf16*)HB, dbg, 3); break;
        case 2: hipLaunchKernelGGL(chk_wt, cg, cb, 0, stream, a.in[I_WO], (const bf16*)(ws + WS_WO), D, D, dbg, 0); hipLaunchKernelGGL(chk_qkv, cg, cb, 0, stream, (const bf16*)HB, (const bf16*)(ws + WS_WQKV), (const bf16*)(ws + WS_Q), (const bf16*)(ws + WS_KF), (const bf16*)(ws + WS_VTF), (const float*)(out + O_NK), (const float*)(out + O_NV), dbg); break;
        case 3: hipLaunchKernelGGL(chk_attn, cg, cb, 0, stream, (const bf16*)(ws + WS_Q), (const bf16*)(ws + WS_KF), (const bf16*)(ws + WS_VTF), a.in[I_RPB], (const bf16*)(ws + WS_O), dbg); break;
        case 5: hipLaunchKernelGGL(chk_norm, cg, cb, 0, stream, (const float*)X1, (const float*)X1, 0, a.in[I_N2G], modl, 3, 4, (const bf16*)HB, dbg, 7); hipLaunchKernelGGL(chk_res, cg, cb, 0, stream, (const bf16*)(ws + WS_O), (const bf16*)(ws + WS_WO), D, a.in[I_XP], a.in[I_XS], (int)MP, (mod + (size_t)0 * 3 * 12288) + 2 * 2048, (const float*)X1, dbg, 6); break;
        case 6: hipLaunchKernelGGL(chk_wt, cg, cb, 0, stream, a.in[I_WDN], (const bf16*)(ws + WS_WDN0), FF, D, dbg, 0); break;
        case 7: hipLaunchKernelGGL(chk_upconv, cg, cb, 0, stream, (const bf16*)HB, (const bf16*)(ws + WS_WUP0), a.in[I_CONVW], a.in[I_CONVB], (const bf16*)(ws + WS_ACT), dbg, 9); break;
        case 9: hipLaunchKernelGGL(chk_norm, cg, cb, 0, stream, (const float*)X1, (const float*)X1, 0, a.in[I_N1G] + D, modl, 0, 1, (const bf16*)HB, dbg, 11); hipLaunchKernelGGL(chk_res, cg, cb, 0, stream, (const bf16*)(ws + WS_ACT), (const bf16*)(ws + WS_WDN0), FF, (const float*)XBK, (const float*)XBK, 0, (mod + (size_t)0 * 3 * 12288) + 5 * 2048, (const float*)X1, dbg, 10); break;
        case 10: hipLaunchKernelGGL(chk_gemm_bf, cg, cb, 0, stream, (const bf16*)HB, (const bf16*)(ws + WS_WIN), D, D, (const bf16*)(ws + WS_U), dbg, 12, 1); break;
        case 11: { S5P sp; sp.p[0] = a.in[I_ARE]; sp.p[1] = a.in[I_AIM]; sp.p[2] = a.in[I_LOGDT]; sp.p[3] = a.in[I_BRE]; sp.p[4] = a.in[I_BIM]; sp.p[5] = a.in[I_CRE]; sp.p[6] = a.in[I_CIM]; sp.p[7] = a.in[I_SD];
            hipLaunchKernelGGL(chk_s5, dim3(128), cb, 0, stream, (const bf16*)(ws + WS_U), sp, a.in[I_SRE], a.in[I_SIM], (const bf16*)(ws + WS_Y), (const float*)out, dbg, 13); } break;
        case 12: hipLaunchKernelGGL(chk_wt, cg, cb, 0, stream, a.in[I_WUP] + (size_t)D * F2, (const bf16*)(ws + WS_WUP1), D, F2, dbg, 1); hipLaunchKernelGGL(chk_wt, cg, cb, 0, stream, a.in[I_WDN] + (size_t)FF * D, (const bf16*)(ws + WS_WDN1), FF, D, dbg, 0); hipLaunchKernelGGL(chk_gate, cg, cb, 0, stream, (const bf16*)(ws + WS_Y), (const bf16*)(ws + WS_WGATE), (const bf16*)(ws + WS_Y2), dbg, 15); break;
        case 14: hipLaunchKernelGGL(chk_norm, cg, cb, 0, stream, (const float*)X1, (const float*)X1, 0, a.in[I_N2G] + D, modl, 3, 4, (const bf16*)HB, dbg, 17); hipLaunchKernelGGL(chk_res, cg, cb, 0, stream, (const bf16*)(ws + WS_Y2), (const bf16*)(ws + WS_WOUT), D, (const float*)XBK, (const float*)XBK, 0, (mod + (size_t)1 * 3 * 12288) + 2 * 2048, (const float*)X1, dbg, 16); break;
        case 16: hipLaunchKernelGGL(chk_upconv, cg, cb, 0, stream, (const bf16*)HB, (const bf16*)(ws + WS_WUP1), a.in[I_CONVW] + (size_t)3 * F2, a.in[I_CONVB] + F2, (const bf16*)(ws + WS_ACT), dbg, 19); break;
        case 18: hipLaunchKernelGGL(chk_final, cg, cb, 0, stream, (const float*)X1, a.in[I_FG], (const float*)out, dbg, 21); hipLaunchKernelGGL(chk_res, cg, cb, 0, stream, (const bf16*)(ws + WS_ACT), (const bf16*)(ws + WS_WDN1), FF, (const float*)XBK, (const float*)XBK, 0, (mod + (size_t)1 * 3 * 12288) + 5 * 2048, (const float*)X1, dbg, 20); break;
        }
    }
    hipLaunchKernelGGL(dbg_report, dim3(1024), dim3(256), 0, stream, (const float*)dbg, out, (size_t)O_END, (int)DBG_FORCE_STAGE);
#endif
}
```

```cpp
#define DBG_CHECKS 0
#include <hip/hip_runtime.h>
#include <cstdio>
#include <cstdint>
namespace pg8 {
#define PG8_LAS __attribute__((address_space(3)))
typedef unsigned short bf16_t;
typedef short bf16x8 __attribute__((ext_vector_type(8)));
typedef float f32x4 __attribute__((ext_vector_type(4)));
typedef unsigned u32x4 __attribute__((ext_vector_type(4)));
constexpr int BM = 256, BK = 64, HALF = 128, HTB = HALF * BK * 2  , STAGE_BYTES = 8 * HTB, NXCD = 8, WGM = 8;

__host__ __device__ __forceinline__ int lds_byte(int r, int c) { const int st = (r >> 4) * 2 + (c >> 5), rr = r & 15, cc = c & 31, ob = rr * 64 + cc * 2; return st * 1024 + (ob ^ (((ob >> 9) & 1) << 5)); }
__host__ __device__ __forceinline__ void stage_rc(int b, int& R, int& C) { const int st = b / 1024, sb = b % 1024, swz = sb ^ (((sb >> 9) & 1) << 5); R = (st >> 1) * 16 + swz / 64; C = (st & 1) * 32 + (swz % 64) / 2; }
__host__ __device__ __forceinline__ int perm32(int rho) { const int n = rho >> 4, i = rho & 15; return 8 * (i >> 2) + 4 * n + (i & 3); }

struct Unit { int pm, pn; int k0 = 0, nk = 0, sl = -1; };
struct Gemm { const bf16_t* A; const bf16_t* Bt; int M, N, K; };

struct StaticOrder {
    int nM, nN, nwg, G, c;
    __host__ __device__ void init(int M, int N, int G_, int c_) { nM = M / BM; nN = N / BM; nwg = nM * nN; G = G_; c = c_; }
    __host__ __device__ __forceinline__ bool next(int i, Unit& u) const {
        const long L = (long)i * G + c; if (L >= nwg) return false;
        int wgid = (int)L; { const int q = nwg / NXCD, r = nwg % NXCD, xcd = wgid % NXCD, off = wgid / NXCD; wgid = (xcd < r ? xcd * (q + 1) : r * (q + 1) + (xcd - r) * q) + off; }
        const int nig = WGM * nN, gid = wgid / nig, fm = gid * WGM, gsz = (nM - fm) < WGM ? (nM - fm) : WGM;
        u.pm = fm + ((wgid % nig) % gsz); u.pn = (wgid % nig) / gsz; return true;
    }
    __device__ __forceinline__ void a_ready(const Unit&) const {}
    __device__ __forceinline__ void done(const Unit&) const {}
};

__device__ __forceinline__ unsigned cvt_pk_bf16(float lo, float hi) { unsigned r; asm volatile("v_cvt_pk_bf16_f32 %0, %1, %2" : "=v"(r) : "v"(lo), "v"(hi)); return r; }
typedef float f32x2 __attribute__((ext_vector_type(2)));
__device__ __forceinline__ f32x2 gelu_pk(f32x2 v) {
    const f32x2 av = __builtin_elementwise_abs(v), d = av * 0.2316418882f + 1.0f;
    f32x2 t; t.x = __builtin_amdgcn_rcpf(d.x); t.y = __builtin_amdgcn_rcpf(d.y);
    f32x2 q = t * 0.5307027145f + (-0.7265760135f); q = q * t + 0.7107068705f; q = q * t + (-0.142248368f); q = q * t + 0.127414796f; q = q * t;
    const f32x2 s = (v * v) * (-0.72134752044f);
    f32x2 e; e.x = __builtin_amdgcn_exp2f(s.x); e.y = __builtin_amdgcn_exp2f(s.y);
    const f32x2 m = v * (q * e), r = v - m;
    f32x2 o; o.x = v.x < 0.f ? m.x : r.x; o.y = v.y < 0.f ? m.y : r.y; return o;
}

template <int ACT  > struct EpiBf16 {
    static constexpr bool PERM = true, AFTER_DRAIN = false; static_assert(ACT == 0 || ACT == 1, "EpiBf16: ACT is 0 (none) or 1 (gelu_pk)");
    bf16_t* O; int ldc; const float* bias; int split_cols; size_t split_stride; float scale0;
    __device__ __forceinline__ void operator()(const f32x4 (&acc)[2][2][4][2], const Unit& u, int wr, int wc, int fr, int fq) const {
        const int row0 = u.pm * BM + wr * 64 + fr; int colt = u.pn * BM; bf16_t* base = O;
        float sc = 1.f; if (split_cols) { const int t = colt / split_cols; base += (size_t)t * split_stride; colt -= t * split_cols; if (t == 0) sc = scale0; }
        const int col0 = colt + wc * 32 + 8 * fq, bcol0 = u.pn * BM + wc * 32 + 8 * fq;
        f32x4 bv[2][2];
#pragma unroll
        for (int bj = 0; bj < 2; ++bj)
#pragma unroll
            for (int n = 0; n < 2; ++n) bv[bj][n] = bias ? *(const f32x4*)(bias + bcol0 + bj * HALF + 4 * n) : (f32x4){0.f, 0.f, 0.f, 0.f};
#pragma unroll
        for (int ai = 0; ai < 2; ++ai)
#pragma unroll
            for (int m = 0; m < 4; ++m) { bf16_t* rowp = base + (size_t)(row0 + ai * HALF + m * 16) * ldc + col0;
#pragma unroll
                for (int bj = 0; bj < 2; ++bj) { f32x4 v0 = acc[ai][bj][m][0] + bv[bj][0], v1 = acc[ai][bj][m][1] + bv[bj][1];
                    if (ACT == 1) { f32x2 a = gelu_pk((f32x2){v0[0], v0[1]}), b = gelu_pk((f32x2){v0[2], v0[3]}), c = gelu_pk((f32x2){v1[0], v1[1]}), d = gelu_pk((f32x2){v1[2], v1[3]});
                        v0 = (f32x4){a.x, a.y, b.x, b.y}; v1 = (f32x4){c.x, c.y, d.x, d.y}; }
                    v0 = v0 * sc; v1 = v1 * sc; u32x4 w; w.x = cvt_pk_bf16(v0[0], v0[1]); w.y = cvt_pk_bf16(v0[2], v0[3]); w.z = cvt_pk_bf16(v1[0], v1[1]); w.w = cvt_pk_bf16(v1[2], v1[3]);
                    *(u32x4*)(rowp + bj * HALF) = w; } }
    }
};

typedef unsigned u32x2 __attribute__((ext_vector_type(2)));
__host__ __device__ __forceinline__ int perm16(int ko) { return 8 * ((ko >> 2) & 1) + (ko & 3) + 4 * (ko >> 3); }


constexpr size_t KF_SAMPLE = (size_t)32 * 16 * 256 * 128, KF_CACHE = KF_SAMPLE + (size_t)2 * 16 * 1024 * 128, KF_TOTAL = KF_CACHE + (size_t)2 * 16 * 512 * 128;
__host__ __device__ __forceinline__ size_t kf_off(int t, int d) { return (((size_t)((t >> 5) * 8 + (d >> 4)) * 64 + ((d >> 3) & 1) * 32 + (t & 31)) * 8 + (d & 7)); }
__host__ __device__ __forceinline__ size_t vtf_off(int t, int d) { const int ko32 = t & 31, ko = ko32 & 15; return ((((size_t)((t >> 5) * 2 + (ko32 >> 4)) * 4 + (d >> 5)) * 64 + ((ko >> 2) & 1) * 32 + (d & 31)) * 8 + (ko & 3) + 4 * (ko >> 3)); }
__host__ __device__ __forceinline__ size_t seq_base_row(int row, int h, int& t) { if (row < 8192) { t = row & 255; return (size_t)((row >> 8) * 16 + h) * 256 * 128; } const int rs = row - 8192; t = rs & 1023; return KF_SAMPLE + (size_t)((rs >> 10) * 16 + h) * 1024 * 128; }
__host__ __device__ __forceinline__ size_t seq_base_cache(int b, int h) { return KF_CACHE + (size_t)(b * 16 + h) * 512 * 128; }

struct EpiQKV {
    static constexpr bool PERM = true, AFTER_DRAIN = false;
    bf16_t* Q; bf16_t* Kf; bf16_t* VTf; float* nk; float* nv; float c2;
    __device__ __forceinline__ void operator()(const f32x4 (&acc)[2][2][4][2], const Unit& u, int wr, int wc, int fr, int fq) const {
        const int sec = u.pn >> 3, colt = (u.pn & 7) * BM;
        const int row0 = u.pm * BM + wr * 64 + fr, col0 = colt + wc * 32 + 8 * fq;
        const bool prompt = u.pm < 32;
#pragma unroll
        for (int ai = 0; ai < 2; ++ai)
#pragma unroll
            for (int m = 0; m < 4; ++m) {
                const int row = row0 + ai * HALF + m * 16;
#pragma unroll
                for (int bj = 0; bj < 2; ++bj) {
                    f32x4 v0 = acc[ai][bj][m][0], v1 = acc[ai][bj][m][1];
                    const int col = col0 + bj * HALF;
                    const size_t off = (size_t)row * 2048 + col;
                    if (sec == 0) {
                        v0 = v0 * c2; v1 = v1 * c2;
                        u32x4 w; w.x = cvt_pk_bf16(v0[0], v0[1]); w.y = cvt_pk_bf16(v0[2], v0[3]); w.z = cvt_pk_bf16(v1[0], v1[1]); w.w = cvt_pk_bf16(v1[2], v1[3]);
                        *(u32x4*)(Q + off) = w;
                    } else if (sec == 1) {
                        u32x4 w; w.x = cvt_pk_bf16(v0[0], v0[1]); w.y = cvt_pk_bf16(v0[2], v0[3]); w.z = cvt_pk_bf16(v1[0], v1[1]); w.w = cvt_pk_bf16(v1[2], v1[3]);
                        int t; const size_t sb = seq_base_row(row, col >> 7, t);
                        *(u32x4*)(Kf + sb + kf_off(t, col & 127)) = w;
                        if (prompt) { *(f32x4*)(nk + off) = v0; *(f32x4*)(nk + off + 4) = v1; }
                    } else {
                        if (prompt) { *(f32x4*)(nv + off) = v0; *(f32x4*)(nv + off + 4) = v1; }
                        const unsigned w0 = cvt_pk_bf16(v0[0], v0[1]), w1 = cvt_pk_bf16(v0[2], v0[3]), w2 = cvt_pk_bf16(v1[0], v1[1]), w3 = cvt_pk_bf16(v1[2], v1[3]);
                        int t; const size_t sb = seq_base_row(row, col >> 7, t);
                        bf16_t* p = VTf + sb + vtf_off(t, col & 127);
                        constexpr int st = 8;
                        p[0] = (bf16_t)(w0 & 0xffffu); p[st] = (bf16_t)(w0 >> 16); p[2 * st] = (bf16_t)(w1 & 0xffffu); p[3 * st] = (bf16_t)(w1 >> 16);
                        p[4 * st] = (bf16_t)(w2 & 0xffffu); p[5 * st] = (bf16_t)(w2 >> 16); p[6 * st] = (bf16_t)(w3 & 0xffffu); p[7 * st] = (bf16_t)(w3 >> 16);
                    }
                }
            }
    }
};

struct EpiRes {
    static constexpr bool PERM = false, AFTER_DRAIN = false;
    const float* baseP; const float* baseS; float* out; const float* gate;
    __device__ __forceinline__ void operator()(const f32x4 (&acc)[2][2][4][2], const Unit& u, int wr, int wc, int fr, int fq) const {
        const int cond = u.pm < 32 ? 0 : 1 + ((u.pm - 32) >> 2);
        const float* g = gate + cond * 12288; const float* base = u.pm < 32 ? baseP : baseS;
        const int row0 = u.pm * BM + wr * 64 + fr, col0 = u.pn * BM + wc * 32 + 4 * fq;
        f32x4 gv[2][2];
#pragma unroll
        for (int bj = 0; bj < 2; ++bj)
#pragma unroll
            for (int n = 0; n < 2; ++n) gv[bj][n] = *(const f32x4*)(g + col0 + bj * HALF + n * 16);
#pragma unroll
        for (int ai = 0; ai < 2; ++ai)
#pragma unroll
            for (int m = 0; m < 4; ++m) { const size_t off = (size_t)(row0 + ai * HALF + m * 16) * 2048 + col0;
#pragma unroll
                for (int bj = 0; bj < 2; ++bj)
#pragma unroll
                    for (int n = 0; n < 2; ++n) { const f32x4 bs = *(const f32x4*)(base + off + bj * HALF + n * 16); *(f32x4*)(out + off + bj * HALF + n * 16) = bs + gv[bj][n] * acc[ai][bj][m][n]; }
                if (m & 1) asm volatile("" ::: "memory"); }
    }
};

struct EpiGate {
    static constexpr bool PERM = true, AFTER_DRAIN = false;
    const bf16_t* Y; bf16_t* Y2;
    __device__ __forceinline__ void operator()(const f32x4 (&acc)[2][2][4][2], const Unit& u, int wr, int wc, int fr, int fq) const {
        const int row0 = u.pm * BM + wr * 64 + fr, col0 = u.pn * BM + wc * 32 + 8 * fq;
#pragma unroll
        for (int ai = 0; ai < 2; ++ai)
#pragma unroll
            for (int m = 0; m < 4; ++m) {
#pragma unroll
                for (int bj = 0; bj < 2; ++bj) {
                    const size_t off = (size_t)(row0 + ai * HALF + m * 16) * 2048 + col0 + bj * HALF;
                    const u32x4 yv = *(const u32x4*)(Y + off);
                    const f32x4 z0 = acc[ai][bj][m][0], z1 = acc[ai][bj][m][1];
                    float y[8], o[8];
                    y[0] = __uint_as_float(yv.x << 16); y[1] = __uint_as_float(yv.x & 0xffff0000u); y[2] = __uint_as_float(yv.y << 16); y[3] = __uint_as_float(yv.y & 0xffff0000u);
                    y[4] = __uint_as_float(yv.z << 16); y[5] = __uint_as_float(yv.z & 0xffff0000u); y[6] = __uint_as_float(yv.w << 16); y[7] = __uint_as_float(yv.w & 0xffff0000u);
#pragma unroll
                    for (int e = 0; e < 4; ++e) { o[e] = y[e] * __builtin_amdgcn_rcpf(1.0f + __builtin_amdgcn_exp2f(-1.4426950408889634f * z0[e])); o[4 + e] = y[4 + e] * __builtin_amdgcn_rcpf(1.0f + __builtin_amdgcn_exp2f(-1.4426950408889634f * z1[e])); }
                    u32x4 w; w.x = cvt_pk_bf16(o[0], o[1]); w.y = cvt_pk_bf16(o[2], o[3]); w.z = cvt_pk_bf16(o[4], o[5]); w.w = cvt_pk_bf16(o[6], o[7]);
                    *(u32x4*)(Y2 + off) = w;
                }
            }
    }
};


struct TailOrder {
    int G, c, q, r;
    __host__ __device__ void init(int K, int G_, int c_) { G = G_; c = c_; const int pairs = K / (2 * BK); q = pairs / 4; r = pairs % 4; }
    __host__ __device__ __forceinline__ bool next(int i, Unit& u) const {
        int L = i * G + c; if (L >= 512) return false;
        if (G == 256 && (c & 1)) L = (1 - i) * G + c;
        const int Lf = L < 256 ? L : 255, w = (Lf % NXCD) * 32 + Lf / NXCD, nig = WGM * 8, fm = (w / nig) * WGM;
        const int fpm = fm + ((w % nig) % WGM), fpn = (w % nig) / WGM;
        const int j = L < 256 ? 0 : L - 256, tile = j >> 2, s = j & 3;
        const bool isf = L < 256;
        u.pm = isf ? fpm : 32 + (tile >> 3); u.pn = isf ? fpn : (tile & 7); u.sl = isf ? -1 : s;
        u.k0 = isf ? 0 : 2 * (s * q + (s < r ? s : r)); u.nk = isf ? 0 : 2 * (q + (s < r ? 1 : 0)); return true;
    }
    __device__ __forceinline__ void a_ready(const Unit&) const {}
    __device__ __forceinline__ void done(const Unit&) const {}
};
struct EpiRes2 {
    static constexpr bool PERM = false, AFTER_DRAIN = false;
    const float* baseP; float* out; const float* gate; float* slab;
    __device__ __forceinline__ void operator()(const f32x4 (&acc)[2][2][4][2], const Unit& u, int wr, int wc, int fr, int fq) const {
        const int row0 = u.pm * BM + wr * 64 + fr, col0 = u.pn * BM + wc * 32 + 4 * fq;
        if (u.sl < 0) {
            f32x4 gv[2][2];
#pragma unroll
            for (int bj = 0; bj < 2; ++bj)
#pragma unroll
                for (int n = 0; n < 2; ++n) gv[bj][n] = *(const f32x4*)(gate + col0 + bj * HALF + n * 16);
#pragma unroll
            for (int ai = 0; ai < 2; ++ai)
#pragma unroll
                for (int m = 0; m < 4; ++m) { const size_t off = (size_t)(row0 + ai * HALF + m * 16) * 2048 + col0;
#pragma unroll
                    for (int bj = 0; bj < 2; ++bj)
#pragma unroll
                        for (int n = 0; n < 2; ++n) { const f32x4 bs = *(const f32x4*)(baseP + off + bj * HALF + n * 16); *(f32x4*)(out + off + bj * HALF + n * 16) = bs + gv[bj][n] * acc[ai][bj][m][n]; }
                    if (m & 1) asm volatile("" ::: "memory"); }
        } else {
            float* sp = slab + (size_t)u.sl * 2048 * 2048;
#pragma unroll
            for (int ai = 0; ai < 2; ++ai)
#pragma unroll
                for (int m = 0; m < 4; ++m) { const size_t off = (size_t)(row0 - 8192 + ai * HALF + m * 16) * 2048 + col0;
#pragma unroll
                    for (int bj = 0; bj < 2; ++bj)
#pragma unroll
                        for (int n = 0; n < 2; ++n) *(f32x4*)(sp + off + bj * HALF + n * 16) = acc[ai][bj][m][n]; }
        }
    }
};


template <bool BASE_F32>
struct EpiRes3 {
    static constexpr bool PERM = true, AFTER_DRAIN = false;
    const void* baseP; bf16_t* out; const float* gate; bf16_t* slab;
    __device__ __forceinline__ void operator()(const f32x4 (&acc)[2][2][4][2], const Unit& u, int wr, int wc, int fr, int fq) const {
        const int row0 = u.pm * BM + wr * 64 + fr, col0 = u.pn * BM + wc * 32 + 8 * fq;
        if (u.sl < 0) {
            f32x4 gv[2][2];
#pragma unroll
            for (int bj = 0; bj < 2; ++bj)
#pragma unroll
                for (int n = 0; n < 2; ++n) gv[bj][n] = *(const f32x4*)(gate + col0 + bj * HALF + n * 4);
            if constexpr (!BASE_F32) {
                u32x4 bv[2][4][2];
#pragma unroll
                for (int ai = 0; ai < 2; ++ai)
#pragma unroll
                    for (int m = 0; m < 4; ++m)
#pragma unroll
                        for (int bj = 0; bj < 2; ++bj) bv[ai][m][bj] = *(const u32x4*)((const bf16_t*)baseP + (size_t)(row0 + ai * HALF + m * 16) * 2048 + col0 + bj * HALF);
                asm volatile("" ::: "memory");
#pragma unroll
                for (int ai = 0; ai < 2; ++ai)
#pragma unroll
                    for (int m = 0; m < 4; ++m) { const size_t off = (size_t)(row0 + ai * HALF + m * 16) * 2048 + col0;
#pragma unroll
                        for (int bj = 0; bj < 2; ++bj) { const u32x4 b = bv[ai][m][bj];
                            const f32x4 b0 = (f32x4){__uint_as_float(b.x << 16), __uint_as_float(b.x & 0xffff0000u), __uint_as_float(b.y << 16), __uint_as_float(b.y & 0xffff0000u)};
                            const f32x4 b1 = (f32x4){__uint_as_float(b.z << 16), __uint_as_float(b.z & 0xffff0000u), __uint_as_float(b.w << 16), __uint_as_float(b.w & 0xffff0000u)};
                            const f32x4 o0 = b0 + gv[bj][0] * acc[ai][bj][m][0], o1 = b1 + gv[bj][1] * acc[ai][bj][m][1];
                            u32x4 w; w.x = cvt_pk_bf16(o0[0], o0[1]); w.y = cvt_pk_bf16(o0[2], o0[3]); w.z = cvt_pk_bf16(o1[0], o1[1]); w.w = cvt_pk_bf16(o1[2], o1[3]);
                            *(u32x4*)(out + off + bj * HALF) = w; } }
            } else {
#pragma unroll
            for (int ai = 0; ai < 2; ++ai)
#pragma unroll
                for (int m = 0; m < 4; ++m) { const size_t off = (size_t)(row0 + ai * HALF + m * 16) * 2048 + col0;
#pragma unroll
                    for (int bj = 0; bj < 2; ++bj) {
                        const f32x4 b0 = *(const f32x4*)((const float*)baseP + off + bj * HALF), b1 = *(const f32x4*)((const float*)baseP + off + bj * HALF + 4);
                        const f32x4 o0 = b0 + gv[bj][0] * acc[ai][bj][m][0], o1 = b1 + gv[bj][1] * acc[ai][bj][m][1];
                        u32x4 w; w.x = cvt_pk_bf16(o0[0], o0[1]); w.y = cvt_pk_bf16(o0[2], o0[3]); w.z = cvt_pk_bf16(o1[0], o1[1]); w.w = cvt_pk_bf16(o1[2], o1[3]);
                        *(u32x4*)(out + off + bj * HALF) = w; }
                    if (m & 1) asm volatile("" ::: "memory"); }
            }
        } else {
            bf16_t* sp = slab + (size_t)u.sl * 2048 * 2048;
#pragma unroll
            for (int ai = 0; ai < 2; ++ai)
#pragma unroll
                for (int m = 0; m < 4; ++m) { const size_t off = (size_t)(row0 - 8192 + ai * HALF + m * 16) * 2048 + col0;
#pragma unroll
                    for (int bj = 0; bj < 2; ++bj) { const f32x4 v0 = acc[ai][bj][m][0], v1 = acc[ai][bj][m][1];
                        u32x4 w; w.x = cvt_pk_bf16(v0[0], v0[1]); w.y = cvt_pk_bf16(v0[2], v0[3]); w.z = cvt_pk_bf16(v1[0], v1[1]); w.w = cvt_pk_bf16(v1[2], v1[3]);
                        *(u32x4*)(sp + off + bj * HALF) = w; } }
        }
    }
};

struct EpiNull {
    static constexpr bool PERM = true, AFTER_DRAIN = false;
    __device__ __forceinline__ void operator()(const f32x4 (&acc)[2][2][4][2], const Unit& u, int wr, int wc, int fr, int fq) const {
#pragma unroll
        for (int a = 0; a < 2; ++a)
#pragma unroll
            for (int b = 0; b < 2; ++b)
#pragma unroll
                for (int m = 0; m < 4; ++m)
#pragma unroll
                    for (int n = 0; n < 2; ++n) asm volatile("" :: "v"(acc[a][b][m][n]));
    }
};

__host__ __device__ __forceinline__ size_t s5u_off(int m, int col) { const int g = col >> 4, hi = (col >> 3) & 1, rb = m >> 10, rem = m & 1023, row = rem >> 4, s = rem & 15, mb = row >> 5, r32 = row & 31;
    return ((((size_t)(g * 10 + rb) * 2 + mb) * 16 + s) * 64 + hi * 32 + r32) * 8 + (col & 7); }
struct EpiU {
    static constexpr bool PERM = true, AFTER_DRAIN = false;
    bf16_t* U;
    __device__ __forceinline__ void operator()(const f32x4 (&acc)[2][2][4][2], const Unit& u, int wr, int wc, int fr, int fq) const {
        const int row0 = u.pm * BM + wr * 64 + fr, col0 = u.pn * BM + wc * 32 + 8 * fq;
#pragma unroll
        for (int ai = 0; ai < 2; ++ai)
#pragma unroll
            for (int m = 0; m < 4; ++m)
#pragma unroll
                for (int bj = 0; bj < 2; ++bj) {
                    const f32x4 v0 = acc[ai][bj][m][0], v1 = acc[ai][bj][m][1];
                    u32x4 w; w.x = cvt_pk_bf16(v0[0], v0[1]); w.y = cvt_pk_bf16(v0[2], v0[3]); w.z = cvt_pk_bf16(v1[0], v1[1]); w.w = cvt_pk_bf16(v1[2], v1[3]);
                    *(u32x4*)(U + s5u_off(row0 + ai * HALF + m * 16, col0 + bj * HALF)) = w;
                }
    }
};

__host__ __device__ __forceinline__ int upw_row(int n) { return n < 5504 ? 256 * (n >> 7) + (n & 127) : 256 * ((n - 5504) >> 7) + 128 + ((n - 5504) & 127); }
__device__ __forceinline__ float dpp_ror1(float v) { return __int_as_float(__builtin_amdgcn_update_dpp(0, __float_as_int(v), 0x121, 0xF, 0xF, true)); }
__device__ __forceinline__ float dpp_ror15(float v) { return __int_as_float(__builtin_amdgcn_update_dpp(0, __float_as_int(v), 0x12F, 0xF, 0xF, true)); }
struct UpOrder {
    int G, c;
    __host__ __device__ void init(int G_, int c_) { G = G_; c = c_; }
    __host__ __device__ __forceinline__ bool next(int i, Unit& u) const {
        int strip = -1, k = 0, p = -1;
        if (G == 256) {
            if (c < 86) { if (i < 4) { strip = c; k = i; } else if (i < 7) p = (i - 4) * 86 + c; }
            else { const int q = 258 + (c - 86) + i * 170; if (q < 1376) p = q; }
        } else {
            const int ns = c < 86 ? (86 - c + G - 1) / G : 0;
            if (i < 4 * ns) { strip = c + (i >> 2) * G; k = i & 3; } else { const int q = c + (i - 4 * ns) * G; if (q < 1376) p = q; }
        }
        const bool isS = strip >= 0;
        u.pm = isS ? 32 + 4 * (strip / 43) + k : (p & 31); u.pn = isS ? strip % 43 : (p >> 5);
        return isS || p >= 0;
    }
    __device__ __forceinline__ void a_ready(const Unit&) const {}
    __device__ __forceinline__ void done(const Unit&) const {}
};
struct EpiConv {
    static constexpr bool PERM = true, AFTER_DRAIN = false, PERM_A = true;
    bf16_t* ACT; const float* cw; const float* cb; PG8_LAS float* X;
    __device__ __forceinline__ void operator()(const f32x4 (&acc)[2][2][4][2], const Unit& u, int wr, int wc, int fr, int fq) const {
        const int cl = wc * 32 + 8 * fq;
        const bool sample = u.pm >= 32; const int k = (u.pm - 32) & 3;
        const bool has_prev = sample && k > 0, has_next = sample && k < 3;
        PG8_LAS float* SVw = X + 2048 + (k & 1) * 512; const PG8_LAS float* SVr = X + 2048 + ((k & 1) ^ 1) * 512;
        const int f0 = u.pn * HALF + cl;
        f32x4 cwv[2][8];
        { const int f4 = f0;
            cwv[0][0] = *(const f32x4*)(cw + f4); cwv[0][1] = *(const f32x4*)(cw + 11008 + f4); cwv[0][2] = *(const f32x4*)(cw + 22016 + f4); cwv[0][3] = *(const f32x4*)(cb + f4);
            cwv[0][4] = *(const f32x4*)(cw + 5504 + f4); cwv[0][5] = *(const f32x4*)(cw + 11008 + 5504 + f4); cwv[0][6] = *(const f32x4*)(cw + 22016 + 5504 + f4); cwv[0][7] = *(const f32x4*)(cb + 5504 + f4); }
        if (fr == 0 || fr == 15) {
            const int fl = fr == 0 ? 0 : 1;
#pragma unroll
            for (int ai = 0; ai < 2; ++ai)
#pragma unroll
                for (int bj = 0; bj < 2; ++bj)
#pragma unroll
                    for (int n = 0; n < 2; ++n) *(PG8_LAS f32x4*)(X + ((2 * ai + wr) * 2 + fl) * 256 + bj * HALF + cl + 4 * n) = fr == 0 ? acc[ai][bj][0][n] : acc[ai][bj][3][n];
        }
        asm volatile("s_waitcnt lgkmcnt(0)" ::: "memory"); __builtin_amdgcn_s_barrier(); asm volatile("" ::: "memory");
        const size_t rowb = (size_t)u.pm * BM + wr * 64 + 4 * fr;
#pragma unroll
        for (int n = 0; n < 2; ++n) {
            const int f4 = f0 + 4 * n;
            const f32x4 w0g = cwv[n][0], w1g = cwv[n][1], w2g = cwv[n][2], bg = cwv[n][3], w0v = cwv[n][4], w1v = cwv[n][5], w2v = cwv[n][6], bv = cwv[n][7];
            const f32x4 z4 = {0.f, 0.f, 0.f, 0.f};
            if (has_prev && wr == 1 && fr == 15) {
                const f32x4 pg = *(const PG8_LAS f32x4*)(SVr + cl + 4 * n), pv = *(const PG8_LAS f32x4*)(SVr + HALF + cl + 4 * n), cg = *(const PG8_LAS f32x4*)(SVr + 256 + cl + 4 * n), cv = *(const PG8_LAS f32x4*)(SVr + 256 + HALF + cl + 4 * n);
                const f32x4 ng = *(const PG8_LAS f32x4*)(X + cl + 4 * n), nv = *(const PG8_LAS f32x4*)(X + HALF + cl + 4 * n);
                const f32x4 zg = w0g * pg + w1g * cg + w2g * ng + bg, zv = w0v * pv + w1v * cv + w2v * nv + bv;
                float o[4];
#pragma unroll
                for (int e2 = 0; e2 < 4; ++e2) o[e2] = zg[e2] * __builtin_amdgcn_rcpf(1.0f + __builtin_amdgcn_exp2f(-1.4426950408889634f * zg[e2])) * zv[e2];
                u32x2 w; w.x = cvt_pk_bf16(o[0], o[1]); w.y = cvt_pk_bf16(o[2], o[3]);
                *(u32x2*)(ACT + ((size_t)u.pm * BM - 1) * 5504 + f4) = w;
            }
#pragma unroll
            for (int ai = 0; ai < 2; ++ai) {
                const int q = 2 * ai + wr;
                if (n == 0 && ai == 1) { const int f4 = f0 + 4;
                    cwv[1][0] = *(const f32x4*)(cw + f4); cwv[1][1] = *(const f32x4*)(cw + 11008 + f4); cwv[1][2] = *(const f32x4*)(cw + 22016 + f4); cwv[1][3] = *(const f32x4*)(cb + f4);
                    cwv[1][4] = *(const f32x4*)(cw + 5504 + f4); cwv[1][5] = *(const f32x4*)(cw + 11008 + 5504 + f4); cwv[1][6] = *(const f32x4*)(cw + 22016 + 5504 + f4); cwv[1][7] = *(const f32x4*)(cb + 5504 + f4); }
                const f32x4 hpg = q > 0 ? *(const PG8_LAS f32x4*)(X + ((q - 1) * 2 + 1) * 256 + cl + 4 * n) : (has_prev ? *(const PG8_LAS f32x4*)(SVr + 256 + cl + 4 * n) : z4);
                const f32x4 hpv = q > 0 ? *(const PG8_LAS f32x4*)(X + ((q - 1) * 2 + 1) * 256 + HALF + cl + 4 * n) : (has_prev ? *(const PG8_LAS f32x4*)(SVr + 256 + HALF + cl + 4 * n) : z4);
                const f32x4 hng = q < 3 ? *(const PG8_LAS f32x4*)(X + ((q + 1) * 2 + 0) * 256 + cl + 4 * n) : z4, hnv = q < 3 ? *(const PG8_LAS f32x4*)(X + ((q + 1) * 2 + 0) * 256 + HALF + cl + 4 * n) : z4;
                const bool deferred = has_next && ai == 1 && wr == 1 && fr == 15;
                u32x2 ow[4];
#pragma unroll
                for (int p = 0; p < 2; ++p) {
                    const f32x2 x0 = p ? acc[ai][0][0][n].hi : acc[ai][0][0][n].lo, x1 = p ? acc[ai][0][1][n].hi : acc[ai][0][1][n].lo, x2 = p ? acc[ai][0][2][n].hi : acc[ai][0][2][n].lo, x3 = p ? acc[ai][0][3][n].hi : acc[ai][0][3][n].lo;
                    const f32x2 y0 = p ? acc[ai][1][0][n].hi : acc[ai][1][0][n].lo, y1 = p ? acc[ai][1][1][n].hi : acc[ai][1][1][n].lo, y2 = p ? acc[ai][1][2][n].hi : acc[ai][1][2][n].lo, y3 = p ? acc[ai][1][3][n].hi : acc[ai][1][3][n].lo;
                    const f32x2 hpg2 = p ? hpg.hi : hpg.lo, hpv2 = p ? hpv.hi : hpv.lo, hng2 = p ? hng.hi : hng.lo, hnv2 = p ? hnv.hi : hnv.lo;
                    f32x2 pg, pv, ng, nv;
                    pg.x = dpp_ror1(x3.x); pg.y = dpp_ror1(x3.y); pv.x = dpp_ror1(y3.x); pv.y = dpp_ror1(y3.y); ng.x = dpp_ror15(x0.x); ng.y = dpp_ror15(x0.y); nv.x = dpp_ror15(y0.x); nv.y = dpp_ror15(y0.y);
                    pg.x = fr == 0 ? hpg2.x : pg.x; pg.y = fr == 0 ? hpg2.y : pg.y; pv.x = fr == 0 ? hpv2.x : pv.x; pv.y = fr == 0 ? hpv2.y : pv.y;
                    ng.x = fr == 15 ? hng2.x : ng.x; ng.y = fr == 15 ? hng2.y : ng.y; nv.x = fr == 15 ? hnv2.x : nv.x; nv.y = fr == 15 ? hnv2.y : nv.y;
                    const f32x2 a0 = p ? w0g.hi : w0g.lo, a1 = p ? w1g.hi : w1g.lo, a2 = p ? w2g.hi : w2g.lo, ab = p ? bg.hi : bg.lo, c0 = p ? w0v.hi : w0v.lo, c1 = p ? w1v.hi : w1v.lo, c2 = p ? w2v.hi : w2v.lo, cbb = p ? bv.hi : bv.lo;
                    f32x2 zg[4], zv[4];
                    zg[0] = __builtin_elementwise_fma(pg, a0, __builtin_elementwise_fma(x1, a2, __builtin_elementwise_fma(x0, a1, ab)));
                    zg[1] = __builtin_elementwise_fma(x0, a0, __builtin_elementwise_fma(x2, a2, __builtin_elementwise_fma(x1, a1, ab)));
                    zg[2] = __builtin_elementwise_fma(x1, a0, __builtin_elementwise_fma(x3, a2, __builtin_elementwise_fma(x2, a1, ab)));
                    zg[3] = __builtin_elementwise_fma(x2, a0, __builtin_elementwise_fma(ng, a2, __builtin_elementwise_fma(x3, a1, ab)));
                    zv[0] = __builtin_elementwise_fma(pv, c0, __builtin_elementwise_fma(y1, c2, __builtin_elementwise_fma(y0, c1, cbb)));
                    zv[1] = __builtin_elementwise_fma(y0, c0, __builtin_elementwise_fma(y2, c2, __builtin_elementwise_fma(y1, c1, cbb)));
                    zv[2] = __builtin_elementwise_fma(y1, c0, __builtin_elementwise_fma(y3, c2, __builtin_elementwise_fma(y2, c1, cbb)));
                    zv[3] = __builtin_elementwise_fma(y2, c0, __builtin_elementwise_fma(nv, c2, __builtin_elementwise_fma(y3, c1, cbb)));
#pragma unroll
                    for (int m = 0; m < 4; ++m) {
                        const f32x2 ea = zg[m] * -1.4426950408889634f; f32x2 ex; ex.x = __builtin_amdgcn_exp2f(ea.x); ex.y = __builtin_amdgcn_exp2f(ea.y);
                        const f32x2 dn = ex + 1.0f; f32x2 rc; rc.x = __builtin_amdgcn_rcpf(dn.x); rc.y = __builtin_amdgcn_rcpf(dn.y);
                        const f32x2 o2 = (zg[m] * zv[m]) * rc;
                        const unsigned pk = cvt_pk_bf16(o2.x, o2.y); if (p == 0) ow[m].x = pk; else ow[m].y = pk;
                    }
                }
                if (ai == 1) { if (deferred) { *(PG8_LAS f32x4*)(SVw + cl + 4 * n) = acc[1][0][2][n]; *(PG8_LAS f32x4*)(SVw + HALF + cl + 4 * n) = acc[1][1][2][n]; *(PG8_LAS f32x4*)(SVw + 256 + cl + 4 * n) = acc[1][0][3][n]; *(PG8_LAS f32x4*)(SVw + 256 + HALF + cl + 4 * n) = acc[1][1][3][n]; } }
#pragma unroll
                for (int m = 0; m < 4; ++m) if (!(deferred && m == 3)) *(u32x2*)(ACT + (rowb + ai * HALF + m) * 5504 + f4) = ow[m];
            }
        }
    }
};
template <class E, class = void> struct epi_perm_a { static constexpr bool v = false; };
template <class E> struct epi_perm_a<E, decltype((void)E::PERM_A)> { static constexpr bool v = E::PERM_A; };
template <class Epi, class Sched, bool ALIGN_EPI = false, bool SP2 = false>
__device__ __forceinline__ void gemm_phase(PG8_LAS unsigned char* lds, const Gemm g, const Sched& S, const Epi& E, const int tid) {
    const int wid = __builtin_amdgcn_readfirstlane(tid >> 6), lane = tid & 63, wr = wid >> 2, wc = wid & 3, fr = lane & 15, fq = lane >> 4;
    const int K = g.K, nt = K / BK;
    unsigned voffA[2], voffB[2];
#pragma unroll
    for (int i = 0; i < 2; ++i) { int R, C; stage_rc(tid * 16 + i * 8192, R, C); const int Rb = Epi::PERM ? ((R & ~31) + perm32(R & 31)) : R;
        const int Ra = epi_perm_a<Epi>::v ? ((R & 64) + 4 * (R & 15) + ((R >> 4) & 3)) : R;
        voffA[i] = (unsigned)(Ra * K + C) * 2u; voffB[i] = (unsigned)(Rb * K + C) * 2u; }
    const size_t kstep = (size_t)(BK * 2);
    const size_t hstep = (size_t)HALF * K * 2;
    const size_t tstep = 2 * hstep;
    const unsigned ldsw = (unsigned)wid * 1024u;
    const int aoff = lds_byte(wr * 64 + fr, fq * 8), boff = lds_byte(wc * 32 + fr, fq * 8);
#define PG8_SA(b, h) (((b) * 2 + (h)) * HTB)
#define PG8_SB(b, h) ((4 + (b) * 2 + (h)) * HTB)
#define PG8_STAGE(bufoff, gbase, voff) do { _Pragma("unroll") for (int _i = 0; _i < 2; ++_i) \
        __builtin_amdgcn_global_load_lds((const unsigned*)((const char*)(gbase) + (voff)[_i]), (PG8_LAS unsigned*)(lds + (bufoff) + ldsw + _i * 8192), 16, 0, 0); } while (0)
#define PG8_LDA(dst, b, h) do { _Pragma("unroll") for (int m = 0; m < 4; ++m) _Pragma("unroll") for (int k = 0; k < 2; ++k) dst[m][k] = *(const PG8_LAS bf16x8*)(lds + PG8_SA(b, h) + aoff + m * 2048 + k * 1024); } while (0)
#define PG8_LDB(dst, b, h) do { _Pragma("unroll") for (int n = 0; n < 2; ++n) _Pragma("unroll") for (int k = 0; k < 2; ++k) dst[n][k] = *(const PG8_LAS bf16x8*)(lds + PG8_SB(b, h) + boff + n * 2048 + k * 1024); } while (0)
#define PG8_MMA(ai, bj, At, Bt) do { __builtin_amdgcn_s_setprio(1); _Pragma("unroll") for (int m = 0; m < 4; ++m) _Pragma("unroll") for (int n = 0; n < 2; ++n) _Pragma("unroll") for (int k = 0; k < 2; ++k) \
        acc[ai][bj][m][n] = __builtin_amdgcn_mfma_f32_16x16x32_bf16(Bt[n][k], At[m][k], acc[ai][bj][m][n], 0, 0, 0); __builtin_amdgcn_s_setprio(0); } while (0)
#define PG8_WAIT_V(n) asm volatile("s_waitcnt vmcnt(" #n ")" ::: "memory")
#define PG8_WAIT_L(n) asm volatile("s_waitcnt lgkmcnt(" #n ")" ::: "memory")
#define PG8_BAR __builtin_amdgcn_s_barrier()
#define PG8_SCHED __builtin_amdgcn_sched_barrier(0)
    Unit cur, nxt; int ui = 0;
    if (!S.next(0, cur)) return;
    f32x4 acc[2][2][4][2];
#pragma unroll
    for (int a = 0; a < 2; ++a)
#pragma unroll
        for (int b = 0; b < 2; ++b)
#pragma unroll
            for (int m = 0; m < 4; ++m)
#pragma unroll
                for (int n = 0; n < 2; ++n) acc[a][b][m][n] = (f32x4){0.f, 0.f, 0.f, 0.f};
    bf16x8 At[4][2], B0[2][2], B1[2][2];
    const char* cA = (const char*)g.A + (size_t)cur.pm * tstep + (size_t)cur.k0 * kstep; const char* cB = (const char*)g.Bt + (size_t)cur.pn * tstep + (size_t)cur.k0 * kstep;
    S.a_ready(cur);
    if constexpr (SP2) {
        PG8_STAGE(PG8_SB(0, 0), cB, voffB); PG8_STAGE(PG8_SB(0, 1), cB + hstep, voffB); PG8_STAGE(PG8_SA(0, 0), cA, voffA); PG8_STAGE(PG8_SA(0, 1), cA + hstep, voffA);
        if (wr == 1) PG8_BAR;
        PG8_WAIT_V(2); PG8_BAR;
        PG8_STAGE(PG8_SB(1, 0), cB + kstep, voffB); PG8_STAGE(PG8_SA(1, 0), cA + kstep, voffA); PG8_STAGE(PG8_SB(1, 1), cB + hstep + kstep, voffB);
        PG8_WAIT_V(6); PG8_BAR;
    } else {
        PG8_STAGE(PG8_SB(0, 0), cB, voffB); PG8_STAGE(PG8_SA(0, 0), cA, voffA); PG8_STAGE(PG8_SB(0, 1), cB + hstep, voffB); PG8_STAGE(PG8_SA(0, 1), cA + hstep, voffA);
        if (wr == 1) PG8_BAR;
        PG8_WAIT_V(4); PG8_BAR;
        PG8_STAGE(PG8_SB(1, 0), cB + kstep, voffB); PG8_STAGE(PG8_SA(1, 0), cA + kstep, voffA); PG8_STAGE(PG8_SB(1, 1), cB + hstep + kstep, voffB);
        PG8_WAIT_V(6); PG8_BAR;
    }
    for (;;) {
        const bool has_next = S.next(ui + 1, nxt);
        const char* nA = has_next ? (const char*)g.A + (size_t)nxt.pm * tstep + (size_t)nxt.k0 * kstep : cA; const char* nB = has_next ? (const char*)g.Bt + (size_t)nxt.pn * tstep + (size_t)nxt.k0 * kstep : cB;
        const int cnt = cur.nk ? cur.nk : nt;
        for (int t = 0; t < cnt; t += 2) {
            const bool last = (t == cnt - 2);
            const char* a1 = cA + (size_t)(t + 1) * kstep;
            const char* a2 = last ? nA : cA + (size_t)(t + 2) * kstep; const char* b2 = last ? nB : cB + (size_t)(t + 2) * kstep;
            const char* a3 = a2 + kstep; const char* b3 = b2 + kstep;
            if (last && has_next) S.a_ready(nxt);
            if constexpr (SP2) {
            PG8_LDB(B0, 0, 0); PG8_LDB(B1, 0, 1); PG8_SCHED; PG8_LDA(At, 0, 0); PG8_STAGE(PG8_SA(1, 1), a1 + hstep, voffA);
            PG8_WAIT_V(8); PG8_WAIT_L(0); PG8_BAR; PG8_MMA(0, 0, At, B0); PG8_MMA(0, 1, At, B1); PG8_BAR; PG8_SCHED;
            PG8_LDA(At, 0, 1); PG8_STAGE(PG8_SB(0, 0), b2, voffB); PG8_STAGE(PG8_SB(0, 1), b2 + hstep, voffB); PG8_STAGE(PG8_SA(0, 0), a2, voffA);
            PG8_WAIT_V(8); PG8_WAIT_L(0); PG8_BAR; PG8_MMA(1, 0, At, B0); PG8_MMA(1, 1, At, B1); PG8_BAR; PG8_SCHED;
            PG8_LDB(B0, 1, 0); PG8_LDB(B1, 1, 1); PG8_SCHED; PG8_LDA(At, 1, 0); PG8_STAGE(PG8_SA(0, 1), a2 + hstep, voffA);
            PG8_WAIT_V(8); PG8_WAIT_L(0); PG8_BAR; PG8_MMA(0, 0, At, B0); PG8_MMA(0, 1, At, B1); PG8_BAR; PG8_SCHED;
            PG8_LDA(At, 1, 1); PG8_STAGE(PG8_SB(1, 0), b3, voffB); PG8_STAGE(PG8_SB(1, 1), b3 + hstep, voffB); PG8_STAGE(PG8_SA(1, 0), a3, voffA);
            PG8_WAIT_V(8); PG8_WAIT_L(0); PG8_BAR; PG8_MMA(1, 0, At, B0); PG8_MMA(1, 1, At, B1); PG8_BAR; PG8_SCHED;
            } else {
            PG8_LDB(B0, 0, 0); PG8_SCHED; PG8_LDA(At, 0, 0); PG8_STAGE(PG8_SA(1, 1), a1 + hstep, voffA);
            PG8_WAIT_L(8); PG8_BAR; PG8_WAIT_L(0); PG8_MMA(0, 0, At, B0); PG8_BAR; PG8_SCHED;
            PG8_LDB(B1, 0, 1); PG8_STAGE(PG8_SB(0, 0), b2, voffB);
            PG8_BAR; PG8_WAIT_L(0); PG8_MMA(0, 1, At, B1); PG8_BAR;
            PG8_LDA(At, 0, 1); PG8_STAGE(PG8_SA(0, 0), a2, voffA);
            PG8_BAR; PG8_WAIT_L(0); PG8_MMA(1, 0, At, B0); PG8_BAR; PG8_SCHED;
            PG8_STAGE(PG8_SB(0, 1), b2 + hstep, voffB);
            PG8_WAIT_V(6); PG8_BAR; PG8_MMA(1, 1, At, B1); PG8_BAR;
            PG8_LDB(B0, 1, 0); PG8_SCHED; PG8_LDA(At, 1, 0); PG8_STAGE(PG8_SA(0, 1), a2 + hstep, voffA);
            PG8_WAIT_L(8); PG8_BAR; PG8_WAIT_L(0); PG8_MMA(0, 0, At, B0); PG8_BAR; PG8_SCHED;
            PG8_LDB(B1, 1, 1); PG8_STAGE(PG8_SB(1, 0), b3, voffB);
            PG8_BAR; PG8_WAIT_L(0); PG8_MMA(0, 1, At, B1); PG8_BAR;
            PG8_LDA(At, 1, 1); PG8_STAGE(PG8_SA(1, 0), a3, voffA);
            PG8_BAR; PG8_WAIT_L(0); PG8_MMA(1, 0, At, B0); PG8_BAR; PG8_SCHED;
            PG8_STAGE(PG8_SB(1, 1), b3 + hstep, voffB);
            PG8_WAIT_V(6); PG8_BAR; PG8_MMA(1, 1, At, B1); PG8_BAR;
            }
        }
        if constexpr (ALIGN_EPI) { if (wr == 0) PG8_BAR; }
        if constexpr (!Epi::AFTER_DRAIN) { E(acc, cur, wr, wc, fr, fq); S.done(cur); }
        if (!has_next) break;
#pragma unroll
        for (int a = 0; a < 2; ++a)
#pragma unroll
            for (int b = 0; b < 2; ++b)
#pragma unroll
                for (int m = 0; m < 4; ++m)
#pragma unroll
                    for (int n = 0; n < 2; ++n) acc[a][b][m][n] = (f32x4){0.f, 0.f, 0.f, 0.f};
        cur = nxt; cA = nA; cB = nB; ++ui;
        if constexpr (ALIGN_EPI) { if (wr == 1) PG8_BAR; }
    }
    PG8_WAIT_V(0);
    if constexpr (!ALIGN_EPI) { if (wr == 0) PG8_BAR; }
    PG8_BAR;
    if constexpr (Epi::AFTER_DRAIN) { E.fused(acc, cur, wr, wc, fr, fq, lds, wid, lane); S.done(cur); }
#undef PG8_SA
#undef PG8_SB
#undef PG8_STAGE
#undef PG8_LDA
#undef PG8_LDB
#undef PG8_MMA
#undef PG8_WAIT_V
#undef PG8_WAIT_L
#undef PG8_BAR
#undef PG8_SCHED
}
}
#define GAS __attribute__((address_space(1)))
#define LAS __attribute__((address_space(3)))
typedef unsigned short bf16;
typedef unsigned v4u __attribute__((ext_vector_type(4)));
typedef float f32x4 __attribute__((ext_vector_type(4)));
typedef short bf16x8 __attribute__((ext_vector_type(8)));
typedef GAS unsigned gu32;
typedef GAS unsigned long long gu64;
#define RLX_AGENT __ATOMIC_RELAXED, __HIP_MEMORY_SCOPE_AGENT
#define LDS_WAIT() asm volatile("s_waitcnt lgkmcnt(0)" ::: "memory")
#define VM_WAIT() asm volatile("s_waitcnt vmcnt(0)" ::: "memory")
__device__ __forceinline__ unsigned long long rt() { return __builtin_amdgcn_s_memrealtime(); }
__device__ __forceinline__ unsigned f2bf(float f) { unsigned u = __builtin_bit_cast(unsigned, f); return (u + 0x7fffu + ((u >> 16) & 1u)) >> 16; }
__device__ __forceinline__ unsigned pk2(float lo, float hi) { return f2bf(lo) | (f2bf(hi) << 16); }

#define XB_TMO      128
#define XB_XCNT(j)  (256  + 64 * (j))
#define XB_XSUB(j)  (1280 + 64 * (j))
#define XB_XGEN(j)  (2304 + 64 * (j))
#define XB_TOP      3328
#define XB_TOPGEN   3392
#define XCD_BAR_WORDS 3456
#define XB_SPIN_CAP (1u << 18)

__device__ __forceinline__ unsigned xb_ld(unsigned* p)              { return __hip_atomic_load(p, __ATOMIC_RELAXED, __HIP_MEMORY_SCOPE_AGENT); }
__device__ __forceinline__ unsigned xb_add(unsigned* p, unsigned v) { return __hip_atomic_fetch_add(p, v, __ATOMIC_RELAXED, __HIP_MEMORY_SCOPE_AGENT); }
__device__ __forceinline__ unsigned xb_xcc_id() { return (unsigned)__builtin_amdgcn_s_getreg((3 << 11) | 20) & 0xFu; }
#define XB_SPIN(cond, bar) do { unsigned _sp = 0; while (cond) { __builtin_amdgcn_s_sleep(1); \
    if ((++_sp & 255u) == 0u) { if (xb_ld(&(bar)[XB_TMO])) break; if (_sp > XB_SPIN_CAP) { atomicAdd(&(bar)[XB_TMO], 1u); break; } } } } while (0)

struct XcdBarrier {
    unsigned* bar; unsigned x;
    volatile LAS unsigned* st;
};

__device__ __forceinline__ XcdBarrier xcd_barrier_post(unsigned* bar, volatile LAS unsigned* st) {
    XcdBarrier b; b.bar = bar; b.x = xb_xcc_id(); b.st = st;
    if (threadIdx.x == 0) (void)xb_add(&bar[XB_XCNT(b.x)], 1u);
    return b;
}
__device__ __forceinline__ void xcd_barrier_complete(unsigned* bar, unsigned x, unsigned& nloc, unsigned& nx) {
    const unsigned G = gridDim.x * gridDim.y * gridDim.z;
    unsigned sum, cnt, mine, sp = 0u;
    for (;;) {
        sum = 0u; cnt = 0u; mine = 0u;
#pragma unroll
        for (unsigned j = 0; j < 16; ++j) { const unsigned c = xb_ld(&bar[XB_XCNT(j)]); sum += c; cnt += (c > 0u) ? 1u : 0u; mine = (j == x) ? c : mine; }
        if (sum == G) break;
        __builtin_amdgcn_s_sleep(1);
        if ((++sp & 255u) == 0u) { if (xb_ld(&bar[XB_TMO])) break; if (sp > XB_SPIN_CAP) { atomicAdd(&bar[XB_TMO], 1u); break; } }
    }
    nloc = mine > 0u ? mine : 1u; nx = cnt > 0u ? cnt : 1u;
}

__device__ __forceinline__ void xcd_barrier(const XcdBarrier& b) {
    asm volatile("s_waitcnt vmcnt(0)" ::: "memory");
    __syncthreads();
    if (threadIdx.x == 0) {
        unsigned* bar = b.bar;
        __builtin_amdgcn_s_waitcnt(0);
        unsigned nloc = b.st[0], nx = b.st[1];
        if (nloc == 0u) { xcd_barrier_complete(bar, b.x, nloc, nx); b.st[0] = nloc; b.st[1] = nx; }
        const unsigned old = xb_add(&bar[XB_XSUB(b.x)], 1u);
        const unsigned gen = old / nloc;
        if (old + 1u == (gen + 1u) * nloc) {
            __builtin_amdgcn_fence(__ATOMIC_RELEASE, "agent");
            asm volatile("s_waitcnt vmcnt(0)" ::: "memory");
            const unsigned og = xb_add(&bar[XB_TOP], 1u);
            const unsigned tg = og / nx;
            if (og + 1u == (tg + 1u) * nx) xb_add(&bar[XB_TOPGEN], 1u);
            else XB_SPIN(xb_ld(&bar[XB_TOPGEN]) == tg, bar);
            __builtin_amdgcn_fence(__ATOMIC_ACQUIRE, "agent");
            xb_add(&bar[XB_XGEN(b.x)], 1u);
            asm volatile("s_waitcnt vmcnt(0)" ::: "memory");
        } else {
            XB_SPIN(xb_ld(&bar[XB_XGEN(b.x)]) == gen, bar);
            __builtin_amdgcn_fence(__ATOMIC_ACQUIRE, "agent");
            asm volatile("s_waitcnt vmcnt(0)" ::: "memory");
        }
    }
    __syncthreads();
}
constexpr int D = 2048, NH = 16, HD = 128, FF = 5504, F2 = 11008, MP = 8192, MS = 2048, M = 10240;
constexpr int SEQ = 256, DSEQ = 1024, PAST = 512, NG = 128, GC = 16, SP = 64;
constexpr float NORM_EPS = 1e-6f;
constexpr float LOG2E = 1.4426950408889634f;
constexpr float C2 = 0.08838834764831845f * 1.4426950408889634f;
constexpr int NWAVES = 8, NTHR = 512;
enum { I_XP = 0, I_XS, I_CK, I_CV, I_SRE, I_SIM, I_C, I_CCTX, I_ADAW, I_ADAB, I_N1G, I_N2G, I_WQKV, I_RPB, I_WO, I_WIN, I_ARE, I_AIM, I_LOGDT, I_BRE, I_BIM, I_CRE, I_CIM, I_SD, I_WGATE, I_WOUT, I_WUP, I_CONVW, I_CONVB, I_WDN, I_FG, N_IN };

struct Args;
typedef const __attribute__((address_space(4))) unsigned char* kseg_t;
__device__ __forceinline__ const float* ARG_IN(int i) { kseg_t k = (kseg_t)__builtin_amdgcn_kernarg_segment_ptr(); return *(const float* const volatile __attribute__((address_space(4)))*)(k + 8 * i); }
__device__ __forceinline__ float* ARG_OUT() { kseg_t k = (kseg_t)__builtin_amdgcn_kernarg_segment_ptr(); return *(float* const volatile __attribute__((address_space(4)))*)(k + 8 * N_IN); }
__device__ __forceinline__ int ARG_I32(int i) { kseg_t k = (kseg_t)__builtin_amdgcn_kernarg_segment_ptr(); return *(const volatile __attribute__((address_space(4))) int*)(k + 8 * N_IN + 16 + 4 * i); }
__device__ __forceinline__ unsigned char* ARG_WS() { kseg_t k = (kseg_t)__builtin_amdgcn_kernarg_segment_ptr(); return *(unsigned char* const volatile __attribute__((address_space(4)))*)(k + 8 * N_IN + 8); }
constexpr size_t O_Y = 0, O_NK = (size_t)M * D, O_NV = O_NK + (size_t)MP * D, O_SRE = O_NV + (size_t)MP * D, O_SIM = O_SRE + 32 * 2 * 128 * 64, O_END = O_SIM + 32 * 2 * 128 * 64;

constexpr size_t MiB = 1u << 20, KiB = 1u << 10;
constexpr size_t WS_CTL = 0, CTL_ZERO_BYTES = 1 * MiB;
constexpr size_t WS_MOD = 256 * KiB;
constexpr size_t WS_DBG = 768 * KiB;
constexpr size_t WS_WQKV = 1 * MiB, WS_WO = 25 * MiB, WS_WIN = 33 * MiB, WS_WGATE = 41 * MiB, WS_WOUT = 49 * MiB;
constexpr size_t WS_WUP0 = 57 * MiB, WS_WUP1 = 100 * MiB, WS_WDN0 = 143 * MiB, WS_WDN1 = 143 * MiB + 22016 * KiB;
constexpr size_t WS_X1 = 186 * MiB, WS_HB = 266 * MiB, WS_S = 306 * MiB;
constexpr size_t WS_Q = WS_S, WS_KF = WS_S + 40 * MiB, WS_VTF = WS_S + 84 * MiB, WS_O = WS_S + 128 * MiB;
constexpr size_t WS_UP = WS_S, WS_ACT = WS_S + 215 * MiB;
constexpr size_t WS_U = WS_S, WS_Y = WS_S + 40 * MiB, WS_Y2 = WS_S + 80 * MiB, WS_S5W = WS_S + 120 * MiB;
constexpr size_t WS_SLAB = WS_S + 323 * MiB;
constexpr size_t WS_END = WS_SLAB + 64 * MiB;
static_assert(WS_WDN1 + (size_t)D * FF * 2 <= WS_X1 && WS_WUP0 + (size_t)F2 * D * 2 <= WS_WUP1 && WS_WUP1 + (size_t)F2 * D * 2 <= WS_WDN0 && WS_WDN0 + (size_t)D * FF * 2 <= WS_WDN1, "weight map");
static_assert(WS_UP + (size_t)M * F2 * 2 <= WS_ACT && WS_ACT + (size_t)M * FF * 2 <= WS_END && WS_O + (size_t)M * D * 2 <= WS_END && WS_S5W + (size_t)NG * 3 * 131072 <= WS_END, "scratch map");
constexpr int CW_BAR = 4096;

constexpr int RING_BYTES = 131072, LDSCTL_OFF = RING_BYTES, MISC_OFF = LDSCTL_OFF + 320, XCH_OFF = LDSCTL_OFF + 1024  , KFB_OFF = XCH_OFF  , LDS_BYTES = 155648;

typedef float f32x16 __attribute__((ext_vector_type(16)));
typedef unsigned u32x2 __attribute__((ext_vector_type(2)));
__device__ __forceinline__ unsigned cvtpk(float lo, float hi) { unsigned r; asm volatile("v_cvt_pk_bf16_f32 %0, %1, %2" : "=v"(r) : "v"(lo), "v"(hi)); return r; }
__device__ __forceinline__ float bf_lo(unsigned w) { return __uint_as_float(w << 16); }
__device__ __forceinline__ float bf_hi(unsigned w) { return __uint_as_float(w & 0xffff0000u); }
__device__ __forceinline__ float wave_sum(float v) {
#pragma unroll
    for (int o = 1; o < 64; o <<= 1) v += __shfl_xor(v, o);
    return v;
}
__device__ __forceinline__ float silu_f(float x) { return x / (1.0f + __expf(-x)); }
__device__ __forceinline__ float gelu_tanh(float x) {
    const float z = 0.7978845608028654f * (x + 0.044715f * x * x * x);
    return x * __builtin_amdgcn_rcpf(1.0f + __builtin_amdgcn_exp2f(-2.0f * LOG2E * z));
}

__device__ __forceinline__ void p0_ada(LAS unsigned char* lds, const float* adaw, const float* adab, const float* cctx, const float* cs, float* mod, int tid, int wave, int lane) {
    LAS float* red = (LAS float*)lds;
    for (int it = blockIdx.x; it < 1536; it += gridDim.x) {
        const int l = it / 768, r = it % 768, cb = r >> 4, ks = r & 15;
        const float* W = adaw + (size_t)l * 2048 * 12288 + cb * 256 + lane * 4;
        const int k0 = ks * 128 + wave * 16;
        f32x4 a0 = {0.f, 0.f, 0.f, 0.f}, a1 = a0, a2 = a0;
        f32x4 wv[16];
#pragma unroll
        for (int i = 0; i < 16; ++i) wv[i] = *(const f32x4*)(W + (size_t)(k0 + i) * 12288);
#pragma unroll
        for (int i = 0; i < 16; ++i) {
            const int k = k0 + i;
            const float s0 = silu_f(cctx[k]), s1 = silu_f(cs[k]), s2 = silu_f(cs[2048 + k]);
            a0 += wv[i] * s0; a1 += wv[i] * s1; a2 += wv[i] * s2;
        }
        *(LAS f32x4*)(red + (wave * 3 + 0) * 256 + lane * 4) = a0;
        *(LAS f32x4*)(red + (wave * 3 + 1) * 256 + lane * 4) = a1;
        *(LAS f32x4*)(red + (wave * 3 + 2) * 256 + lane * 4) = a2;
        __syncthreads();
        for (int idx = tid; idx < 768; idx += NTHR) {
            const int cond = idx >> 8, col = idx & 255;
            float s = 0.f;
#pragma unroll
            for (int w = 0; w < 8; ++w) s += red[(w * 3 + cond) * 256 + col];
            if (ks == 0) s += adab[l * 12288 + cb * 256 + col];
            atomicAdd(mod + (size_t)(l * 3 + cond) * 12288 + cb * 256 + col, s);
        }
        __syncthreads();
    }
}
template <bool UPW = false>
__device__ __forceinline__ void p0_transpose_item(const float* W, int K, int N, bf16* WT, LAS float* scr, int item, int lane) {
    const int nblk = N / 32, kb = item / nblk, nb = item % nblk, k0 = 64 * kb, n0 = 32 * nb, r0 = UPW ? pg8::upw_row(n0) : n0;
    f32x4 v[8];
#pragma unroll
    for (int i = 0; i < 8; ++i) v[i] = *(const f32x4*)(W + (size_t)(k0 + 8 * i + (lane >> 3)) * N + n0 + (lane & 7) * 4);
#pragma unroll
    for (int i = 0; i < 8; ++i) { LAS float* d = scr + (8 * i + (lane >> 3)) * 33 + (lane & 7) * 4; d[0] = v[i].x; d[1] = v[i].y; d[2] = v[i].z; d[3] = v[i].w; }
    LDS_WAIT(); asm volatile("" ::: "memory");
    const int c = lane & 7;
#pragma unroll
    for (int j = 0; j < 4; ++j) { const int n = (lane >> 3) + 8 * j; const LAS float* s = scr + (8 * c) * 33 + n;
        v4u o; o.x = pk2(s[0 * 33], s[1 * 33]); o.y = pk2(s[2 * 33], s[3 * 33]); o.z = pk2(s[4 * 33], s[5 * 33]); o.w = pk2(s[6 * 33], s[7 * 33]);
        *(GAS v4u*)(WT + (size_t)(r0 + n) * K + k0 + 8 * c) = o; }
    LDS_WAIT(); asm volatile("" ::: "memory");
}
__device__ __forceinline__ void p0_weights(LAS unsigned char* lds, unsigned char* ws, int gw, int NGW, int wave, int lane, int it_lo = 0, int it_hi = 47360) {
    LAS float* scr = (LAS float*)(lds + wave * 16384);
    constexpr int I_QKV = 32 * 192, I_SQ = 32 * 64, I_UP = 32 * 344, I_DN = 86 * 64;
    for (int it = it_lo + gw; it < it_hi; it += NGW) {
        int r = it;
        if (r < I_QKV) { p0_transpose_item(ARG_IN(I_WQKV), D, 3 * D, (bf16*)(ws + WS_WQKV), scr, r, lane); continue; } r -= I_QKV;
        if (r < I_SQ) { p0_transpose_item(ARG_IN(I_WO), D, D, (bf16*)(ws + WS_WO), scr, r, lane); continue; } r -= I_SQ;
        if (r < I_SQ) { p0_transpose_item(ARG_IN(I_WIN), D, D, (bf16*)(ws + WS_WIN), scr, r, lane); continue; } r -= I_SQ;
        if (r < I_SQ) { p0_transpose_item(ARG_IN(I_WGATE), D, D, (bf16*)(ws + WS_WGATE), scr, r, lane); continue; } r -= I_SQ;
        if (r < I_SQ) { p0_transpose_item(ARG_IN(I_WOUT), D, D, (bf16*)(ws + WS_WOUT), scr, r, lane); continue; } r -= I_SQ;
        if (r < I_UP) { p0_transpose_item<true>(ARG_IN(I_WUP), D, F2, (bf16*)(ws + WS_WUP0), scr, r, lane); continue; } r -= I_UP;
        if (r < I_UP) { p0_transpose_item<true>(ARG_IN(I_WUP) + (size_t)D * F2, D, F2, (bf16*)(ws + WS_WUP1), scr, r, lane); continue; } r -= I_UP;
        if (r < I_DN) { p0_transpose_item(ARG_IN(I_WDN), FF, D, (bf16*)(ws + WS_WDN0), scr, r, lane); continue; } r -= I_DN;
        p0_transpose_item(ARG_IN(I_WDN) + (size_t)FF * D, FF, D, (bf16*)(ws + WS_WDN1), scr, r, lane);
    }
}
__device__ __forceinline__ void p0_cache(const float* ck, const float* cv, bf16* Kf, bf16* VTf, int gtid, int NGT) {
    for (int i = gtid; i < 2 * 512 * 256; i += NGT) {
        const size_t e = (size_t)i * 8;
        const int bt = i >> 8, col = (i & 255) * 8, bb = bt >> 9, t = bt & 511, h = col >> 7, d0 = col & 127;
        const size_t sb = pg8::seq_base_cache(bb, h);
        const f32x4 a = *(const f32x4*)(ck + e), b = *(const f32x4*)(ck + e + 4);
        const f32x4 c = *(const f32x4*)(cv + e), d = *(const f32x4*)(cv + e + 4);
        v4u o; o.x = pk2(a.x, a.y); o.y = pk2(a.z, a.w); o.z = pk2(b.x, b.y); o.w = pk2(b.z, b.w);
        *(v4u*)(Kf + sb + pg8::kf_off(t, d0)) = o;
        bf16* p = VTf + sb + pg8::vtf_off(t, d0);
        p[0] = (bf16)f2bf(c.x); p[8] = (bf16)f2bf(c.y); p[16] = (bf16)f2bf(c.z); p[24] = (bf16)f2bf(c.w);
        p[32] = (bf16)f2bf(d.x); p[40] = (bf16)f2bf(d.y); p[48] = (bf16)f2bf(d.z); p[56] = (bf16)f2bf(d.w);
    }
}

__device__ __forceinline__ void norm_rows(const float* xa, const float* xb, const float* g, const float* modl, int jshift, int jscale, bf16* out, int gw, int NGW, int lane,
                                          const float* slab = nullptr, const float* gatep = nullptr, float* xw = nullptr) {
    int m = gw; if (m >= M) return;
    f32x4 vn[8];
    { const float* xr = (m < MP ? xa : xb) + (size_t)m * D + lane * 4;
#pragma unroll
      for (int j = 0; j < 8; ++j) vn[j] = *(const f32x4*)(xr + 256 * j); }
    int ccur = -1; f32x4 A[8], B[8];
    while (m < M) {
        f32x4 v[8];
#pragma unroll
        for (int j = 0; j < 8; ++j) v[j] = vn[j];
        const int mn = m + NGW;
        if (mn < M) { const float* xr = (mn < MP ? xa : xb) + (size_t)mn * D + lane * 4;
#pragma unroll
            for (int j = 0; j < 8; ++j) vn[j] = *(const f32x4*)(xr + 256 * j); }
        const int cond = m < MP ? 0 : 1 + ((m - MP) >> 10);
        if (cond != ccur) {
            const float* sh = modl + (size_t)cond * 12288 + jshift * 2048 + lane * 4; const float* sc = modl + (size_t)cond * 12288 + jscale * 2048 + lane * 4;
#pragma unroll
            for (int j = 0; j < 8; ++j) { A[j] = *(const f32x4*)(g + lane * 4 + 256 * j) * (*(const f32x4*)(sc + 256 * j) + 1.0f); B[j] = *(const f32x4*)(sh + 256 * j); }
            ccur = cond;
        }
        if (slab != nullptr && m >= MP) {
            const float* sp = slab + (size_t)(m - MP) * D + lane * 4; const float* gt = gatep + (size_t)cond * 12288 + lane * 4; float* wr = xw + (size_t)m * D + lane * 4;
#pragma unroll
            for (int j = 0; j < 8; ++j) {
                const f32x4 p = (*(const f32x4*)(sp + 256 * j) + *(const f32x4*)(sp + (size_t)2048 * 2048 + 256 * j)) + (*(const f32x4*)(sp + (size_t)2 * 2048 * 2048 + 256 * j) + *(const f32x4*)(sp + (size_t)3 * 2048 * 2048 + 256 * j));
                v[j] = v[j] + *(const f32x4*)(gt + 256 * j) * p; *(f32x4*)(wr + 256 * j) = v[j];
            }
        }
        float ss = 0.f;
#pragma unroll
        for (int j = 0; j < 8; ++j) ss += (v[j].x * v[j].x + v[j].y * v[j].y) + (v[j].z * v[j].z + v[j].w * v[j].w);
        const float rstd = 1.0f / sqrtf(wave_sum(ss) * (1.0f / D) + NORM_EPS);
        bf16* orow = out + (size_t)m * D + lane * 4;
#pragma unroll
        for (int j = 0; j < 8; ++j) {
            const f32x4 o = v[j] * rstd * A[j] + B[j];
            u32x2 w; w.x = pk2(o.x, o.y); w.y = pk2(o.z, o.w);
            *(u32x2*)(orow + 256 * j) = w;
        }
        m = mn;
    }
}
__device__ __forceinline__ void final_norm_rows(float* x, const float* g, float* out, int gw, int NGW, int lane, const float* slab, const float* gate  ) {
    int m = gw; if (m >= M) return;
    f32x4 vn[8], G8[8];
#pragma unroll
    for (int j = 0; j < 8; ++j) { vn[j] = *(const f32x4*)(x + (size_t)m * D + lane * 4 + 256 * j); G8[j] = *(const f32x4*)(g + lane * 4 + 256 * j); }
    while (m < M) {
        float* xr = x + (size_t)m * D + lane * 4;
        f32x4 v[8];
#pragma unroll
        for (int j = 0; j < 8; ++j) v[j] = vn[j];
        const int mn = m + NGW;
        if (mn < M) {
#pragma unroll
            for (int j = 0; j < 8; ++j) vn[j] = *(const f32x4*)(x + (size_t)mn * D + lane * 4 + 256 * j); }
        if (m >= MP) {
            const int cond = 1 + ((m - MP) >> 10);
            const float* sp = slab + (size_t)(m - MP) * D + lane * 4; const float* gt = gate + (size_t)cond * 12288 + lane * 4;
#pragma unroll
            for (int j = 0; j < 8; ++j) {
                const f32x4 p = (*(const f32x4*)(sp + 256 * j) + *(const f32x4*)(sp + (size_t)2048 * 2048 + 256 * j)) + (*(const f32x4*)(sp + (size_t)2 * 2048 * 2048 + 256 * j) + *(const f32x4*)(sp + (size_t)3 * 2048 * 2048 + 256 * j));
                v[j] = v[j] + *(const f32x4*)(gt + 256 * j) * p;
#if DBG_CHECKS
                *(f32x4*)(xr + 256 * j) = v[j];
#endif
            }
        }
        (void)xr;
        float ss = 0.f;
#pragma unroll
        for (int j = 0; j < 8; ++j) ss += (v[j].x * v[j].x + v[j].y * v[j].y) + (v[j].z * v[j].z + v[j].w * v[j].w);
        const float rstd = 1.0f / sqrtf(wave_sum(ss) * (1.0f / D) + NORM_EPS);
        float* orow = out + (size_t)m * D + lane * 4;
#pragma unroll
        for (int j = 0; j < 8; ++j) *(f32x4*)(orow + 256 * j) = v[j] * rstd * G8[j];
        m = mn;
    }
}


__device__ __forceinline__ void unpack8(const v4u w, f32x4& a, f32x4& b) { a = (f32x4){bf_lo(w.x), bf_hi(w.x), bf_lo(w.y), bf_hi(w.y)}; b = (f32x4){bf_lo(w.z), bf_hi(w.z), bf_lo(w.w), bf_hi(w.w)}; }
template <bool SF32>
__device__ __forceinline__ void norm_rows_b(const bf16* x, const float* xs, const float* g, const float* modl, int jshift, int jscale, bf16* out, int gw, int NGW, int lane,
                                            const bf16* slab, const float* gatep, bf16* xw) {
    if (gw >= M) return;
    int m = gw + ((M - 1 - gw) / NGW) * NGW;
    v4u pn[4];
    if (m < MP) { const bf16* xr = x + (size_t)m * D + lane * 8;
#pragma unroll
        for (int j = 0; j < 4; ++j) pn[j] = *(const v4u*)(xr + 512 * j); }
    int ccur = -1; f32x4 A[4][2], B[4][2];
    while (m >= 0) {
        const int mn = m - NGW;
        f32x4 v[4][2];
        const int cond = m < MP ? 0 : 1 + ((m - MP) >> 10);
        if (m >= MP) {
            const bf16* sp = slab + (size_t)(m - MP) * D + lane * 8; const float* gt = gatep + (size_t)cond * 12288 + lane * 8;
            v4u s[4][4];
            if constexpr (SF32) { const float* xr = xs + (size_t)m * D + lane * 8;
#pragma unroll
                for (int j = 0; j < 4; ++j) { v[j][0] = *(const f32x4*)(xr + 512 * j); v[j][1] = *(const f32x4*)(xr + 512 * j + 4); } }
            else { const bf16* xr = x + (size_t)m * D + lane * 8;
#pragma unroll
                for (int j = 0; j < 4; ++j) { const v4u w = *(const v4u*)(xr + 512 * j); unpack8(w, v[j][0], v[j][1]); } }
#pragma unroll
            for (int k = 0; k < 4; ++k)
#pragma unroll
                for (int j = 0; j < 4; ++j) s[k][j] = *(const v4u*)(sp + (size_t)k * 2048 * 2048 + 512 * j);
            if (mn >= 0 && mn < MP) { const bf16* xr = x + (size_t)mn * D + lane * 8;
#pragma unroll
                for (int j = 0; j < 4; ++j) pn[j] = *(const v4u*)(xr + 512 * j); }
            bf16* wr = xw + (size_t)m * D + lane * 8;
#pragma unroll
            for (int j = 0; j < 4; ++j) {
                f32x4 p0, p1, q0, q1; unpack8(s[0][j], p0, p1); unpack8(s[1][j], q0, q1); p0 += q0; p1 += q1; unpack8(s[2][j], q0, q1); f32x4 r0, r1; unpack8(s[3][j], r0, r1); p0 += q0 + r0; p1 += q1 + r1;
                v[j][0] += *(const f32x4*)(gt + 512 * j) * p0; v[j][1] += *(const f32x4*)(gt + 512 * j + 4) * p1;
                v4u o; o.x = cvtpk(v[j][0].x, v[j][0].y); o.y = cvtpk(v[j][0].z, v[j][0].w); o.z = cvtpk(v[j][1].x, v[j][1].y); o.w = cvtpk(v[j][1].z, v[j][1].w);
                *(v4u*)(wr + 512 * j) = o;
                unpack8(o, v[j][0], v[j][1]);
            }
        } else {
#pragma unroll
            for (int j = 0; j < 4; ++j) unpack8(pn[j], v[j][0], v[j][1]);
            if (mn >= 0) { const bf16* xr = x + (size_t)mn * D + lane * 8;
#pragma unroll
                for (int j = 0; j < 4; ++j) pn[j] = *(const v4u*)(xr + 512 * j); }
        }
        if (cond != ccur) {
            const float* sh = modl + (size_t)cond * 12288 + jshift * 2048 + lane * 8; const float* sc = modl + (size_t)cond * 12288 + jscale * 2048 + lane * 8;
#pragma unroll
            for (int j = 0; j < 4; ++j)
#pragma unroll
                for (int h = 0; h < 2; ++h) { A[j][h] = *(const f32x4*)(g + lane * 8 + 512 * j + 4 * h) * (*(const f32x4*)(sc + 512 * j + 4 * h) + 1.0f); B[j][h] = *(const f32x4*)(sh + 512 * j + 4 * h); }
            ccur = cond;
        }
        float ss = 0.f;
#pragma unroll
        for (int j = 0; j < 4; ++j)
#pragma unroll
            for (int h = 0; h < 2; ++h) ss += (v[j][h].x * v[j][h].x + v[j][h].y * v[j][h].y) + (v[j][h].z * v[j][h].z + v[j][h].w * v[j][h].w);
        const float rstd = 1.0f / sqrtf(wave_sum(ss) * (1.0f / D) + NORM_EPS);
        bf16* orow = out + (size_t)m * D + lane * 8;
#pragma unroll
        for (int j = 0; j < 4; ++j) {
            const f32x4 o0 = v[j][0] * rstd * A[j][0] + B[j][0], o1 = v[j][1] * rstd * A[j][1] + B[j][1];
            v4u w; w.x = cvtpk(o0.x, o0.y); w.y = cvtpk(o0.z, o0.w); w.z = cvtpk(o1.x, o1.y); w.w = cvtpk(o1.z, o1.w);
            *(v4u*)(orow + 512 * j) = w;
        }
        m = mn;
    }
}
__device__ __forceinline__ void final_norm_rows_b(const bf16* x, const float* g, float* out, int gw, int NGW, int lane, const bf16* slab, const float* gate  ) {
    if (gw >= M) return;
    int m = gw + ((M - 1 - gw) / NGW) * NGW;
    v4u pn[4]; f32x4 G8[4][2];
#pragma unroll
    for (int j = 0; j < 4; ++j) { G8[j][0] = *(const f32x4*)(g + lane * 8 + 512 * j); G8[j][1] = *(const f32x4*)(g + lane * 8 + 512 * j + 4); }
    { const bf16* xr = x + (size_t)m * D + lane * 8;
#pragma unroll
      for (int j = 0; j < 4; ++j) pn[j] = *(const v4u*)(xr + 512 * j); }
    while (m >= 0) {
        const int mn = m - NGW;
        f32x4 v[4][2];
#pragma unroll
        for (int j = 0; j < 4; ++j) unpack8(pn[j], v[j][0], v[j][1]);
        if (m >= MP) {
            const int cond = 1 + ((m - MP) >> 10);
            const bf16* sp = slab + (size_t)(m - MP) * D + lane * 8; const float* gt = gate + (size_t)cond * 12288 + lane * 8;
            v4u s[4][4];
#pragma unroll
            for (int k = 0; k < 4; ++k)
#pragma unroll
                for (int j = 0; j < 4; ++j) s[k][j] = *(const v4u*)(sp + (size_t)k * 2048 * 2048 + 512 * j);
            if (mn >= 0) { const bf16* xr = x + (size_t)mn * D + lane * 8;
#pragma unroll
                for (int j = 0; j < 4; ++j) pn[j] = *(const v4u*)(xr + 512 * j); }
#pragma unroll
            for (int j = 0; j < 4; ++j) {
                f32x4 p0, p1, q0, q1; unpack8(s[0][j], p0, p1); unpack8(s[1][j], q0, q1); p0 += q0; p1 += q1; unpack8(s[2][j], q0, q1); f32x4 r0, r1; unpack8(s[3][j], r0, r1); p0 += q0 + r0; p1 += q1 + r1;
                v[j][0] += *(const f32x4*)(gt + 512 * j) * p0; v[j][1] += *(const f32x4*)(gt + 512 * j + 4) * p1;
            }
        } else if (mn >= 0) { const bf16* xr = x + (size_t)mn * D + lane * 8;
#pragma unroll
            for (int j = 0; j < 4; ++j) pn[j] = *(const v4u*)(xr + 512 * j); }
        float ss = 0.f;
#pragma unroll
        for (int j = 0; j < 4; ++j)
#pragma unroll
            for (int h = 0; h < 2; ++h) ss += (v[j][h].x * v[j][h].x + v[j][h].y * v[j][h].y) + (v[j][h].z * v[j][h].z + v[j][h].w * v[j][h].w);
        const float rstd = 1.0f / sqrtf(wave_sum(ss) * (1.0f / D) + NORM_EPS);
        float* orow = out + (size_t)m * D + lane * 8;
#pragma unroll
        for (int j = 0; j < 4; ++j) { *(f32x4*)(orow + 512 * j) = v[j][0] * rstd * G8[j][0]; *(f32x4*)(orow + 512 * j + 4) = v[j][1] * rstd * G8[j][1]; }
        m = mn;
    }
}

__device__ __forceinline__ void load8(const bf16* p, float (&o)[8]) {
    const v4u w = *(const v4u*)p;
    o[0] = bf_lo(w.x); o[1] = bf_hi(w.x); o[2] = bf_lo(w.y); o[3] = bf_hi(w.y); o[4] = bf_lo(w.z); o[5] = bf_hi(w.z); o[6] = bf_lo(w.w); o[7] = bf_hi(w.w);
}
__device__ __forceinline__ void conv_gate_s(const bf16* ups, const float* cw, const float* cb, bf16* act, int gtid, int NGT) {
    constexpr int NCH = FF / 8, RB = 8;
    for (int it = gtid; it < (MS / RB) * NCH; it += NGT) {
        const int rb = it / NCH, ch = it % NCH, f0 = ch * 8, r0 = rb * RB, cg = 256 * (f0 >> 7) + (f0 & 127), cv_ = cg + 128;
        float w0g[8], w1g[8], w2g[8], bg[8], w0v[8], w1v[8], w2v[8], bv[8];
#pragma unroll
        for (int e = 0; e < 8; ++e) { w0g[e] = cw[f0 + e]; w1g[e] = cw[F2 + f0 + e]; w2g[e] = cw[2 * F2 + f0 + e]; bg[e] = cb[f0 + e];
            w0v[e] = cw[FF + f0 + e]; w1v[e] = cw[F2 + FF + f0 + e]; w2v[e] = cw[2 * F2 + FF + f0 + e]; bv[e] = cb[FF + f0 + e]; }
        const int pos0 = r0 & (DSEQ - 1);
        float pg[8], pv[8], cg_[8], cv[8], ng[8], nv[8];
        if (pos0 == 0) {
#pragma unroll
            for (int e = 0; e < 8; ++e) { pg[e] = 0.f; pv[e] = 0.f; }
        } else { load8(ups + (size_t)(r0 - 1) * F2 + cg, pg); load8(ups + (size_t)(r0 - 1) * F2 + cv_, pv); }
        load8(ups + (size_t)r0 * F2 + cg, cg_); load8(ups + (size_t)r0 * F2 + cv_, cv);
#pragma unroll
        for (int i = 0; i < RB; ++i) {
            const int r = r0 + i;
            if (pos0 + i + 1 >= DSEQ) {
#pragma unroll
                for (int e = 0; e < 8; ++e) { ng[e] = 0.f; nv[e] = 0.f; }
            } else { load8(ups + (size_t)(r + 1) * F2 + cg, ng); load8(ups + (size_t)(r + 1) * F2 + cv_, nv); }
            float o[8];
#pragma unroll
            for (int e = 0; e < 8; ++e) {
                const float zg = w0g[e] * pg[e] + w1g[e] * cg_[e] + w2g[e] * ng[e] + bg[e];
                const float zv = w0v[e] * pv[e] + w1v[e] * cv[e] + w2v[e] * nv[e] + bv[e];
                o[e] = zg * __builtin_amdgcn_rcpf(1.0f + __builtin_amdgcn_exp2f(-LOG2E * zg)) * zv;
                pg[e] = cg_[e]; pv[e] = cv[e]; cg_[e] = ng[e]; cv[e] = nv[e];
            }
            v4u w; w.x = pk2(o[0], o[1]); w.y = pk2(o[2], o[3]); w.z = pk2(o[4], o[5]); w.w = pk2(o[6], o[7]);
            *(v4u*)(act + (size_t)(MP + r) * FF + f0) = w;
        }
    }
}

__device__ __forceinline__ f32x16 mfma32(bf16x8 a, bf16x8 b, f32x16 c) { return __builtin_amdgcn_mfma_f32_32x32x16_bf16(a, b, c, 0, 0, 0); }
#define LDSR128(dst, a, off) asm volatile("ds_read_b128 %0, %1 offset:%2" : "=v"(dst) : "v"(a), "n"(off))
#define LDSR32(dst, a) asm volatile("ds_read_b32 %0, %1" : "=v"(dst) : "v"(a))
#define LDS_DRAIN() do { asm volatile("s_waitcnt lgkmcnt(0)" ::: "memory"); __builtin_amdgcn_sched_barrier(0); } while (0)
__device__ __forceinline__ void attn_chunk(const LAS unsigned char* kbuf, const LAS unsigned char* vbuf, const bf16x8 (&qf)[8], f32x16 (&o)[4], float& m_run, float& l_run, int lane,
                                           const LAS float* rpbL, bool WIN, int wq, int drb, int jj, bool attend) {
    const int hi = lane >> 5;
    f32x16 s[2];
#pragma unroll
    for (int r = 0; r < 16; ++r) { s[0][r] = 0.f; s[1][r] = 0.f; }
#pragma unroll
    for (int hb = 0; hb < 2; ++hb) {
        bf16x8 kf[8];
#pragma unroll
        for (int q = 0; q < 8; ++q) kf[q] = *(const LAS bf16x8*)(kbuf + (((q >> 2) * 8 + 4 * hb + (q & 3)) * 64 + lane) * 16);
#pragma unroll
        for (int q = 0; q < 4; ++q) { s[0] = mfma32(kf[q], qf[4 * hb + q], s[0]); s[1] = mfma32(kf[4 + q], qf[4 * hb + q], s[1]); }
        __builtin_amdgcn_sched_group_barrier(0x100, 8, 0);
        __builtin_amdgcn_sched_group_barrier(0x008, 8, 0);
    }
    if (WIN) {
        asm volatile("" : "+v"(wq));
        const int cs = attend ? min(max(wq - 8, 0), 48) : 4096;
        const LAS float* tb = rpbL + (attend ? (drb + jj + 7) * 31 + 15 : 15);
#pragma unroll
        for (int kb = 0; kb < 2; ++kb) {
            float bv[16];
#pragma unroll
            for (int r = 0; r < 16; ++r) {
                const int wk = 32 * kb + (r & 3) + 8 * (r >> 2) + 4 * hi, dd = wk - wq;
                const int okm = -(int)((wk >= cs) & (wk < cs + 16));
                bv[r] = tb[dd & okm];
            }
#pragma unroll
            for (int r = 0; r < 16; ++r) {
                const int wk = 32 * kb + (r & 3) + 8 * (r >> 2) + 4 * hi;
                const bool ok = (wk >= cs) && (wk < cs + 16);
                s[kb][r] = ok ? s[kb][r] + bv[r] : -1e30f;
            }
        }
    }
    float mx = s[0][0];
#pragma unroll
    for (int kb = 0; kb < 2; ++kb)
#pragma unroll
        for (int r = 0; r < 16; ++r) mx = fmaxf(mx, s[kb][r]);
    mx = fmaxf(mx, __shfl_xor(mx, 32));
    const float m_new = fmaxf(m_run, mx);
    const float alpha = __builtin_amdgcn_exp2f(m_run - m_new);
    m_run = m_new;
    float ls = 0.f;
#pragma unroll
    for (int kb = 0; kb < 2; ++kb)
#pragma unroll
        for (int r = 0; r < 16; ++r) { const float p = __builtin_amdgcn_exp2f(s[kb][r] - m_new); s[kb][r] = p; ls += p; }
    l_run = l_run * alpha + ls;
#pragma unroll
    for (int db = 0; db < 4; ++db)
#pragma unroll
        for (int r = 0; r < 16; ++r) o[db][r] *= alpha;
#pragma unroll
    for (int kb = 0; kb < 2; ++kb) {
        bf16x8 vf[8];
#pragma unroll
        for (int i = 0; i < 8; ++i) vf[i] = *(const LAS bf16x8*)(vbuf + ((kb * 8 + i) * 64 + lane) * 16);
        bf16x8 pf[2];
#pragma unroll
        for (int s2 = 0; s2 < 2; ++s2) {
            v4u pw; pw.x = cvtpk(s[kb][8 * s2 + 0], s[kb][8 * s2 + 1]); pw.y = cvtpk(s[kb][8 * s2 + 2], s[kb][8 * s2 + 3]); pw.z = cvtpk(s[kb][8 * s2 + 4], s[kb][8 * s2 + 5]); pw.w = cvtpk(s[kb][8 * s2 + 6], s[kb][8 * s2 + 7]);
            pf[s2] = __builtin_bit_cast(bf16x8, pw); }
#pragma unroll
        for (int s2 = 0; s2 < 2; ++s2)
#pragma unroll
            for (int db = 0; db < 4; ++db) o[db] = mfma32(vf[s2 * 4 + db], pf[s2], o[db]);
        __builtin_amdgcn_sched_group_barrier(0x100, 8, 0);
        __builtin_amdgcn_sched_group_barrier(0x008, 8, 0);
    }
}
__device__ __forceinline__ void attn_store(const f32x16 (&o)[4], float l_run, bf16* Orow  , int lane) {
    const int hi = lane >> 5;
    const float lt = l_run + __shfl_xor(l_run, 32);
    const float inv = 1.0f / lt;
#pragma unroll
    for (int db = 0; db < 4; ++db)
#pragma unroll
        for (int rg = 0; rg < 4; ++rg) {
            u32x2 w; w.x = cvtpk(o[db][4 * rg + 0] * inv, o[db][4 * rg + 1] * inv); w.y = cvtpk(o[db][4 * rg + 2] * inv, o[db][4 * rg + 3] * inv);
            *(u32x2*)(Orow + 32 * db + 8 * rg + 4 * hi) = w;
        }
}
__device__ __forceinline__ void attn_issue(LAS unsigned char* buf, const bf16* Kc, const bf16* Vc, int wave, int lane) {
    const unsigned lo = (unsigned)((2 * wave * 64 + lane) * 16);
    const char* kb = (const char*)Kc; const char* vb = (const char*)Vc;
#pragma unroll
    for (int i = 0; i < 2; ++i) {
        __builtin_amdgcn_global_load_lds((const unsigned*)(kb + lo + i * 1024), (LAS unsigned*)(buf + (2 * wave + i) * 1024), 16, 0, 0);
        __builtin_amdgcn_global_load_lds((const unsigned*)(vb + lo + i * 1024), (LAS unsigned*)(buf + 16384 + (2 * wave + i) * 1024), 16, 0, 0);
    }
}
#define ATTN_WAIT_BAR(n) asm volatile("s_waitcnt vmcnt(" #n ") lgkmcnt(0)\n\ts_barrier" ::: "memory")
__device__ __forceinline__ void attn_wait_bar(int ahead) {
    if (ahead >= 3) ATTN_WAIT_BAR(12); else if (ahead == 2) ATTN_WAIT_BAR(8); else if (ahead == 1) ATTN_WAIT_BAR(4); else ATTN_WAIT_BAR(0);
}
__device__ __forceinline__ void attn_phase(LAS unsigned char* lds, const bf16* Qb, const bf16* Kf, const bf16* VTf, bf16* Ob, const float* rpb, int tid, int wave, int lane) {
    const int r32 = lane & 31, hi = lane >> 5;
    LAS float* rpbL = (LAS float*)(lds + XCH_OFF);
    const int G = gridDim.x, nlat = G / 2 < 128 ? G / 2 : 128;
    const bool lat = (int)blockIdx.x < nlat;
    const int ufirst = lat ? (int)blockIdx.x : (int)blockIdx.x - nlat, ustep = lat ? nlat : G - nlat, uend = lat ? 128 : 512;
    for (int un = ufirst; un < uend; un += ustep) {
        const int b = lat ? un >> 6 : un >> 4, h = lat ? (un >> 2) & 15 : un & 15, rg4 = un & 3;
        const int r = 4 * rg4 + (wave >> 1), wq0 = 32 * (wave & 1), start = min(max(r - 4, 0), 8);
        const int jmin = min(max(4 * rg4 - 4, 0), 8), jmax = min(max(4 * rg4 - 1, 0), 8) + 7;
        const int n0 = lat ? 8 : 4, nch = lat ? 8 + (jmax - jmin + 1) : 4;
        const int qrow = lat ? MP + b * DSEQ + r * 64 + wq0 + r32 : b * SEQ + 32 * wave + r32;
        const size_t base0 = lat ? pg8::seq_base_cache(b, h) : (size_t)(b * 16 + h) * 256 * 128, base1 = pg8::KF_SAMPLE + (size_t)(b * 16 + h) * 1024 * 128 + (size_t)jmin * 8192;
        ATTN_WAIT_BAR(0);
        if (lat) for (int i = tid; i < 465; i += NTHR) rpbL[i] = rpb[h * 465 + i] * LOG2E;
        attn_issue(lds, Kf + base0, VTf + base0, wave, lane);
        bf16x8 qf[8];
#pragma unroll
        for (int st = 0; st < 8; ++st) qf[st] = *(const bf16x8*)(Qb + (size_t)qrow * D + h * HD + 16 * st + 8 * hi);
        attn_issue(lds + 32768, Kf + base0 + 8192, VTf + base0 + 8192, wave, lane);
        attn_issue(lds + 65536, Kf + base0 + 16384, VTf + base0 + 16384, wave, lane);
        f32x16 o[4];
#pragma unroll
        for (int db = 0; db < 4; ++db)
#pragma unroll
            for (int rr = 0; rr < 16; ++rr) o[db][rr] = 0.f;
        float m_run = -1e30f, l_run = 0.f;
#pragma unroll 1
        for (int i = 0; i < nch; ++i) {
            attn_wait_bar(min(nch - 1 - i, 2));
            if (i + 3 < nch) { const int n3 = i + 3; const size_t co = n3 < n0 ? base0 + (size_t)n3 * 8192 : base1 + (size_t)(n3 - n0) * 8192;
                attn_issue(lds + (n3 & 3) * 32768, Kf + co, VTf + co, wave, lane); }
            const LAS unsigned char* kb_ = lds + (i & 3) * 32768;
            const int j = jmin + i - n0;
            attn_chunk(kb_, kb_ + 16384, qf, o, m_run, l_run, lane, rpbL, i >= n0, wq0 + r32, start - r, j - start, j >= start && j < start + 8);
        }
        attn_store(o, l_run, Ob + (size_t)qrow * D + h * HD, lane);
    }
}

__device__ __forceinline__ void cpow(float are, float aim, float dt, int e, float& pr, float& pi) {
    const float fe = (float)e, mag = __expf(are * dt * fe);
    float ang = aim * dt * fe; const float k = rintf(ang * 0.15915494309189535f);
    ang = fmaf(-k, 6.28318548202514648f, ang); ang = fmaf(-k, -1.74845553146e-7f, ang);
    pr = mag * __cosf(ang); pi = mag * __sinf(ang);
}
__device__ __forceinline__ void s5w_gen(LAS unsigned char* lds, bf16* S5W, int tid, int rank, int nrank) {
    LAS float* pwr = (LAS float*)lds; LAS float* pwi = pwr + 17 * 128; LAS float* bbr = pwi + 17 * 128; LAS float* bbi = bbr + 2048; LAS float* bbTr = bbi + 2048; LAS float* bbTi = bbTr + 2048;
    LAS float* ccTr = bbTi + 2048; LAS float* ccTi = ccTr + 2048; LAS float* KFT = ccTi + 2048; LAS float* pwT = KFT + 31 * 256;
    const float* are = ARG_IN(I_ARE); const float* aim = ARG_IN(I_AIM); const float* ldt = ARG_IN(I_LOGDT); const float* bre = ARG_IN(I_BRE); const float* bim = ARG_IN(I_BIM); const float* cre = ARG_IN(I_CRE); const float* cim = ARG_IN(I_CIM); const float* sd = ARG_IN(I_SD);
    for (int it = rank; it < 2 * NG; it += nrank) {
        const int g = it >> 1, half = it & 1;
        __syncthreads();
        {
            const int sp = tid & 127, dir = sp >> 6, p = sp & 63, eq = tid >> 7;
            const float ar = are[(dir * NG + g) * SP + p], ai = aim[(dir * NG + g) * SP + p], dt = __expf(ldt[dir * NG + g]);
            for (int e = eq; e <= 16; e += 4) { float pr, pi; cpow(ar, ai, dt, e, pr, pi); pwr[e * 128 + sp] = pr; pwi[e * 128 + sp] = pi; if (e < 16) { pwT[sp * 32 + e] = pr; pwT[sp * 32 + 16 + e] = pi; } }
            float a1r, a1i; cpow(ar, ai, dt, 1, a1r, a1i);
            const float den = ar * ar + ai * ai, nr = a1r - 1.0f, ni = a1i;
            const float cfr = (nr * ar + ni * ai) / den, cfi = (ni * ar - nr * ai) / den;
            const f32x4 b4r = *(const f32x4*)(bre + ((size_t)(dir * NG + g) * SP + p) * GC + eq * 4), b4i = *(const f32x4*)(bim + ((size_t)(dir * NG + g) * SP + p) * GC + eq * 4);
#pragma unroll
            for (int q = 0; q < 4; ++q) { const int c = eq * 4 + q; const float vr = cfr * b4r[q] - cfi * b4i[q], vi = cfr * b4i[q] + cfi * b4r[q];
                bbr[sp * 16 + c] = vr; bbi[sp * 16 + c] = vi; bbTr[c * 128 + sp] = vr; bbTi[c * 128 + sp] = vi; }
        }
        for (int i = tid; i < 2048; i += NTHR) { const int dir = i >> 10, c = (i >> 6) & 15, p = i & 63; ccTr[(dir * 64 + p) * 16 + c] = cre[((size_t)(dir * NG + g) * GC) * SP + (i & 1023)]; ccTi[(dir * 64 + p) * 16 + c] = cim[((size_t)(dir * NG + g) * GC) * SP + (i & 1023)]; }
        __syncthreads();
        bf16* W0 = S5W + ((size_t)g * 3 + 0) * 65536; bf16* W1 = W0 + 65536; bf16* W2 = W1 + 65536;
        if (half == 0) {
            for (int i = tid; i < 8192; i += NTHR) {
                const int n = (i >> 10) * 32 + (i & 31), k0 = ((i >> 6) & 15) * 16 + ((i >> 5) & 1) * 8;
                {
                    const int dir = n >> 7, ri = (n >> 6) & 1, p = n & 63, s = k0 >> 4, c0 = k0 & 15, e = dir ? s : 15 - s, sp = dir * 64 + p;
                    const float pr = pwr[e * 128 + sp], pi = pwi[e * 128 + sp]; float v[8];
#pragma unroll
                    for (int q = 0; q < 8; ++q) { const float br = bbTr[(c0 + q) * 128 + sp], bi = bbTi[(c0 + q) * 128 + sp]; v[q] = ri ? (pr * bi + pi * br) : (pr * br - pi * bi); }
                    v4u o; o.x = pk2(v[0], v[1]); o.y = pk2(v[2], v[3]); o.z = pk2(v[4], v[5]); o.w = pk2(v[6], v[7]);
                    *(v4u*)(W0 + (size_t)i * 8) = o;
                }
                {
                    const int t = n >> 4, c = n & 15, dir = k0 >> 7, ri = (k0 >> 6) & 1, p0 = k0 & 63, e = dir ? 16 - t : t + 1; float v[8];
#pragma unroll
                    for (int q = 0; q < 8; ++q) { const int sp = dir * 64 + p0 + q; const float pr = pwr[e * 128 + sp], pi = pwi[e * 128 + sp], cr = ccTr[sp * 16 + c], ci = ccTi[sp * 16 + c];
                        v[q] = ri ? -(cr * pi + ci * pr) : (cr * pr - ci * pi); }
                    v4u o; o.x = pk2(v[0], v[1]); o.y = pk2(v[2], v[3]); o.z = pk2(v[4], v[5]); o.w = pk2(v[6], v[7]);
                    *(v4u*)(W1 + (size_t)i * 8) = o;
                }
            }
        } else {
            {
                const int dir = tid >> 8, c = (tid >> 4) & 15, cp = tid & 15;
                float acc[16];
#pragma unroll
                for (int e = 0; e < 16; ++e) acc[e] = 0.f;
                for (int p = 0; p < 64; ++p) {
                    const int sp = dir * 64 + p;
                    const float cr = ccTr[sp * 16 + c], ci = ccTi[sp * 16 + c], br = bbr[sp * 16 + cp], bi = bbi[sp * 16 + cp];
                    const float zr = cr * br - ci * bi, zi = cr * bi + ci * br;
                    f32x4 pr4[4], pi4[4];
#pragma unroll
                    for (int q = 0; q < 4; ++q) { pr4[q] = *(const LAS f32x4*)(pwT + sp * 32 + 4 * q); pi4[q] = *(const LAS f32x4*)(pwT + sp * 32 + 16 + 4 * q); }
#pragma unroll
                    for (int e = 0; e < 16; ++e) acc[e] += zr * pr4[e >> 2][e & 3] - zi * pi4[e >> 2][e & 3];
                }
                if (dir == 0) {
#pragma unroll
                    for (int e = 1; e < 16; ++e) KFT[((15 + e) * 16 + cp) * 16 + c] = acc[e];
                    KFT[(15 * 16 + cp) * 16 + c] = acc[0] + (c == cp ? sd[g * 16 + c] : 0.f);
                } else {
#pragma unroll
                    for (int e = 1; e < 16; ++e) KFT[((15 - e) * 16 + cp) * 16 + c] = acc[e];
                }
                __syncthreads();
                if (dir == 1) KFT[(15 * 16 + cp) * 16 + c] += acc[0];
            }
            __syncthreads();
            for (int i = tid; i < 31 * 256; i += NTHR) {
                const int tau = i >> 8, c = (i >> 4) & 15, cp = i & 15;
                W2[i] = (bf16)f2bf(KFT[(tau * 16 + cp) * 16 + c]);
            }
        }
    }
}
constexpr int S5_SL_OFF = 0, S5_HIN_OFF = 65536, S5_UT_OFF = 98304;
#define LDS_BAR() asm volatile("s_waitcnt lgkmcnt(0)\n\ts_barrier" ::: "memory")
__device__ __forceinline__ void s5_phase(LAS unsigned char* lds, const bf16* U, const bf16* S5W, bf16* Y, float* out, int tid, int wave, int lane) {
    LAS float* Sl = (LAS float*)(lds + S5_SL_OFF); LAS bf16* Hin = (LAS bf16*)(lds + S5_HIN_OFF); const LAS unsigned char* Ut = lds + S5_UT_OFF;
    const int r32 = lane & 31, hi = lane >> 5;
    int gcur = -1; float a16r = 0.f, a16i = 0.f;
    bf16x8 bA[16], bB[16];
    if ((int)blockIdx.x < NG * 10) { const bf16* U0 = U + ((size_t)(((int)blockIdx.x & 127) * 10 + ((int)blockIdx.x >> 7)) * 2 * 16 * 64) * 8;
#pragma unroll
        for (int i = 0; i < 4; ++i) { const int piece = 4 * wave + i; __builtin_amdgcn_global_load_lds((const unsigned*)(U0 + (piece * 64 + lane) * 8), (LAS unsigned*)(lds + S5_UT_OFF + piece * 1024), 16, 0, 0); } }
    for (int un = blockIdx.x; un < NG * 10; un += gridDim.x) {
        const int g = un & 127, rb = un >> 7;
        if (g != gcur) { const int dir = (tid >> 6) & 1, p = tid & 63; const float ar = ARG_IN(I_ARE)[(dir * NG + g) * SP + p], ai = ARG_IN(I_AIM)[(dir * NG + g) * SP + p], dt = __expf(ARG_IN(I_LOGDT)[dir * NG + g]);
            cpow(ar, ai, dt, 16, a16r, a16i); gcur = g;
            LDS_BAR();
            { const bf16* kfg = S5W + ((size_t)g * 3 + 2) * 65536; for (int i = tid; i < 31 * 256 / 8; i += NTHR) *(LAS v4u*)(lds + KFB_OFF + i * 16) = *(const v4u*)(kfg + i * 8); }
            { const bf16* WSt = S5W + ((size_t)g * 3 + 0) * 65536 + ((size_t)(wave * 16) * 64 + lane) * 8;
#pragma unroll
              for (int st = 0; st < 16; ++st) { bA[st] = *(const bf16x8*)(WSt + 512 * st); bB[st] = *(const bf16x8*)(WSt + 65536 + 512 * st); } } }
        const int tok0 = rb * 1024;
        if (un == (int)blockIdx.x) asm volatile("s_waitcnt vmcnt(0)" ::: "memory"); else asm volatile("s_waitcnt vmcnt(4)" ::: "memory");
        LDS_BAR();
        {
            f32x16 acc[2];
#pragma unroll
            for (int mb = 0; mb < 2; ++mb)
#pragma unroll
                for (int r = 0; r < 16; ++r) acc[mb][r] = 0.f;
#pragma unroll
            for (int s2 = 0; s2 < 8; ++s2) {
                bf16x8 af[4];
#pragma unroll
                for (int i = 0; i < 4; ++i) af[i] = *(const LAS bf16x8*)(Ut + (((i & 1) * 16 + 2 * s2 + (i >> 1)) * 64 + lane) * 16);
#pragma unroll
                for (int i = 0; i < 4; ++i) acc[i & 1] = mfma32(af[i], bA[2 * s2 + (i >> 1)], acc[i & 1]);
                __builtin_amdgcn_sched_group_barrier(0x100, 4, 0); __builtin_amdgcn_sched_group_barrier(0x008, 4, 0);
            }
#pragma unroll
            for (int mb = 0; mb < 2; ++mb)
#pragma unroll
                for (int r = 0; r < 16; ++r) Sl[(32 * mb + (r & 3) + 8 * (r >> 2) + 4 * hi) * 256 + 32 * wave + r32] = acc[mb][r];
        }
        LDS_BAR();
        {
            const bool prompt = rb < 8;
            const int dir = (tid >> 6) & 1, p = tid & 63, bi = tid >> 7;
            if (prompt || tid < 128) {
                float hr = 0.f, hi_ = 0.f; const int nc = prompt ? 16 : 64, row0 = prompt ? bi * 16 : 0;
                if (!prompt) { const size_t si = ((size_t)((rb - 8) * 2 + dir) * NG + g) * SP + p; hr = ARG_IN(I_SRE)[si]; hi_ = ARG_IN(I_SIM)[si]; }
                const int cre_ = dir * 128 + p, cim_ = dir * 128 + 64 + p;
                const int hre = (cre_ >> 4) * 512 + ((cre_ >> 3) & 1) * 256 + (cre_ & 7), him = (cim_ >> 4) * 512 + ((cim_ >> 3) & 1) * 256 + (cim_ & 7);
                for (int c = 0; c < nc; ++c) {
                    const int row = row0 + (dir ? nc - 1 - c : c), ro = (row >> 5) * 8192 + (row & 31) * 8;
                    Hin[ro + hre] = (bf16)f2bf(hr); Hin[ro + him] = (bf16)f2bf(hi_);
                    const float sr = Sl[row * 256 + cre_], si = Sl[row * 256 + cim_];
                    const float nr = a16r * hr - a16i * hi_ + sr, ni = a16r * hi_ + a16i * hr + si;
                    hr = nr; hi_ = ni;
                }
                if (prompt) { const size_t so = ((size_t)((rb * 4 + bi) * 2 + dir) * NG + g) * SP + p; out[O_SRE + so] = hr; out[O_SIM + so] = hi_; }
            }
        }
        LDS_BAR();
#ifndef S5REP3
#define S5REP3 0
#endif
#pragma unroll
        for (int rp3_ = 0; rp3_ <= S5REP3; ++rp3_) {
            f32x16 acc[2];
#pragma unroll
            for (int mb = 0; mb < 2; ++mb)
#pragma unroll
                for (int r = 0; r < 16; ++r) acc[mb][r] = 0.f;
            const LAS unsigned char* kfl = lds + KFB_OFF + (((2 * wave + (r32 >> 4) + 15) * 256 + (lane & 15) * 16 + 8 * hi) * 2);
#pragma unroll
            for (int s2 = 0; s2 < 8; ++s2) {
                bf16x8 af[4], kf[2];
#pragma unroll
                for (int i = 0; i < 2; ++i) kf[i] = *(const LAS bf16x8*)(kfl - (2 * s2 + i) * 512);
#pragma unroll
                for (int i = 0; i < 4; ++i) af[i] = *(const LAS bf16x8*)(Ut + (((i & 1) * 16 + 2 * s2 + (i >> 1)) * 64 + lane) * 16);
#pragma unroll
                for (int i = 0; i < 4; ++i) acc[i & 1] = mfma32(af[i], kf[i >> 1], acc[i & 1]);
                __builtin_amdgcn_sched_group_barrier(0x100, 6, 0); __builtin_amdgcn_sched_group_barrier(0x008, 4, 0);
            }
            LDS_BAR();
            { const int un1 = un + (int)gridDim.x;
              if (un1 < NG * 10) { const bf16* U1 = U + ((size_t)((un1 & 127) * 10 + (un1 >> 7)) * 2 * 16 * 64) * 8;
#pragma unroll
                for (int i = 0; i < 4; ++i) { const int piece = 4 * wave + i; __builtin_amdgcn_global_load_lds((const unsigned*)(U1 + (piece * 64 + lane) * 8), (LAS unsigned*)(lds + S5_UT_OFF + piece * 1024), 16, 0, 0); } } }
#pragma unroll
            for (int s2 = 0; s2 < 8; ++s2) {
                bf16x8 af[4];
#pragma unroll
                for (int i = 0; i < 4; ++i) af[i] = *(const LAS bf16x8*)(Hin + (((i & 1) * 16 + 2 * s2 + (i >> 1)) * 64 + lane) * 8);
#pragma unroll
                for (int i = 0; i < 4; ++i) acc[i & 1] = mfma32(af[i], bB[2 * s2 + (i >> 1)], acc[i & 1]);
                __builtin_amdgcn_sched_group_barrier(0x100, 4, 0); __builtin_amdgcn_sched_group_barrier(0x008, 4, 0);
            }
            const int t = 2 * wave + (r32 >> 4), c = lane & 15;
            LAS bf16* Yt = (LAS bf16*)(lds + S5_SL_OFF);
#pragma unroll
            for (int mb = 0; mb < 2; ++mb)
#pragma unroll
                for (int r = 0; r < 16; ++r) { const int row = 32 * mb + (r & 3) + 8 * (r >> 2) + 4 * hi; Yt[(row * 16 + t) * 16 + c] = (bf16)f2bf(gelu_tanh(acc[mb][r])); }
        }
        LDS_BAR();
#pragma unroll
        for (int i = 0; i < 4; ++i) { const int p = tid + NTHR * i, tok = p >> 1, hf = p & 1;
            *(v4u*)(Y + (size_t)(tok0 + tok) * D + g * 16 + hf * 8) = *(const LAS v4u*)(lds + S5_SL_OFF + p * 16); }
    }
}
#ifndef DBG_CHECKS
#define DBG_CHECKS 0
#endif
#ifndef XB16
#define XB16 1
#endif
constexpr int N_PHASES = 19;
struct Args { const float* in[N_IN]; float* out; unsigned char* ws; int ph_lo, ph_hi, use_bar, pad; };
__global__ void __launch_bounds__(NTHR, 2) mega_fwd(Args args) {
    extern __shared__ __attribute__((aligned(16))) unsigned char lds_raw[];
    LAS unsigned char* lds = (LAS unsigned char*)lds_raw;
    { const int t0 = threadIdx.x; for (int u = t0; u < (LDS_BYTES - LDSCTL_OFF) / 4; u += NTHR) ((LAS unsigned*)(lds + LDSCTL_OFF))[u] = 0u; }
    __syncthreads();
    if (ARG_I32(2)) (void)xcd_barrier_post((unsigned*)((gu32*)(ARG_WS() + WS_CTL) + CW_BAR), (volatile LAS unsigned*)(lds + MISC_OFF) + 8);
#define PH_IDS() int tid = threadIdx.x; asm volatile("" : "+v"(tid)); int bid = blockIdx.x, G = gridDim.x; asm volatile("" : "+s"(bid), "+s"(G)); LAS unsigned char* lds_p = lds; asm volatile("" : "+s"(lds_p)); const int lane = tid & 63, wave = __builtin_amdgcn_readfirstlane(tid >> 6); \
    const int gw = bid * NWAVES + wave, NGW = G * NWAVES, gtid = bid * NTHR + tid, NGT = G * NTHR; (void)lane; (void)gw; (void)NGW; (void)gtid; (void)NGT; (void)G
#define ws ARG_WS()
#define out ARG_OUT()
#define mod ((float*)(ARG_WS() + WS_MOD))
#define HB ((bf16*)(ARG_WS() + WS_HB))
#define X1 ((float*)(ARG_WS() + WS_X1))
#define X1B ((bf16*)(ARG_WS() + WS_X1))
#define SLABB ((bf16*)(ARG_WS() + WS_SLAB))
#define IN(k) (ARG_I32(0) <= (k) && (k) < ARG_I32(1))
#define SEAM(k) do { if (IN(k) && IN((k) + 1)) { XcdBarrier bar_; bar_.bar = (unsigned*)((gu32*)(ARG_WS() + WS_CTL) + CW_BAR); bar_.x = xb_xcc_id(); bar_.st = (volatile LAS unsigned*)(lds + MISC_OFF) + 8; xcd_barrier(bar_); } } while (0)
#ifndef DEFER_P0
#define DEFER_P0 1
#endif
#ifndef DEFER_UP1
#define DEFER_UP1 1
#endif
#ifndef REP_MASK
#define REP_MASK 0
#endif
#define REPL(k) for (int rep_ = 0; rep_ <= (((unsigned)REP_MASK >> (k)) & 1); ++rep_)
#define xs_off (ARG_IN(I_XS) - (size_t)MP * D)

    if (IN(0)) { PH_IDS();
        p0_ada(lds_p, ARG_IN(I_ADAW), ARG_IN(I_ADAB), ARG_IN(I_CCTX), ARG_IN(I_C), mod, tid, wave, lane);
        const bool defer = DEFER_P0 && G == 256;
        p0_weights(lds_p, ws, gw, NGW, wave, lane, 0, 6144);
        p0_weights(lds_p, ws, gw, NGW, wave, lane, defer ? 8192 : 6144, 25344);
        if (!defer) p0_weights(lds_p, ws, gw, NGW, wave, lane, 25344, 47360);
        else if (!DEFER_UP1) { p0_weights(lds_p, ws, gw, NGW, wave, lane, 25344, 36352); p0_weights(lds_p, ws, gw, NGW, wave, lane, 41856, 47360); }
        p0_cache(ARG_IN(I_CK), ARG_IN(I_CV), (bf16*)(ws + WS_KF), (bf16*)(ws + WS_VTF), gtid, NGT);
    }
    SEAM(0);
#pragma unroll
    for (int l = 0; l < 2; ++l) {
        const int pb = l == 0 ? 1 : 9;
        const float* modl = mod + (size_t)l * 3 * 12288;
        if (IN(pb)) { PH_IDS();
            if (l == 0) REPL(1) norm_rows(ARG_IN(I_XP), xs_off, ARG_IN(I_N1G), modl, 0, 1, HB, gw, NGW, lane);
#if XB16
            else norm_rows_b<false>(X1B, nullptr, ARG_IN(I_N1G) + D, modl, 0, 1, HB, gw, NGW, lane, SLABB, mod + 5 * 2048, X1B);
#else
            else norm_rows(X1, X1, ARG_IN(I_N1G) + D, modl, 0, 1, HB, gw, NGW, lane, (const float*)(ws + WS_SLAB), mod + 5 * 2048, X1);
#endif
            if (l == 1 && G <= 64) s5w_gen(lds_p, (bf16*)(ws + WS_S5W), tid, bid, G);
        }
        SEAM(pb);
        if (l == 0) {
            if (IN(2)) { PH_IDS();
                pg8::Gemm g{HB, (const bf16*)(ws + WS_WQKV), M, 3 * D, D}; pg8::StaticOrder S; S.init(M, 3 * D, G, bid);
                pg8::EpiQKV E{(bf16*)(ws + WS_Q), (bf16*)(ws + WS_KF), (bf16*)(ws + WS_VTF), out + O_NK, out + O_NV, C2};
#if defined(PROBE_NULLEPI) && PROBE_NULLEPI == 2
                if (ARG_I32(3)) { pg8::EpiQKV E2{(bf16*)(ws + WS_Q), (bf16*)(ws + WS_KF), (bf16*)(ws + WS_VTF), (float*)(ws + WS_ACT), (float*)(ws + WS_ACT) + (size_t)8192 * 2048, C2}; pg8::gemm_phase<pg8::EpiQKV, pg8::StaticOrder, true, true>(lds_p, g, S, E2, tid); } else
#elif defined(PROBE_NULLEPI)
                if (ARG_I32(3)) { pg8::EpiNull EN; pg8::gemm_phase<pg8::EpiNull, pg8::StaticOrder, true, true>(lds_p, g, S, EN, tid); } else
#endif
                pg8::gemm_phase<pg8::EpiQKV, pg8::StaticOrder, true, true>(lds_p, g, S, E, tid);
                if (DEFER_P0 && G == 256 && bid >= 192) p0_weights(lds_p, ws, (bid - 192) * NWAVES + wave, 64 * NWAVES, wave, lane, 6144, 8192);
            }
            SEAM(2);
            if (IN(3)) { PH_IDS(); REPL(3) attn_phase(lds_p, (const bf16*)(ws + WS_Q), (const bf16*)(ws + WS_KF), (const bf16*)(ws + WS_VTF), (bf16*)(ws + WS_O), ARG_IN(I_RPB), tid, wave, lane); }
            SEAM(3);
            if (IN(4)) { PH_IDS();
                pg8::Gemm g{(const bf16*)(ws + WS_O), (const bf16*)(ws + WS_WO), M, D, D}; pg8::TailOrder S; S.init(D, G, bid);
#if XB16
                pg8::EpiRes3<true> E{ARG_IN(I_XP), (pg8::bf16_t*)X1B, modl + 2 * 2048, (pg8::bf16_t*)SLABB};
                pg8::gemm_phase<pg8::EpiRes3<true>, pg8::TailOrder, true, true>(lds_p, g, S, E, tid);
#else
                pg8::EpiRes2 E{ARG_IN(I_XP), X1, modl + 2 * 2048, (float*)(ws + WS_SLAB)};
                pg8::gemm_phase<pg8::EpiRes2, pg8::TailOrder, true, true>(lds_p, g, S, E, tid);
#endif
            }
            SEAM(4);
        } else {
            if (IN(10)) { PH_IDS();
                pg8::Gemm g{HB, (const bf16*)(ws + WS_WIN), M, D, D}; pg8::StaticOrder S; S.init(M, D, G, bid);
                pg8::EpiU E{(bf16*)(ws + WS_U)};
                pg8::gemm_phase<pg8::EpiU, pg8::StaticOrder, true, true>(lds_p, g, S, E, tid);
                if (G > 64 && bid >= 64) s5w_gen(lds_p, (bf16*)(ws + WS_S5W), tid, bid - 64, G - 64);
            }
            SEAM(10);
            if (IN(11)) { PH_IDS(); REPL(11) s5_phase(lds_p, (const bf16*)(ws + WS_U), (const bf16*)(ws + WS_S5W), (bf16*)(ws + WS_Y), out, tid, wave, lane); }
            SEAM(11);
            if (IN(12)) { PH_IDS();
                pg8::Gemm g{(const bf16*)(ws + WS_Y), (const bf16*)(ws + WS_WGATE), M, D, D}; pg8::StaticOrder S; S.init(M, D, G, bid);
                pg8::EpiGate E{(const bf16*)(ws + WS_Y), (bf16*)(ws + WS_Y2)};
                pg8::gemm_phase<pg8::EpiGate, pg8::StaticOrder, true, true>(lds_p, g, S, E, tid);
                if (DEFER_P0 && DEFER_UP1 && G == 256 && bid >= 64) { const int sw = (bid - 64) * NWAVES + wave;
                    p0_weights(lds_p, ws, sw, 192 * NWAVES, wave, lane, 25344, 36352); p0_weights(lds_p, ws, sw, 192 * NWAVES, wave, lane, 41856, 44608); }
            }
            SEAM(12);
            if (IN(13)) { PH_IDS();
                pg8::Gemm g{(const bf16*)(ws + WS_Y2), (const bf16*)(ws + WS_WOUT), M, D, D}; pg8::TailOrder S; S.init(D, G, bid);
#if XB16
                pg8::EpiRes3<false> E{X1B, (pg8::bf16_t*)X1B, modl + 2 * 2048, (pg8::bf16_t*)SLABB};
                pg8::gemm_phase<pg8::EpiRes3<false>, pg8::TailOrder, true, true>(lds_p, g, S, E, tid);
#else
                pg8::EpiRes2 E{X1, X1, modl + 2 * 2048, (float*)(ws + WS_SLAB)};
                pg8::gemm_phase<pg8::EpiRes2, pg8::TailOrder, true, true>(lds_p, g, S, E, tid);
#endif
            }
            SEAM(13);
        }
        const int fb = l == 0 ? 5 : 14;
#if XB16
        if (IN(fb)) { PH_IDS();
            if (l == 0) norm_rows_b<true>(X1B, xs_off, ARG_IN(I_N2G), modl, 3, 4, HB, gw, NGW, lane, SLABB, modl + 2 * 2048, X1B);
            else norm_rows_b<false>(X1B, nullptr, ARG_IN(I_N2G) + D, modl, 3, 4, HB, gw, NGW, lane, SLABB, modl + 2 * 2048, X1B); }
#else
        if (IN(fb)) { PH_IDS(); norm_rows(X1, l == 0 ? xs_off : X1, ARG_IN(I_N2G) + l * D, modl, 3, 4, HB, gw, NGW, lane, (const float*)(ws + WS_SLAB), modl + 2 * 2048, X1); }
#endif
        SEAM(fb);
        if (IN(fb + 1)) { PH_IDS();
            pg8::Gemm g{HB, (const bf16*)(ws + (l == 0 ? WS_WUP0 : WS_WUP1)), M, F2, D}; pg8::UpOrder S; S.init(G, bid);
            pg8::EpiConv E{(bf16*)(ws + WS_ACT), ARG_IN(I_CONVW) + (size_t)l * 3 * F2, ARG_IN(I_CONVB) + (size_t)l * F2, (LAS float*)(lds_p + XCH_OFF)};
#ifdef PROBE_NULLEPI
            if (ARG_I32(3)) { pg8::EpiNull EN; pg8::gemm_phase<pg8::EpiNull, pg8::UpOrder, true, true>(lds_p, g, S, EN, tid); } else
#endif
            pg8::gemm_phase<pg8::EpiConv, pg8::UpOrder, true, true>(lds_p, g, S, E, tid);
            if (DEFER_P0 && G == 256 && bid >= 184) { if (l == 0) p0_weights(lds_p, ws, (bid - 184) * NWAVES + wave, 72 * NWAVES, wave, lane, 36352, 41856); else if (DEFER_UP1) p0_weights(lds_p, ws, (bid - 184) * NWAVES + wave, 72 * NWAVES, wave, lane, 44608, 47360); }
        }
        do { if (IN(fb + 1) && (IN(fb + 2) || IN(fb + 3))) { XcdBarrier bar_; bar_.bar = (unsigned*)((gu32*)(ARG_WS() + WS_CTL) + CW_BAR); bar_.x = xb_xcc_id(); bar_.st = (volatile LAS unsigned*)(lds + MISC_OFF) + 8; xcd_barrier(bar_); } } while (0);
        if (IN(fb + 3)) { PH_IDS();
            pg8::Gemm g{(const bf16*)(ws + WS_ACT), (const bf16*)(ws + (l == 0 ? WS_WDN0 : WS_WDN1)), M, D, FF}; pg8::TailOrder S; S.init(FF, G, bid);
#if XB16
            pg8::EpiRes3<false> E{X1B, (pg8::bf16_t*)X1B, modl + 5 * 2048, (pg8::bf16_t*)SLABB};
#ifdef PROBE_NULLEPI
            if (ARG_I32(3)) { pg8::EpiNull EN; pg8::gemm_phase<pg8::EpiNull, pg8::TailOrder, true, true>(lds_p, g, S, EN, tid); } else
#endif
            pg8::gemm_phase<pg8::EpiRes3<false>, pg8::TailOrder, true, true>(lds_p, g, S, E, tid);
#else
            pg8::EpiRes2 E{X1, X1, modl + 5 * 2048, (float*)(ws + WS_SLAB)};
            pg8::gemm_phase<pg8::EpiRes2, pg8::TailOrder, true, true>(lds_p, g, S, E, tid);
#endif
        }
        SEAM(fb + 3);
    }
#if XB16
    if (IN(18)) { PH_IDS(); final_norm_rows_b(X1B, ARG_IN(I_FG), out + O_Y, gw, NGW, lane, SLABB, mod + (size_t)3 * 12288 + 5 * 2048); }
#else
    if (IN(18)) { PH_IDS(); REPL(18) final_norm_rows(X1, ARG_IN(I_FG), out + O_Y, gw, NGW, lane, (const float*)(ws + WS_SLAB), mod + (size_t)3 * 12288 + 5 * 2048); }
#endif
#ifdef PROBE_COPY
    if (IN(19)) { PH_IDS(); p0_weights(lds_p, ws, gw, NGW, wave, lane, 0, 47360); }
#endif
#undef IN
#undef SEAM
#undef ws
#undef out
#undef mod
#undef HB
#undef X1
#undef X1B
#undef SLABB
#undef xs_off
}
#if DBG_CHECKS
constexpr size_t WS_XBK = WS_S;
__device__ __forceinline__ unsigned hashu(unsigned x) { x ^= x >> 16; x *= 0x7feb352dU; x ^= x >> 15; x *= 0x846ca68bU; x ^= x >> 16; return x; }
__device__ __forceinline__ float bff(bf16 v) { return __uint_as_float((unsigned)v << 16); }
__device__ __forceinline__ void dacc(float* dbg, int stage, float got, float ref) { const float d = got - ref; atomicAdd(dbg + 2 * stage, d * d); atomicAdd(dbg + 2 * stage + 1, ref * ref); }
__device__ __forceinline__ float dotbf(const bf16* a, const bf16* b, int K) { float s = 0.f; for (int k = 0; k < K; ++k) s += bff(a[k]) * bff(b[k]); return s; }

__global__ void chk_mod(const float* adaw, const float* adab, const float* cctx, const float* cs, const float* mod, float* dbg) {
    const unsigned id = blockIdx.x * blockDim.x + threadIdx.x, hsh = hashu(id * 7919u + 13u);
    const int l = hsh & 1, cond = (hsh >> 1) % 3, n = (hsh >> 8) % 12288;
    const float* cv = cond == 0 ? cctx : cs + (cond - 1) * 2048;
    float s = adab[l * 12288 + n];
    for (int k = 0; k < 2048; ++k) s += silu_f(cv[k]) * adaw[((size_t)l * 2048 + k) * 12288 + n];
    dacc(dbg, 0, mod[(size_t)(l * 3 + cond) * 12288 + n], s);
}
__global__ void chk_wt(const float* W, const bf16* WT, int K, int N, float* dbg, int upw) {
    const unsigned id = blockIdx.x * blockDim.x + threadIdx.x, hsh = hashu(id * 7919u + 17u), h2 = hashu(hsh + 99u);
    const int k = hsh % K, n = h2 % N;
    dacc(dbg, 1, bff(WT[(size_t)(upw ? pg8::upw_row(n) : n) * K + k]), bff((bf16)f2bf(W[(size_t)k * N + n])));
}
__global__ void chk_cache(const float* ck, const float* cv, const bf16* Kf, const bf16* VTf, float* dbg) {
    const unsigned id = blockIdx.x * blockDim.x + threadIdx.x, hsh = hashu(id * 7919u + 19u);
    const int i = hsh % (2 * 512 * 2048), bt = i >> 11, col = i & 2047, b = bt >> 9, t = bt & 511, h = col >> 7, d = col & 127;
    dacc(dbg, 2, bff(Kf[pg8::seq_base_cache(b, h) + pg8::kf_off(t, d)]), ck[i]);
    dacc(dbg, 2, bff(VTf[pg8::seq_base_cache(b, h) + pg8::vtf_off(t, d)]), cv[i]);
}
__global__ void chk_norm(const float* xa, const float* xb, int xb_sub, const float* g, const float* modl, int jshift, int jscale, const bf16* out, float* dbg, int stage) {
    const unsigned id = blockIdx.x * blockDim.x + threadIdx.x, hsh = hashu(id * 7919u + 23u + stage), h2 = hashu(hsh + 5u);
    const int m = hsh % M, n = h2 % D;
    const float* xr = m < MP ? xa + (size_t)m * D : xb + (size_t)(m - xb_sub) * D;
    float ss = 0.f; for (int k = 0; k < D; ++k) ss += xr[k] * xr[k];
    const float rstd = 1.0f / sqrtf(ss / D + NORM_EPS); const int cond = m < MP ? 0 : 1 + ((m - MP) >> 10);
    const float ref = xr[n] * rstd * g[n] * (1.0f + modl[cond * 12288 + jscale * 2048 + n]) + modl[cond * 12288 + jshift * 2048 + n];
    dacc(dbg, stage, bff(out[(size_t)m * D + n]), ref);
}
__global__ void chk_final(const float* x, const float* g, const float* out, float* dbg, int stage) {
    const unsigned id = blockIdx.x * blockDim.x + threadIdx.x, hsh = hashu(id * 7919u + 29u), h2 = hashu(hsh + 5u);
    const int m = hsh % M, n = h2 % D; const float* xr = x + (size_t)m * D;
    float ss = 0.f; for (int k = 0; k < D; ++k) ss += xr[k] * xr[k];
    dacc(dbg, stage, out[(size_t)m * D + n], xr[n] / sqrtf(ss / D + NORM_EPS) * g[n]);
}
__global__ void chk_qkv(const bf16* HB, const bf16* Wt, const bf16* Q, const bf16* Kf, const bf16* VTf, const float* nk, const float* nv, float* dbg) {
    const unsigned id = blockIdx.x * blockDim.x + threadIdx.x, hsh = hashu(id * 7919u + 31u), h2 = hashu(hsh + 5u);
    const int m = hsh % M, n = h2 % (3 * D), sec = n / D, col = n % D, h = col >> 7, d = col & 127;
    const float acc = dotbf(HB + (size_t)m * D, Wt + (size_t)n * D, D);
    int t; const size_t sb = pg8::seq_base_row(m, h, t);
    if (sec == 0) dacc(dbg, 4, bff(Q[(size_t)m * D + col]), acc * C2);
    else if (sec == 1) { dacc(dbg, 4, bff(Kf[sb + pg8::kf_off(t, d)]), acc); if (m < MP) dacc(dbg, 4, nk[(size_t)m * D + col], acc); }
    else { dacc(dbg, 4, bff(VTf[sb + pg8::vtf_off(t, d)]), acc); if (m < MP) dacc(dbg, 4, nv[(size_t)m * D + col], acc); }
}
__device__ __forceinline__ float dotqk(const bf16* q, const bf16* Kf, size_t sb, int t) { float s = 0.f; for (int k = 0; k < HD; ++k) s += bff(q[k]) * bff(Kf[sb + pg8::kf_off(t, k)]); return s; }
__global__ void chk_attn(const bf16* Q, const bf16* Kf, const bf16* VTf, const float* rpb, const bf16* O, float* dbg) {
    const unsigned id = blockIdx.x * blockDim.x + threadIdx.x, hsh = hashu(id * 7919u + 37u), h2 = hashu(hsh + 5u);
    int m = hsh % M; if (id & 1) m = MP + (hsh % MS);
    const int h = h2 & 15, d = (h2 >> 4) & 127;
    const bf16* q = Q + (size_t)m * D + h * HD;
    float mx = -1e30f, l = 0.f, o = 0.f;
    auto step = [&](float lg, float v) { const float mn = fmaxf(mx, lg), a = exp2f(mx - mn), p = exp2f(lg - mn); l = l * a + p; o = o * a + p * v; mx = mn; };
    int tq; const size_t sb = pg8::seq_base_row(m, h, tq);
    if (m < MP) {
        for (int t = 0; t < 256; ++t) step(dotqk(q, Kf, sb, t), bff(VTf[sb + pg8::vtf_off(t, d)]));
    } else { const int b = (m - MP) >> 10, pos = tq, r = pos >> 6, wq = pos & 63, start = min(max(r - 4, 0), 8), cs = min(max(wq - 8, 0), 48);
        for (int j = 0; j < 8; ++j) for (int wk = cs; wk < cs + 16; ++wk) { const int t = (start + j) * 64 + wk;
            step(dotqk(q, Kf, sb, t) + rpb[(h * 15 + (start + j - r + 7)) * 31 + (wk - wq + 15)] * LOG2E, bff(VTf[sb + pg8::vtf_off(t, d)])); }
        const size_t sc = pg8::seq_base_cache(b, h);
        for (int t = 0; t < 512; ++t) step(dotqk(q, Kf, sc, t), bff(VTf[sc + pg8::vtf_off(t, d)]));
    }
    dacc(dbg, 5, bff(O[(size_t)m * D + h * HD + d]), o / l);
}
__global__ void chk_res(const bf16* A, const bf16* Bt, int K, const float* baseP, const float* baseS, int bs_sub, const float* gate, const float* out, float* dbg, int stage) {
    const unsigned id = blockIdx.x * blockDim.x + threadIdx.x, hsh = hashu(id * 7919u + 41u + stage), h2 = hashu(hsh + 5u);
    const int m = hsh % M, n = h2 % D, cond = m < MP ? 0 : 1 + ((m - MP) >> 10);
    const float acc = dotbf(A + (size_t)m * K, Bt + (size_t)n * K, K);
    const float ref = (m < MP ? baseP[(size_t)m * D + n] : baseS[(size_t)(m - bs_sub) * D + n]) + gate[cond * 12288 + n] * acc;
    dacc(dbg, stage, out[(size_t)m * D + n], ref);
}
__global__ void chk_gemm_bf(const bf16* A, const bf16* Bt, int K, int N, const bf16* O, float* dbg, int stage, int ulay) {
    const unsigned id = blockIdx.x * blockDim.x + threadIdx.x, hsh = hashu(id * 7919u + 43u + stage), h2 = hashu(hsh + 5u);
    const int m = hsh % M, n = h2 % N;
    dacc(dbg, stage, bff(O[ulay ? pg8::s5u_off(m, n) : (size_t)m * N + n]), dotbf(A + (size_t)m * K, Bt + (size_t)n * K, K));
}
__global__ void chk_gate(const bf16* Y, const bf16* Bt, const bf16* Y2, float* dbg, int stage) {
    const unsigned id = blockIdx.x * blockDim.x + threadIdx.x, hsh = hashu(id * 7919u + 47u), h2 = hashu(hsh + 5u);
    const int m = hsh % M, n = h2 % D;
    const float z = dotbf(Y + (size_t)m * D, Bt + (size_t)n * D, D);
    dacc(dbg, stage, bff(Y2[(size_t)m * D + n]), bff(Y[(size_t)m * D + n]) / (1.0f + expf(-z)));
}
__global__ void chk_upconv(const bf16* HB, const bf16* WupT, const float* cw, const float* cb, const bf16* act, float* dbg, int stage) {
    const unsigned id = blockIdx.x * blockDim.x + threadIdx.x, hsh = hashu(id * 7919u + 53u + stage), h2 = hashu(hsh + 5u);
    int m = hsh % M; const int f = h2 % FF;
    if ((id & 7) == 0) m = (m & ~255);
    if ((id & 7) == 1) m = (m | 255);
    if ((id & 7) == 2) m = (m & ~63);
    if ((id & 7) == 3) m = (m | 63);
    if ((id & 7) >= 6) m = MP + (hsh % MS);
    const int seqlen = m < MP ? SEQ : DSEQ, pos = m < MP ? (m & 255) : ((m - MP) & 1023);
    float z[2];
    for (int q = 0; q < 2; ++q) { const int c = f + q * FF; const bf16* wrow = WupT + (size_t)pg8::upw_row(c) * D;
        const float a = pos > 0 ? bff((bf16)f2bf(dotbf(HB + (size_t)(m - 1) * D, wrow, D))) : 0.f, b = bff((bf16)f2bf(dotbf(HB + (size_t)m * D, wrow, D))), d = pos + 1 < seqlen ? bff((bf16)f2bf(dotbf(HB + (size_t)(m + 1) * D, wrow, D))) : 0.f;
        z[q] = cw[c] * a + cw[F2 + c] * b + cw[2 * F2 + c] * d + cb[c]; }
    dacc(dbg, stage, bff(act[(size_t)m * FF + f]), z[0] / (1.0f + expf(-z[0])) * z[1]);
}
struct S5P { const float* p[8]; };
__global__ void chk_s5(const bf16* U, S5P inp, const float* sre, const float* sim, const bf16* Y, const float* out, float* dbg, int stage) {
    const float* are = inp.p[0]; const float* aim = inp.p[1]; const float* ldt = inp.p[2]; const float* bre = inp.p[3]; const float* bim = inp.p[4]; const float* cre = inp.p[5]; const float* cim = inp.p[6]; const float* sd = inp.p[7];
    const int wv = (blockIdx.x * blockDim.x + threadIdx.x) >> 6, p = threadIdx.x & 63;
    const unsigned hsh = hashu(wv * 7919u + 59u), h2 = hashu(hsh + 5u);
    const bool stchk = (wv & 3) == 3;
    int m = hsh % M; if (wv & 1) m = MP + (hsh % MS);
    if (stchk) m = hsh % MP;
    const int ch = h2 % D, g = ch >> 4, c = ch & 15;
    const int L = m < MP ? SEQ : DSEQ, tokbase = m < MP ? (m & ~255) : MP + ((m - MP) & ~1023), t = m - tokbase;
    float ysum = 0.f;
    for (int dir = 0; dir < 2; ++dir) {
        const double ar = are[(dir * NG + g) * SP + p], ai = aim[(dir * NG + g) * SP + p], dt = exp((double)ldt[dir * NG + g]);
        const double mag = exp(ar * dt), abr = mag * cos(ai * dt), abi = mag * sin(ai * dt), den = ar * ar + ai * ai, nr = abr - 1.0;
        const double cfr = (nr * ar + abi * ai) / den, cfi = (abi * ar - nr * ai) / den;
        float bbr[16], bbi[16];
#pragma unroll
        for (int q = 0; q < 16; ++q) { const double br = bre[((size_t)(dir * NG + g) * SP + p) * GC + q], bi = bim[((size_t)(dir * NG + g) * SP + p) * GC + q]; bbr[q] = (float)(cfr * br - cfi * bi); bbi[q] = (float)(cfr * bi + cfi * br); }
        float hr = 0.f, hi = 0.f;
        if (m >= MP) { const size_t si = ((size_t)(((m - MP) >> 10) * 2 + dir) * NG + g) * SP + p; hr = sre[si]; hi = sim[si]; }
        const int tend = stchk ? (dir ? 0 : L - 1) : t;
        for (int s = dir ? L - 1 : 0; dir ? s >= tend : s <= tend; s += dir ? -1 : 1) {
            float ur = 0.f, ui = 0.f;
#pragma unroll
            for (int q = 0; q < 16; ++q) { const float u = bff(U[pg8::s5u_off(tokbase + s, g * 16 + q)]); ur += bbr[q] * u; ui += bbi[q] * u; }
            const float n_r = (float)abr * hr - (float)abi * hi + ur, n_i = (float)abr * hi + (float)abi * hr + ui; hr = n_r; hi = n_i;
        }
        if (stchk) { const size_t so = ((size_t)((m >> 8) * 2 + dir) * NG + g) * SP + p; dacc(dbg, stage + 1, out[O_SRE + so], hr); dacc(dbg, stage + 1, out[O_SIM + so], hi); }
        ysum += hr * cre[((size_t)(dir * NG + g) * GC + c) * SP + p] - hi * cim[((size_t)(dir * NG + g) * GC + c) * SP + p];
    }
    if (!stchk) {
        float y = wave_sum(ysum) + sd[ch] * bff(U[pg8::s5u_off(m, ch)]);
        if (p == 0) { const float z = 0.7978845608028654f * (y + 0.044715f * y * y * y); dacc(dbg, stage, bff(Y[(size_t)m * D + ch]), 0.5f * y * (1.0f + tanhf(z))); }
    }
}
constexpr int DBG_NSTAGE = 22;
__device__ const float DBG_TOL[DBG_NSTAGE] = {1e-9f, 1e-12f, 2e-5f, 2e-5f, 2e-5f, 1e-4f, 1e-9f, 2e-5f, 2e-5f, 3e-5f, 1e-9f, 2e-5f, 2e-5f, 3e-4f, 3e-4f, 3e-5f, 1e-9f, 2e-5f, 2e-5f, 3e-5f, 1e-9f, 1e-9f};
__global__ void dbg_report(const float* dbg, float* out, size_t nout, int force_stage) {
    __shared__ float code;
    if (threadIdx.x == 0) {
        float cv = 0.f;
        for (int s = 0; s < DBG_NSTAGE; ++s) {
            const float num = dbg[2 * s], den = dbg[2 * s + 1]; const float r = num / den;
            if (num == 0.f && den == 0.f) continue;
            const bool bad = !(r <= DBG_TOL[s]) || !(den > 0.f);
            if ((force_stage < 0 && bad) || s == force_stage) {
                float lg = (r == r && r > 0.f) ? log10f(r) : (r == 0.f ? -8.f : 3.f); lg = fminf(fmaxf(lg, -8.f), 2.f);
                float mant = 1.0f + (lg + 8.0f) * 0.85f; if (!(r == r) || !(den > 0.f)) mant = 9.9f;
                cv = mant * powf(10.f, (float)(s + 3)); break; }
        }
        code = cv;
    }
    __syncthreads();
    const float cv = code;
    if (cv != 0.f) { for (size_t i = (size_t)blockIdx.x * blockDim.x + threadIdx.x; i < nout; i += (size_t)gridDim.x * blockDim.x) out[i] = (i == 0) ? cv : 0.f; }
}
#endif
#ifndef DBG_CHECKS
#define DBG_CHECKS 0
#endif
#ifndef N_LAUNCHES
#define N_LAUNCHES 1
#endif
#ifndef DBG_FORCE_STAGE
#define DBG_FORCE_STAGE (-1)
#endif
__global__ void err_code_kernel(float* o, float v) { if (threadIdx.x == 0 && blockIdx.x == 0) o[0] = v; }
extern "C" void kernel_launch(void* const* d_in, const int* in_sizes, int n_in, void* d_out, int out_size, void* d_ws, size_t ws_size, hipStream_t stream) {
    static int grid = 0;
    if (grid == 0) {
        size_t need = WS_END;
        if (n_in != N_IN || (size_t)out_size != O_END || ws_size < need) { fprintf(stderr, "kernel_launch: shape mismatch: n_in %d, out %d (want %zu), ws %zu (need %zu); nothing launched\n", n_in, out_size, (size_t)O_END, ws_size, need); grid = -1; return; }
        int dev = 0, cus = 0, per_cu = 0;
        if (hipGetDevice(&dev) != hipSuccess || hipDeviceGetAttribute(&cus, hipDeviceAttributeMultiprocessorCount, dev) != hipSuccess) { fprintf(stderr, "kernel_launch: device query failed\n"); grid = -1; return; }
        if (hipFuncSetAttribute((const void*)mega_fwd, hipFuncAttributeMaxDynamicSharedMemorySize, LDS_BYTES) != hipSuccess) { fprintf(stderr, "kernel_launch: hipFuncSetAttribute failed\n"); grid = -1; return; }
        if (hipOccupancyMaxActiveBlocksPerMultiprocessor(&per_cu, (const void*)mega_fwd, NTHR, LDS_BYTES) != hipSuccess || per_cu < 1) fprintf(stderr, "kernel_launch: note: occupancy query reports %d workgroups per CU\n", per_cu);
        (void)hipGetLastError();
        grid = cus;
    }
    if (grid < 0) { if (out_size > 0) hipLaunchKernelGGL(err_code_kernel, dim3(1), dim3(64), 0, stream, (float*)d_out, 7.7e37f); return; }
    unsigned char* ws = (unsigned char*)d_ws;
    (void)hipMemsetAsync(ws + WS_CTL, 0, CTL_ZERO_BYTES, stream);
    Args a{};
    for (int i = 0; i < N_IN; ++i) a.in[i] = (const float*)d_in[i];
    a.out = (float*)d_out; a.ws = ws;
#if !DBG_CHECKS
    if (N_LAUNCHES == 1) { a.ph_lo = 0; a.ph_hi = N_PHASES; a.use_bar = 1; hipLaunchKernelGGL(mega_fwd, dim3(grid), dim3(NTHR), LDS_BYTES, stream, a); }
    else for (int p = 0; p < N_PHASES; ++p) { a.ph_lo = p; a.ph_hi = p + 1; a.use_bar = 0; hipLaunchKernelGGL(mega_fwd, dim3(grid), dim3(NTHR), LDS_BYTES, stream, a); }
#ifdef PROBE_PHASE
#ifndef PROBE_VARIANT
#define PROBE_VARIANT 0
#endif
    for (int r = 0; r < PROBE_REPS; ++r) { a.ph_lo = PROBE_PHASE; a.ph_hi = PROBE_PHASE + 1; a.use_bar = 0; a.pad = PROBE_VARIANT; hipLaunchKernelGGL(mega_fwd, dim3(grid), dim3(NTHR), LDS_BYTES, stream, a); }
#endif
#ifdef PROBE_COPY
    for (int r = 0; r < PROBE_COPY; ++r) { a.ph_lo = 19; a.ph_hi = 20; a.use_bar = 0; hipLaunchKernelGGL(mega_fwd, dim3(grid), dim3(NTHR), LDS_BYTES, stream, a); }
#endif
#else
    float* dbg = (float*)(ws + WS_DBG); float* out = (float*)d_out; const float* const* in = (const float* const*)a.in;
    float* mod = (float*)(ws + WS_MOD); bf16* HB = (bf16*)(ws + WS_HB); float* X1 = (float*)(ws + WS_X1); float* XBK = (float*)(ws + WS_XBK);
    const dim3 cg(32), cb(256);
    for (int p = 0; p < N_PHASES; ++p) {
        if (p == 8 || p == 13 || p == 17) (void)hipMemcpyAsync(XBK, X1, (size_t)M * D * 4, hipMemcpyDeviceToDevice, stream);
        a.ph_lo = p; a.ph_hi = p + 1; a.use_bar = 0; hipLaunchKernelGGL(mega_fwd, dim3(grid), dim3(NTHR), LDS_BYTES, stream, a);
        const int l = p >= 9 ? 1 : 0; const float* modl = mod + (size_t)l * 3 * 12288;
        switch (p) {
        case 0:
            hipLaunchKernelGGL(chk_mod, cg, cb, 0, stream, a.in[I_ADAW], a.in[I_ADAB], a.in[I_CCTX], a.in[I_C], mod, dbg);
            hipLaunchKernelGGL(chk_wt, cg, cb, 0, stream, a.in[I_WQKV], (const bf16*)(ws + WS_WQKV), D, 3 * D, dbg, 0);
            hipLaunchKernelGGL(chk_wt, cg, cb, 0, stream, a.in[I_WIN], (const bf16*)(ws + WS_WIN), D, D, dbg, 0);
            hipLaunchKernelGGL(chk_wt, cg, cb, 0, stream, a.in[I_WGATE], (const bf16*)(ws + WS_WGATE), D, D, dbg, 0);
            hipLaunchKernelGGL(chk_wt, cg, cb, 0, stream, a.in[I_WOUT], (const bf16*)(ws + WS_WOUT), D, D, dbg, 0);
            hipLaunchKernelGGL(chk_wt, cg, cb, 0, stream, a.in[I_WUP], (const bf16*)(ws + WS_WUP0), D, F2, dbg, 1);
            hipLaunchKernelGGL(chk_cache, cg, cb, 0, stream, a.in[I_CK], a.in[I_CV], (const bf16*)(ws + WS_KF), (const bf16*)(ws + WS_VTF), dbg);
            break;
        case 1: hipLaunchKernelGGL(chk_norm, cg, cb, 0, stream, a.in[I_XP], a.in[I_XS], (int)MP, a.in[I_N1G], modl, 0, 1, (const bf16*)HB, dbg, 3); break;
        case 2: hipLaunchKernelGGL(chk_wt, cg, cb, 0, stream, a.in[I_WO], (const bf16*)(ws + WS_WO), D, D, dbg, 0); hipLaunchKernelGGL(chk_qkv, cg, cb, 0, stream, (const bf16*)HB, (const bf16*)(ws + WS_WQKV), (const bf16*)(ws + WS_Q), (const bf16*)(ws + WS_KF), (const bf16*)(ws + WS_VTF), (const float*)(out + O_NK), (const float*)(out + O_NV), dbg); break;
        case 3: hipLaunchKernelGGL(chk_attn, cg, cb, 0, stream, (const bf16*)(ws + WS_Q), (const bf16*)(ws + WS_KF), (const bf16*)(ws + WS_VTF), a.in[I_RPB], (const bf16*)(ws + WS_O), dbg); break;
        case 5: hipLaunchKernelGGL(chk_norm, cg, cb, 0, stream, (const float*)X1, (const float*)X1, 0, a.in[I_N2G], modl, 3, 4, (const bf16*)HB, dbg, 7); hipLaunchKernelGGL(chk_res, cg, cb, 0, stream, (const bf16*)(ws + WS_O), (const bf16*)(ws + WS_WO), D, a.in[I_XP], a.in[I_XS], (int)MP, (mod + (size_t)0 * 3 * 12288) + 2 * 2048, (const float*)X1, dbg, 6); break;
        case 6: hipLaunchKernelGGL(chk_wt, cg, cb, 0, stream, a.in[I_WDN], (const bf16*)(ws + WS_WDN0), FF, D, dbg, 0); break;
        case 7: hipLaunchKernelGGL(chk_upconv, cg, cb, 0, stream, (const bf16*)HB, (const bf16*)(ws + WS_WUP0), a.in[I_CONVW], a.in[I_CONVB], (const bf16*)(ws + WS_ACT), dbg, 9); break;
        case 9: hipLaunchKernelGGL(chk_norm, cg, cb, 0, stream, (const float*)X1, (const float*)X1, 0, a.in[I_N1G] + D, modl, 0, 1, (const bf16*)HB, dbg, 11); hipLaunchKernelGGL(chk_res, cg, cb, 0, stream, (const bf16*)(ws + WS_ACT), (const bf16*)(ws + WS_WDN0), FF, (const float*)XBK, (const float*)XBK, 0, (mod + (size_t)0 * 3 * 12288) + 5 * 2048, (const float*)X1, dbg, 10); break;
        case 10: hipLaunchKernelGGL(chk_gemm_bf, cg, cb, 0, stream, (const bf16*)HB, (const bf16*)(ws + WS_WIN), D, D, (const bf16*)(ws + WS_U), dbg, 12, 1); break;
        case 11: { S5P sp; sp.p[0] = a.in[I_ARE]; sp.p[1] = a.in[I_AIM]; sp.p[2] = a.in[I_LOGDT]; sp.p[3] = a.in[I_BRE]; sp.p[4] = a.in[I_BIM]; sp.p[5] = a.in[I_CRE]; sp.p[6] = a.in[I_CIM]; sp.p[7] = a.in[I_SD];
            hipLaunchKernelGGL(chk_s5, dim3(128), cb, 0, stream, (const bf16*)(ws + WS_U), sp, a.in[I_SRE], a.in[I_SIM], (const bf16*)(ws + WS_Y), (const float*)out, dbg, 13); } break;
        case 12: hipLaunchKernelGGL(chk_wt, cg, cb, 0, stream, a.in[I_WUP] + (size_t)D * F2, (const bf16*)(ws + WS_WUP1), D, F2, dbg, 1); hipLaunchKernelGGL(chk_wt, cg, cb, 0, stream, a.in[I_WDN] + (size_t)FF * D, (const bf16*)(ws + WS_WDN1), FF, D, dbg, 0); hipLaunchKernelGGL(chk_gate, cg, cb, 0, stream, (const bf16*)(ws + WS_Y), (const bf16*)(ws + WS_WGATE), (const bf16*)(ws + WS_Y2), dbg, 15); break;
        case 14: hipLaunchKernelGGL(chk_norm, cg, cb, 0, stream, (const float*)X1, (const float*)X1, 0, a.in[I_N2G] + D, modl, 3, 4, (const bf16*)HB, dbg, 17); hipLaunchKernelGGL(chk_res, cg, cb, 0, stream, (const bf16*)(ws + WS_Y2), (const bf16*)(ws + WS_WOUT), D, (const float*)XBK, (const float*)XBK, 0, (mod + (size_t)1 * 3 * 12288) + 2 * 2048, (const float*)X1, dbg, 16); break;
        case 16: hipLaunchKernelGGL(chk_upconv, cg, cb, 0, stream, (const bf16*)HB, (const bf16*)(ws + WS_WUP1), a.in[I_CONVW] + (size_t)3 * F2, a.in[I_CONVB] + F2, (const bf16*)(ws + WS_ACT), dbg, 19); break;
        case 18: hipLaunchKernelGGL(chk_final, cg, cb, 0, stream, (const float*)X1, a.in[I_FG], (const float*)out, dbg, 21); hipLaunchKernelGGL(chk_res, cg, cb, 0, stream, (const bf16*)(ws + WS_ACT), (const bf16*)(ws + WS_WDN1), FF, (const float*)XBK, (const float*)XBK, 0, (mod + (size_t)1 * 3 * 12288) + 5 * 2048, (const float*)X1, dbg, 20); break;
        }
    }
    hipLaunchKernelGGL(dbg_report, dim3(1024), dim3(256), 0, stream, (const float*)dbg, out, (size_t)O_END, (int)DBG_FORCE_STAGE);
#endif
}
```

```cpp
#define DBG_CHECKS 0
#include <hip/hip_runtime.h>
#include <cstdio>
#include <cstdint>
namespace pg8 {
#define PG8_LAS __attribute__((address_space(3)))
typedef unsigned short bf16_t;
typedef short bf16x8 __attribute__((ext_vector_type(8)));
typedef float f32x4 __attribute__((ext_vector_type(4)));
typedef unsigned u32x4 __attribute__((ext_vector_type(4)));
constexpr int BM = 256, BK = 64, HALF = 128, HTB = HALF * BK * 2  , STAGE_BYTES = 8 * HTB, NXCD = 8, WGM = 8;

__host__ __device__ __forceinline__ int lds_byte(int r, int c) { const int st = (r >> 4) * 2 + (c >> 5), rr = r & 15, cc = c & 31, ob = rr * 64 + cc * 2; return st * 1024 + (ob ^ (((ob >> 9) & 1) << 5)); }
__host__ __device__ __forceinline__ void stage_rc(int b, int& R, int& C) { const int st = b / 1024, sb = b % 1024, swz = sb ^ (((sb >> 9) & 1) << 5); R = (st >> 1) * 16 + swz / 64; C = (st & 1) * 32 + (swz % 64) / 2; }
__host__ __device__ __forceinline__ int perm32(int rho) { const int n = rho >> 4, i = rho & 15; return 8 * (i >> 2) + 4 * n + (i & 3); }

struct Unit { int pm, pn; int k0 = 0, nk = 0, sl = -1; };
struct Gemm { const bf16_t* A; const bf16_t* Bt; int M, N, K; };

struct StaticOrder {
    int nM, nN, nwg, G, c;
    __host__ __device__ void init(int M, int N, int G_, int c_) { nM = M / BM; nN = N / BM; nwg = nM * nN; G = G_; c = c_; }
    __host__ __device__ __forceinline__ bool next(int i, Unit& u) const {
        const long L = (long)i * G + c; if (L >= nwg) return false;
        int wgid = (int)L; { const int q = nwg / NXCD, r = nwg % NXCD, xcd = wgid % NXCD, off = wgid / NXCD; wgid = (xcd < r ? xcd * (q + 1) : r * (q + 1) + (xcd - r) * q) + off; }
        const int nig = WGM * nN, gid = wgid / nig, fm = gid * WGM, gsz = (nM - fm) < WGM ? (nM - fm) : WGM;
        u.pm = fm + ((wgid % nig) % gsz); u.pn = (wgid % nig) / gsz; return true;
    }
    __device__ __forceinline__ void a_ready(const Unit&) const {}
    __device__ __forceinline__ void done(const Unit&) const {}
};

__device__ __forceinline__ unsigned cvt_pk_bf16(float lo, float hi) { unsigned r; asm volatile("v_cvt_pk_bf16_f32 %0, %1, %2" : "=v"(r) : "v"(lo), "v"(hi)); return r; }
typedef float f32x2 __attribute__((ext_vector_type(2)));
__device__ __forceinline__ f32x2 gelu_pk(f32x2 v) {
    const f32x2 av = __builtin_elementwise_abs(v), d = av * 0.2316418882f + 1.0f;
    f32x2 t; t.x = __builtin_amdgcn_rcpf(d.x); t.y = __builtin_amdgcn_rcpf(d.y);
    f32x2 q = t * 0.5307027145f + (-0.7265760135f); q = q * t + 0.7107068705f; q = q * t + (-0.142248368f); q = q * t + 0.127414796f; q = q * t;
    const f32x2 s = (v * v) * (-0.72134752044f);
    f32x2 e; e.x = __builtin_amdgcn_exp2f(s.x); e.y = __builtin_amdgcn_exp2f(s.y);
    const f32x2 m = v * (q * e), r = v - m;
    f32x2 o; o.x = v.x < 0.f ? m.x : r.x; o.y = v.y < 0.f ? m.y : r.y; return o;
}

template <int ACT  > struct EpiBf16 {
    static constexpr bool PERM = true, AFTER_DRAIN = false; static_assert(ACT == 0 || ACT == 1, "EpiBf16: ACT is 0 (none) or 1 (gelu_pk)");
    bf16_t* O; int ldc; const float* bias; int split_cols; size_t split_stride; float scale0;
    __device__ __forceinline__ void operator()(const f32x4 (&acc)[2][2][4][2], const Unit& u, int wr, int wc, int fr, int fq) const {
        const int row0 = u.pm * BM + wr * 64 + fr; int colt = u.pn * BM; bf16_t* base = O;
        float sc = 1.f; if (split_cols) { const int t = colt / split_cols; base += (size_t)t * split_stride; colt -= t * split_cols; if (t == 0) sc = scale0; }
        const int col0 = colt + wc * 32 + 8 * fq, bcol0 = u.pn * BM + wc * 32 + 8 * fq;
        f32x4 bv[2][2];
#pragma unroll
        for (int bj = 0; bj < 2; ++bj)
#pragma unroll
            for (int n = 0; n < 2; ++n) bv[bj][n] = bias ? *(const f32x4*)(bias + bcol0 + bj * HALF + 4 * n) : (f32x4){0.f, 0.f, 0.f, 0.f};
#pragma unroll
        for (int ai = 0; ai < 2; ++ai)
#pragma unroll
            for (int m = 0; m < 4; ++m) { bf16_t* rowp = base + (size_t)(row0 + ai * HALF + m * 16) * ldc + col0;
#pragma unroll
                for (int bj = 0; bj < 2; ++bj) { f32x4 v0 = acc[ai][bj][m][0] + bv[bj][0], v1 = acc[ai][bj][m][1] + bv[bj][1];
                    if (ACT == 1) { f32x2 a = gelu_pk((f32x2){v0[0], v0[1]}), b = gelu_pk((f32x2){v0[2], v0[3]}), c = gelu_pk((f32x2){v1[0], v1[1]}), d = gelu_pk((f32x2){v1[2], v1[3]});
                        v0 = (f32x4){a.x, a.y, b.x, b.y}; v1 = (f32x4){c.x, c.y, d.x, d.y}; }
                    v0 = v0 * sc; v1 = v1 * sc; u32x4 w; w.x = cvt_pk_bf16(v0[0], v0[1]); w.y = cvt_pk_bf16(v0[2], v0[3]); w.z = cvt_pk_bf16(v1[0], v1[1]); w.w = cvt_pk_bf16(v1[2], v1[3]);
                    *(u32x4*)(rowp + bj * HALF) = w; } }
    }
};

typedef unsigned u32x2 __attribute__((ext_vector_type(2)));
__host__ __device__ __forceinline__ int perm16(int ko) { return 8 * ((ko >> 2) & 1) + (ko & 3) + 4 * (ko >> 3); }


constexpr size_t KF_SAMPLE = (size_t)32 * 16 * 256 * 128, KF_CACHE = KF_SAMPLE + (size_t)2 * 16 * 1024 * 128, KF_TOTAL = KF_CACHE + (size_t)2 * 16 * 512 * 128;
__host__ __device__ __forceinline__ size_t kf_off(int t, int d) { return (((size_t)((t >> 5) * 8 + (d >> 4)) * 64 + ((d >> 3) & 1) * 32 + (t & 31)) * 8 + (d & 7)); }
__host__ __device__ __forceinline__ size_t vtf_off(int t, int d) { const int ko32 = t & 31, ko = ko32 & 15; return ((((size_t)((t >> 5) * 2 + (ko32 >> 4)) * 4 + (d >> 5)) * 64 + ((ko >> 2) & 1) * 32 + (d & 31)) * 8 + (ko & 3) + 4 * (ko >> 3)); }
__host__ __device__ __forceinline__ size_t seq_base_row(int row, int h, int& t) { if (row < 8192) { t = row & 255; return (size_t)((row >> 8) * 16 + h) * 256 * 128; } const int rs = row - 8192; t = rs & 1023; return KF_SAMPLE + (size_t)((rs >> 10) * 16 + h) * 1024 * 128; }
__host__ __device__ __forceinline__ size_t seq_base_cache(int b, int h) { return KF_CACHE + (size_t)(b * 16 + h) * 512 * 128; }

struct EpiQKV {
    static constexpr bool PERM = true, AFTER_DRAIN = false, PERM_A_UNIT = true;
    static __device__ __forceinline__ bool perm_a_of(const Unit& u) { return (u.pn >> 3) == 2; }
    bf16_t* Q; bf16_t* Kf; bf16_t* VTf; float* nk; float* nv; float c2;
    __device__ __forceinline__ void operator()(const f32x4 (&acc)[2][2][4][2], const Unit& u, int wr, int wc, int fr, int fq) const {
        const int sec = u.pn >> 3, colt = (u.pn & 7) * BM;
        const int col0 = colt + wc * 32 + 8 * fq;
        const bool prompt = u.pm < 32;
        if (sec < 2) {
            const int row0 = u.pm * BM + wr * 64 + fr;
#pragma unroll
            for (int ai = 0; ai < 2; ++ai)
#pragma unroll
                for (int m = 0; m < 4; ++m) {
                    const int row = row0 + ai * HALF + m * 16;
#pragma unroll
                    for (int bj = 0; bj < 2; ++bj) {
                        f32x4 v0 = acc[ai][bj][m][0], v1 = acc[ai][bj][m][1];
                        const int col = col0 + bj * HALF;
                        const size_t off = (size_t)row * 2048 + col;
                        if (sec == 0) {
                            v0 = v0 * c2; v1 = v1 * c2;
                            u32x4 w; w.x = cvt_pk_bf16(v0[0], v0[1]); w.y = cvt_pk_bf16(v0[2], v0[3]); w.z = cvt_pk_bf16(v1[0], v1[1]); w.w = cvt_pk_bf16(v1[2], v1[3]);
                            *(u32x4*)(Q + off) = w;
                        } else {
                            u32x4 w; w.x = cvt_pk_bf16(v0[0], v0[1]); w.y = cvt_pk_bf16(v0[2], v0[3]); w.z = cvt_pk_bf16(v1[0], v1[1]); w.w = cvt_pk_bf16(v1[2], v1[3]);
                            int t; const size_t sb = seq_base_row(row, col >> 7, t);
                            *(u32x4*)(Kf + sb + kf_off(t, col & 127)) = w;
                            if (prompt) { *(f32x4*)(nk + off) = v0; *(f32x4*)(nk + off + 4) = v1; }
                        }
                    }
                }
        } else {
            const int row0 = u.pm * BM + wr * 64 + 4 * fr;
#pragma unroll
            for (int ai = 0; ai < 2; ++ai)
#pragma unroll
                for (int bj = 0; bj < 2; ++bj) {
                    const int col = col0 + bj * HALF, rowq = row0 + ai * HALF;
                    if (prompt) {
#pragma unroll
                        for (int m = 0; m < 4; ++m) { const size_t off = (size_t)(rowq + m) * 2048 + col; *(f32x4*)(nv + off) = acc[ai][bj][m][0]; *(f32x4*)(nv + off + 4) = acc[ai][bj][m][1]; }
                    }
                    int t; const size_t sb = seq_base_row(rowq, col >> 7, t);
                    bf16_t* p = VTf + sb + vtf_off(t, col & 127);
#pragma unroll
                    for (int n = 0; n < 2; ++n)
#pragma unroll
                        for (int e2 = 0; e2 < 4; ++e2) {
                            u32x2 w; w.x = cvt_pk_bf16(acc[ai][bj][0][n][e2], acc[ai][bj][1][n][e2]); w.y = cvt_pk_bf16(acc[ai][bj][2][n][e2], acc[ai][bj][3][n][e2]);
                            *(u32x2*)(p + (4 * n + e2) * 8) = w;
                        }
                }
        }
    }
};

struct EpiRes {
    static constexpr bool PERM = false, AFTER_DRAIN = false;
    const float* baseP; const float* baseS; float* out; const float* gate;
    __device__ __forceinline__ void operator()(const f32x4 (&acc)[2][2][4][2], const Unit& u, int wr, int wc, int fr, int fq) const {
        const int cond = u.pm < 32 ? 0 : 1 + ((u.pm - 32) >> 2);
        const float* g = gate + cond * 12288; const float* base = u.pm < 32 ? baseP : baseS;
        const int row0 = u.pm * BM + wr * 64 + fr, col0 = u.pn * BM + wc * 32 + 4 * fq;
        f32x4 gv[2][2];
#pragma unroll
        for (int bj = 0; bj < 2; ++bj)
#pragma unroll
            for (int n = 0; n < 2; ++n) gv[bj][n] = *(const f32x4*)(g + col0 + bj * HALF + n * 16);
#pragma unroll
        for (int ai = 0; ai < 2; ++ai)
#pragma unroll
            for (int m = 0; m < 4; ++m) { const size_t off = (size_t)(row0 + ai * HALF + m * 16) * 2048 + col0;
#pragma unroll
                for (int bj = 0; bj < 2; ++bj)
#pragma unroll
                    for (int n = 0; n < 2; ++n) { const f32x4 bs = *(const f32x4*)(base + off + bj * HALF + n * 16); *(f32x4*)(out + off + bj * HALF + n * 16) = bs + gv[bj][n] * acc[ai][bj][m][n]; }
                if (m & 1) asm volatile("" ::: "memory"); }
    }
};

struct EpiGate {
    static constexpr bool PERM = true, AFTER_DRAIN = false;
    const bf16_t* Y; bf16_t* Y2;
    __device__ __forceinline__ void operator()(const f32x4 (&acc)[2][2][4][2], const Unit& u, int wr, int wc, int fr, int fq) const {
        const int row0 = u.pm * BM + wr * 64 + fr, col0 = u.pn * BM + wc * 32 + 8 * fq;
#pragma unroll
        for (int ai = 0; ai < 2; ++ai)
#pragma unroll
            for (int m = 0; m < 4; ++m) {
#pragma unroll
                for (int bj = 0; bj < 2; ++bj) {
                    const size_t off = (size_t)(row0 + ai * HALF + m * 16) * 2048 + col0 + bj * HALF;
                    const u32x4 yv = *(const u32x4*)(Y + off);
                    const f32x4 z0 = acc[ai][bj][m][0], z1 = acc[ai][bj][m][1];
                    float y[8], o[8];
                    y[0] = __uint_as_float(yv.x << 16); y[1] = __uint_as_float(yv.x & 0xffff0000u); y[2] = __uint_as_float(yv.y << 16); y[3] = __uint_as_float(yv.y & 0xffff0000u);
                    y[4] = __uint_as_float(yv.z << 16); y[5] = __uint_as_float(yv.z & 0xffff0000u); y[6] = __uint_as_float(yv.w << 16); y[7] = __uint_as_float(yv.w & 0xffff0000u);
#pragma unroll
                    for (int e = 0; e < 4; ++e) { o[e] = y[e] * __builtin_amdgcn_rcpf(1.0f + __builtin_amdgcn_exp2f(-1.4426950408889634f * z0[e])); o[4 + e] = y[4 + e] * __builtin_amdgcn_rcpf(1.0f + __builtin_amdgcn_exp2f(-1.4426950408889634f * z1[e])); }
                    u32x4 w; w.x = cvt_pk_bf16(o[0], o[1]); w.y = cvt_pk_bf16(o[2], o[3]); w.z = cvt_pk_bf16(o[4], o[5]); w.w = cvt_pk_bf16(o[6], o[7]);
                    *(u32x4*)(Y2 + off) = w;
                }
            }
    }
};


struct TailOrder {
    int G, c, q, r;
    __host__ __device__ void init(int K, int G_, int c_) { G = G_; c = c_; const int pairs = K / (2 * BK); q = pairs / 4; r = pairs % 4; }
    __host__ __device__ __forceinline__ bool next(int i, Unit& u) const {
        const int L = i * G + c; if (L >= 512) return false;
        const int Lf = L < 256 ? L : 255, w = (Lf % NXCD) * 32 + Lf / NXCD, nig = WGM * 8, fm = (w / nig) * WGM;
        const int fpm = fm + ((w % nig) % WGM), fpn = (w % nig) / WGM;
        const int j = L < 256 ? 0 : L - 256, tile = j >> 2, s = j & 3;
        const bool isf = L < 256;
        u.pm = isf ? fpm : 32 + (tile >> 3); u.pn = isf ? fpn : (tile & 7); u.sl = isf ? -1 : s;
        u.k0 = isf ? 0 : 2 * (s * q + (s < r ? s : r)); u.nk = isf ? 0 : 2 * (q + (s < r ? 1 : 0)); return true;
    }
    __device__ __forceinline__ void a_ready(const Unit&) const {}
    __device__ __forceinline__ void done(const Unit&) const {}
};
struct EpiRes2 {
    static constexpr bool PERM = false, AFTER_DRAIN = false;
    const float* baseP; float* out; const float* gate; float* slab;
    __device__ __forceinline__ void operator()(const f32x4 (&acc)[2][2][4][2], const Unit& u, int wr, int wc, int fr, int fq) const {
        const int row0 = u.pm * BM + wr * 64 + fr, col0 = u.pn * BM + wc * 32 + 4 * fq;
        if (u.sl < 0) {
            f32x4 gv[2][2];
#pragma unroll
            for (int bj = 0; bj < 2; ++bj)
#pragma unroll
                for (int n = 0; n < 2; ++n) gv[bj][n] = *(const f32x4*)(gate + col0 + bj * HALF + n * 16);
#pragma unroll
            for (int ai = 0; ai < 2; ++ai)
#pragma unroll
                for (int m = 0; m < 4; ++m) { const size_t off = (size_t)(row0 + ai * HALF + m * 16) * 2048 + col0;
#pragma unroll
                    for (int bj = 0; bj < 2; ++bj)
#pragma unroll
                        for (int n = 0; n < 2; ++n) { const f32x4 bs = *(const f32x4*)(baseP + off + bj * HALF + n * 16); *(f32x4*)(out + off + bj * HALF + n * 16) = bs + gv[bj][n] * acc[ai][bj][m][n]; }
                    if (m & 1) asm volatile("" ::: "memory"); }
        } else {
            float* sp = slab + (size_t)u.sl * 2048 * 2048;
#pragma unroll
            for (int ai = 0; ai < 2; ++ai)
#pragma unroll
                for (int m = 0; m < 4; ++m) { const size_t off = (size_t)(row0 - 8192 + ai * HALF + m * 16) * 2048 + col0;
#pragma unroll
                    for (int bj = 0; bj < 2; ++bj)
#pragma unroll
                        for (int n = 0; n < 2; ++n) *(f32x4*)(sp + off + bj * HALF + n * 16) = acc[ai][bj][m][n]; }
        }
    }
};


template <bool BASE_F32>
struct EpiRes3 {
    static constexpr bool PERM = true, AFTER_DRAIN = false;
    const void* baseP; bf16_t* out; const float* gate; bf16_t* slab;
    __device__ __forceinline__ void operator()(const f32x4 (&acc)[2][2][4][2], const Unit& u, int wr, int wc, int fr, int fq) const {
        const int row0 = u.pm * BM + wr * 64 + fr, col0 = u.pn * BM + wc * 32 + 8 * fq;
        if (u.sl < 0) {
            f32x4 gv[2][2];
#pragma unroll
            for (int bj = 0; bj < 2; ++bj)
#pragma unroll
                for (int n = 0; n < 2; ++n) gv[bj][n] = *(const f32x4*)(gate + col0 + bj * HALF + n * 4);
            if constexpr (!BASE_F32) {
                u32x4 bv[2][4][2];
#pragma unroll
                for (int ai = 0; ai < 2; ++ai)
#pragma unroll
                    for (int m = 0; m < 4; ++m)
#pragma unroll
                        for (int bj = 0; bj < 2; ++bj) bv[ai][m][bj] = *(const u32x4*)((const bf16_t*)baseP + (size_t)(row0 + ai * HALF + m * 16) * 2048 + col0 + bj * HALF);
                asm volatile("" ::: "memory");
#pragma unroll
                for (int ai = 0; ai < 2; ++ai)
#pragma unroll
                    for (int m = 0; m < 4; ++m) { const size_t off = (size_t)(row0 + ai * HALF + m * 16) * 2048 + col0;
#pragma unroll
                        for (int bj = 0; bj < 2; ++bj) { const u32x4 b = bv[ai][m][bj];
                            const f32x4 b0 = (f32x4){__uint_as_float(b.x << 16), __uint_as_float(b.x & 0xffff0000u), __uint_as_float(b.y << 16), __uint_as_float(b.y & 0xffff0000u)};
                            const f32x4 b1 = (f32x4){__uint_as_float(b.z << 16), __uint_as_float(b.z & 0xffff0000u), __uint_as_float(b.w << 16), __uint_as_float(b.w & 0xffff0000u)};
                            const f32x4 o0 = b0 + gv[bj][0] * acc[ai][bj][m][0], o1 = b1 + gv[bj][1] * acc[ai][bj][m][1];
                            u32x4 w; w.x = cvt_pk_bf16(o0[0], o0[1]); w.y = cvt_pk_bf16(o0[2], o0[3]); w.z = cvt_pk_bf16(o1[0], o1[1]); w.w = cvt_pk_bf16(o1[2], o1[3]);
                            *(u32x4*)(out + off + bj * HALF) = w; } }
            } else {
#pragma unroll
            for (int ai = 0; ai < 2; ++ai)
#pragma unroll
                for (int m = 0; m < 4; ++m) { const size_t off = (size_t)(row0 + ai * HALF + m * 16) * 2048 + col0;
#pragma unroll
                    for (int bj = 0; bj < 2; ++bj) {
                        const f32x4 b0 = *(const f32x4*)((const float*)baseP + off + bj * HALF), b1 = *(const f32x4*)((const float*)baseP + off + bj * HALF + 4);
                        const f32x4 o0 = b0 + gv[bj][0] * acc[ai][bj][m][0], o1 = b1 + gv[bj][1] * acc[ai][bj][m][1];
                        u32x4 w; w.x = cvt_pk_bf16(o0[0], o0[1]); w.y = cvt_pk_bf16(o0[2], o0[3]); w.z = cvt_pk_bf16(o1[0], o1[1]); w.w = cvt_pk_bf16(o1[2], o1[3]);
                        *(u32x4*)(out + off + bj * HALF) = w; }
                    if (m & 1) asm volatile("" ::: "memory"); }
            }
        } else {
            bf16_t* sp = slab + (size_t)u.sl * 2048 * 2048;
#pragma unroll
            for (int ai = 0; ai < 2; ++ai)
#pragma unroll
                for (int m = 0; m < 4; ++m) { const size_t off = (size_t)(row0 - 8192 + ai * HALF + m * 16) * 2048 + col0;
#pragma unroll
                    for (int bj = 0; bj < 2; ++bj) { const f32x4 v0 = acc[ai][bj][m][0], v1 = acc[ai][bj][m][1];
                        u32x4 w; w.x = cvt_pk_bf16(v0[0], v0[1]); w.y = cvt_pk_bf16(v0[2], v0[3]); w.z = cvt_pk_bf16(v1[0], v1[1]); w.w = cvt_pk_bf16(v1[2], v1[3]);
                        *(u32x4*)(sp + off + bj * HALF) = w; } }
        }
    }
};

struct EpiNull {
    static constexpr bool PERM = true, AFTER_DRAIN = false;
    __device__ __forceinline__ void operator()(const f32x4 (&acc)[2][2][4][2], const Unit& u, int wr, int wc, int fr, int fq) const {
#pragma unroll
        for (int a = 0; a < 2; ++a)
#pragma unroll
            for (int b = 0; b < 2; ++b)
#pragma unroll
                for (int m = 0; m < 4; ++m)
#pragma unroll
                    for (int n = 0; n < 2; ++n) asm volatile("" :: "v"(acc[a][b][m][n]));
    }
};

__host__ __device__ __forceinline__ size_t s5u_off(int m, int col) { const int g = col >> 4, hi = (col >> 3) & 1, rb = m >> 10, rem = m & 1023, row = rem >> 4, s = rem & 15, mb = row >> 5, r32 = row & 31;
    return ((((size_t)(g * 10 + rb) * 2 + mb) * 16 + s) * 64 + hi * 32 + r32) * 8 + (col & 7); }
struct EpiU {
    static constexpr bool PERM = true, AFTER_DRAIN = false;
    bf16_t* U;
    __device__ __forceinline__ void operator()(const f32x4 (&acc)[2][2][4][2], const Unit& u, int wr, int wc, int fr, int fq) const {
        const int row0 = u.pm * BM + wr * 64 + fr, col0 = u.pn * BM + wc * 32 + 8 * fq;
#pragma unroll
        for (int ai = 0; ai < 2; ++ai)
#pragma unroll
            for (int m = 0; m < 4; ++m)
#pragma unroll
                for (int bj = 0; bj < 2; ++bj) {
                    const f32x4 v0 = acc[ai][bj][m][0], v1 = acc[ai][bj][m][1];
                    u32x4 w; w.x = cvt_pk_bf16(v0[0], v0[1]); w.y = cvt_pk_bf16(v0[2], v0[3]); w.z = cvt_pk_bf16(v1[0], v1[1]); w.w = cvt_pk_bf16(v1[2], v1[3]);
                    *(u32x4*)(U + s5u_off(row0 + ai * HALF + m * 16, col0 + bj * HALF)) = w;
                }
    }
};

__host__ __device__ __forceinline__ int upw_row(int n) { return n < 5504 ? 256 * (n >> 7) + (n & 127) : 256 * ((n - 5504) >> 7) + 128 + ((n - 5504) & 127); }
__device__ __forceinline__ float dpp_ror1(float v) { return __int_as_float(__builtin_amdgcn_update_dpp(0, __float_as_int(v), 0x121, 0xF, 0xF, true)); }
__device__ __forceinline__ float dpp_ror15(float v) { return __int_as_float(__builtin_amdgcn_update_dpp(0, __float_as_int(v), 0x12F, 0xF, 0xF, true)); }
struct UpOrder {
    int G, c;
    __host__ __device__ void init(int G_, int c_) { G = G_; c = c_; }
    __host__ __device__ __forceinline__ bool next(int i, Unit& u) const {
        int strip = -1, k = 0, p = -1;
        if (G == 256) {
            if (c < 86) { if (i < 4) { strip = c; k = i; } else if (i < 7) p = (i - 4) * 86 + c; }
            else { const int q = 258 + (c - 86) + i * 170; if (q < 1376) p = q; }
        } else {
            const int ns = c < 86 ? (86 - c + G - 1) / G : 0;
            if (i < 4 * ns) { strip = c + (i >> 2) * G; k = i & 3; } else { const int q = c + (i - 4 * ns) * G; if (q < 1376) p = q; }
        }
        const bool isS = strip >= 0;
        u.pm = isS ? 32 + 4 * (strip / 43) + k : (p & 31); u.pn = isS ? strip % 43 : (p >> 5);
        return isS || p >= 0;
    }
    __device__ __forceinline__ void a_ready(const Unit&) const {}
    __device__ __forceinline__ void done(const Unit&) const {}
};
struct EpiConv {
    static constexpr bool PERM = true, AFTER_DRAIN = false, PERM_A = true;
    bf16_t* ACT; const float* cw; const float* cb; PG8_LAS float* X;
    __device__ __forceinline__ void operator()(const f32x4 (&acc)[2][2][4][2], const Unit& u, int wr, int wc, int fr, int fq) const {
        const int cl = wc * 32 + 8 * fq;
        const bool sample = u.pm >= 32; const int k = (u.pm - 32) & 3;
        const bool has_prev = sample && k > 0, has_next = sample && k < 3;
        PG8_LAS float* SVw = X + 2048 + (k & 1) * 512; const PG8_LAS float* SVr = X + 2048 + ((k & 1) ^ 1) * 512;
        const int f0 = u.pn * HALF + cl;
        f32x4 cwv[2][8];
        { const int f4 = f0;
            cwv[0][0] = *(const f32x4*)(cw + f4); cwv[0][1] = *(const f32x4*)(cw + 11008 + f4); cwv[0][2] = *(const f32x4*)(cw + 22016 + f4); cwv[0][3] = *(const f32x4*)(cb + f4);
            cwv[0][4] = *(const f32x4*)(cw + 5504 + f4); cwv[0][5] = *(const f32x4*)(cw + 11008 + 5504 + f4); cwv[0][6] = *(const f32x4*)(cw + 22016 + 5504 + f4); cwv[0][7] = *(const f32x4*)(cb + 5504 + f4); }
        if (fr == 0 || fr == 15) {
            const int fl = fr == 0 ? 0 : 1;
#pragma unroll
            for (int ai = 0; ai < 2; ++ai)
#pragma unroll
                for (int bj = 0; bj < 2; ++bj)
#pragma unroll
                    for (int n = 0; n < 2; ++n) *(PG8_LAS f32x4*)(X + ((2 * ai + wr) * 2 + fl) * 256 + bj * HALF + cl + 4 * n) = fr == 0 ? acc[ai][bj][0][n] : acc[ai][bj][3][n];
        }
        asm volatile("s_waitcnt lgkmcnt(0)" ::: "memory"); __builtin_amdgcn_s_barrier(); asm volatile("" ::: "memory");
        const size_t rowb = (size_t)u.pm * BM + wr * 64 + 4 * fr;
        u32x2 owk[2][4];
#pragma unroll
        for (int n = 0; n < 2; ++n) {
            const int f4 = f0 + 4 * n;
            const f32x4 w0g = cwv[n][0], w1g = cwv[n][1], w2g = cwv[n][2], bg = cwv[n][3], w0v = cwv[n][4], w1v = cwv[n][5], w2v = cwv[n][6], bv = cwv[n][7];
            const f32x4 z4 = {0.f, 0.f, 0.f, 0.f};
            if (has_prev && wr == 1 && fr == 15) {
                const f32x4 pg = *(const PG8_LAS f32x4*)(SVr + cl + 4 * n), pv = *(const PG8_LAS f32x4*)(SVr + HALF + cl + 4 * n), cg = *(const PG8_LAS f32x4*)(SVr + 256 + cl + 4 * n), cv = *(const PG8_LAS f32x4*)(SVr + 256 + HALF + cl + 4 * n);
                const f32x4 ng = *(const PG8_LAS f32x4*)(X + cl + 4 * n), nv = *(const PG8_LAS f32x4*)(X + HALF + cl + 4 * n);
                const f32x4 zg = w0g * pg + w1g * cg + w2g * ng + bg, zv = w0v * pv + w1v * cv + w2v * nv + bv;
                float o[4];
#pragma unroll
                for (int e2 = 0; e2 < 4; ++e2) o[e2] = zg[e2] * __builtin_amdgcn_rcpf(1.0f + __builtin_amdgcn_exp2f(-1.4426950408889634f * zg[e2])) * zv[e2];
                u32x2 w; w.x = cvt_pk_bf16(o[0], o[1]); w.y = cvt_pk_bf16(o[2], o[3]);
                *(u32x2*)(ACT + ((size_t)u.pm * BM - 1) * 5504 + f4) = w;
            }
#pragma unroll
            for (int ai = 0; ai < 2; ++ai) {
                const int q = 2 * ai + wr;
                if (n == 0 && ai == 1) { const int f4 = f0 + 4;
                    cwv[1][0] = *(const f32x4*)(cw + f4); cwv[1][1] = *(const f32x4*)(cw + 11008 + f4); cwv[1][2] = *(const f32x4*)(cw + 22016 + f4); cwv[1][3] = *(const f32x4*)(cb + f4);
                    cwv[1][4] = *(const f32x4*)(cw + 5504 + f4); cwv[1][5] = *(const f32x4*)(cw + 11008 + 5504 + f4); cwv[1][6] = *(const f32x4*)(cw + 22016 + 5504 + f4); cwv[1][7] = *(const f32x4*)(cb + 5504 + f4); }
                const f32x4 hpg = q > 0 ? *(const PG8_LAS f32x4*)(X + ((q - 1) * 2 + 1) * 256 + cl + 4 * n) : (has_prev ? *(const PG8_LAS f32x4*)(SVr + 256 + cl + 4 * n) : z4);
                const f32x4 hpv = q > 0 ? *(const PG8_LAS f32x4*)(X + ((q - 1) * 2 + 1) * 256 + HALF + cl + 4 * n) : (has_prev ? *(const PG8_LAS f32x4*)(SVr + 256 + HALF + cl + 4 * n) : z4);
                const f32x4 hng = q < 3 ? *(const PG8_LAS f32x4*)(X + ((q + 1) * 2 + 0) * 256 + cl + 4 * n) : z4, hnv = q < 3 ? *(const PG8_LAS f32x4*)(X + ((q + 1) * 2 + 0) * 256 + HALF + cl + 4 * n) : z4;
                const bool deferred = has_next && ai == 1 && wr == 1 && fr == 15;
                u32x2 ow[4];
#pragma unroll
                for (int p = 0; p < 2; ++p) {
                    const f32x2 x0 = p ? acc[ai][0][0][n].hi : acc[ai][0][0][n].lo, x1 = p ? acc[ai][0][1][n].hi : acc[ai][0][1][n].lo, x2 = p ? acc[ai][0][2][n].hi : acc[ai][0][2][n].lo, x3 = p ? acc[ai][0][3][n].hi : acc[ai][0][3][n].lo;
                    const f32x2 y0 = p ? acc[ai][1][0][n].hi : acc[ai][1][0][n].lo, y1 = p ? acc[ai][1][1][n].hi : acc[ai][1][1][n].lo, y2 = p ? acc[ai][1][2][n].hi : acc[ai][1][2][n].lo, y3 = p ? acc[ai][1][3][n].hi : acc[ai][1][3][n].lo;
                    const f32x2 hpg2 = p ? hpg.hi : hpg.lo, hpv2 = p ? hpv.hi : hpv.lo, hng2 = p ? hng.hi : hng.lo, hnv2 = p ? hnv.hi : hnv.lo;
                    f32x2 pg, pv, ng, nv;
                    pg.x = dpp_ror1(x3.x); pg.y = dpp_ror1(x3.y); pv.x = dpp_ror1(y3.x); pv.y = dpp_ror1(y3.y); ng.x = dpp_ror15(x0.x); ng.y = dpp_ror15(x0.y); nv.x = dpp_ror15(y0.x); nv.y = dpp_ror15(y0.y);
                    pg.x = fr == 0 ? hpg2.x : pg.x; pg.y = fr == 0 ? hpg2.y : pg.y; pv.x = fr == 0 ? hpv2.x : pv.x; pv.y = fr == 0 ? hpv2.y : pv.y;
                    ng.x = fr == 15 ? hng2.x : ng.x; ng.y = fr == 15 ? hng2.y : ng.y; nv.x = fr == 15 ? hnv2.x : nv.x; nv.y = fr == 15 ? hnv2.y : nv.y;
                    const f32x2 a0 = p ? w0g.hi : w0g.lo, a1 = p ? w1g.hi : w1g.lo, a2 = p ? w2g.hi : w2g.lo, ab = p ? bg.hi : bg.lo, c0 = p ? w0v.hi : w0v.lo, c1 = p ? w1v.hi : w1v.lo, c2 = p ? w2v.hi : w2v.lo, cbb = p ? bv.hi : bv.lo;
                    f32x2 zg[4], zv[4];
                    zg[0] = __builtin_elementwise_fma(pg, a0, __builtin_elementwise_fma(x1, a2, __builtin_elementwise_fma(x0, a1, ab)));
                    zg[1] = __builtin_elementwise_fma(x0, a0, __builtin_elementwise_fma(x2, a2, __builtin_elementwise_fma(x1, a1, ab)));
                    zg[2] = __builtin_elementwise_fma(x1, a0, __builtin_elementwise_fma(x3, a2, __builtin_elementwise_fma(x2, a1, ab)));
                    zg[3] = __builtin_elementwise_fma(x2, a0, __builtin_elementwise_fma(ng, a2, __builtin_elementwise_fma(x3, a1, ab)));
                    zv[0] = __builtin_elementwise_fma(pv, c0, __builtin_elementwise_fma(y1, c2, __builtin_elementwise_fma(y0, c1, cbb)));
                    zv[1] = __builtin_elementwise_fma(y0, c0, __builtin_elementwise_fma(y2, c2, __builtin_elementwise_fma(y1, c1, cbb)));
                    zv[2] = __builtin_elementwise_fma(y1, c0, __builtin_elementwise_fma(y3, c2, __builtin_elementwise_fma(y2, c1, cbb)));
                    zv[3] = __builtin_elementwise_fma(y2, c0, __builtin_elementwise_fma(nv, c2, __builtin_elementwise_fma(y3, c1, cbb)));
#pragma unroll
                    for (int m = 0; m < 4; ++m) {
                        const f32x2 ea = zg[m] * -1.4426950408889634f; f32x2 ex; ex.x = __builtin_amdgcn_exp2f(ea.x); ex.y = __builtin_amdgcn_exp2f(ea.y);
                        const f32x2 dn = ex + 1.0f; f32x2 rc; rc.x = __builtin_amdgcn_rcpf(dn.x); rc.y = __builtin_amdgcn_rcpf(dn.y);
                        const f32x2 o2 = (zg[m] * zv[m]) * rc;
                        const unsigned pk = cvt_pk_bf16(o2.x, o2.y); if (p == 0) ow[m].x = pk; else ow[m].y = pk;
                    }
                }
                if (ai == 1) { if (deferred) { *(PG8_LAS f32x4*)(SVw + cl + 4 * n) = acc[1][0][2][n]; *(PG8_LAS f32x4*)(SVw + HALF + cl + 4 * n) = acc[1][1][2][n]; *(PG8_LAS f32x4*)(SVw + 256 + cl + 4 * n) = acc[1][0][3][n]; *(PG8_LAS f32x4*)(SVw + 256 + HALF + cl + 4 * n) = acc[1][1][3][n]; } }
#pragma unroll
                for (int m = 0; m < 4; ++m) {
                    if (n == 0) owk[ai][m] = ow[m];
                    else if (!(deferred && m == 3)) { u32x4 w4; w4.x = owk[ai][m].x; w4.y = owk[ai][m].y; w4.z = ow[m].x; w4.w = ow[m].y; *(u32x4*)(ACT + (rowb + ai * HALF + m) * 5504 + f0) = w4; }
                }
            }
        }
    }
};
template <class E, class = void> struct epi_perm_unit { static constexpr bool v = false; };
template <class E> struct epi_perm_unit<E, decltype((void)E::PERM_A_UNIT)> { static constexpr bool v = E::PERM_A_UNIT; };
template <class E, class = void> struct epi_perm_a { static constexpr bool v = false; };
template <class E> struct epi_perm_a<E, decltype((void)E::PERM_A)> { static constexpr bool v = E::PERM_A; };
template <class Epi, class Sched, bool ALIGN_EPI = false, bool SP2 = false>
__device__ __forceinline__ void gemm_phase(PG8_LAS unsigned char* lds, const Gemm g, const Sched& S, const Epi& E, const int tid) {
    const int wid = __builtin_amdgcn_readfirstlane(tid >> 6), lane = tid & 63, wr = wid >> 2, wc = wid & 3, fr = lane & 15, fq = lane >> 4;
    const int K = g.K, nt = K / BK;
    unsigned voffA[2], voffAp[2], voffB[2];
#pragma unroll
    for (int i = 0; i < 2; ++i) { int R, C; stage_rc(tid * 16 + i * 8192, R, C); const int Rb = Epi::PERM ? ((R & ~31) + perm32(R & 31)) : R;
        const int Rp = (R & 64) + 4 * (R & 15) + ((R >> 4) & 3);
        voffA[i] = (unsigned)(R * K + C) * 2u; voffAp[i] = (unsigned)(Rp * K + C) * 2u; voffB[i] = (unsigned)(Rb * K + C) * 2u; }
    auto permof = [&](const Unit& u_) -> bool { if constexpr (epi_perm_unit<Epi>::v) return Epi::perm_a_of(u_); else return epi_perm_a<Epi>::v; };
    const size_t kstep = (size_t)(BK * 2);
    const size_t hstep = (size_t)HALF * K * 2;
    const size_t tstep = 2 * hstep;
    const unsigned ldsw = (unsigned)wid * 1024u;
    const int aoff = lds_byte(wr * 64 + fr, fq * 8), boff = lds_byte(wc * 32 + fr, fq * 8);
#define PG8_SA(b, h) (((b) * 2 + (h)) * HTB)
#define PG8_SB(b, h) ((4 + (b) * 2 + (h)) * HTB)
#define PG8_STAGE(bufoff, gbase, voff) do { _Pragma("unroll") for (int _i = 0; _i < 2; ++_i) \
        __builtin_amdgcn_global_load_lds((const unsigned*)((const char*)(gbase) + (voff)[_i]), (PG8_LAS unsigned*)(lds + (bufoff) + ldsw + _i * 8192), 16, 0, 0); } while (0)
#define PG8_LDA(dst, b, h) do { _Pragma("unroll") for (int m = 0; m < 4; ++m) _Pragma("unroll") for (int k = 0; k < 2; ++k) dst[m][k] = *(const PG8_LAS bf16x8*)(lds + PG8_SA(b, h) + aoff + m * 2048 + k * 1024); } while (0)
#define PG8_LDB(dst, b, h) do { _Pragma("unroll") for (int n = 0; n < 2; ++n) _Pragma("unroll") for (int k = 0; k < 2; ++k) dst[n][k] = *(const PG8_LAS bf16x8*)(lds + PG8_SB(b, h) + boff + n * 2048 + k * 1024); } while (0)
#define PG8_MMA(ai, bj, At, Bt) do { __builtin_amdgcn_s_setprio(1); _Pragma("unroll") for (int m = 0; m < 4; ++m) _Pragma("unroll") for (int n = 0; n < 2; ++n) _Pragma("unroll") for (int k = 0; k < 2; ++k) \
        acc[ai][bj][m][n] = __builtin_amdgcn_mfma_f32_16x16x32_bf16(Bt[n][k], At[m][k], acc[ai][bj][m][n], 0, 0, 0); __builtin_amdgcn_s_setprio(0); } while (0)
#define PG8_WAIT_V(n) asm volatile("s_waitcnt vmcnt(" #n ")" ::: "memory")
#define PG8_WAIT_L(n) asm volatile("s_waitcnt lgkmcnt(" #n ")" ::: "memory")
#define PG8_BAR __builtin_amdgcn_s_barrier()
#define PG8_SCHED __builtin_amdgcn_sched_barrier(0)
    Unit cur, nxt; int ui = 0;
    if (!S.next(0, cur)) return;
    f32x4 acc[2][2][4][2];
#pragma unroll
    for (int a = 0; a < 2; ++a)
#pragma unroll
        for (int b = 0; b < 2; ++b)
#pragma unroll
            for (int m = 0; m < 4; ++m)
#pragma unroll
                for (int n = 0; n < 2; ++n) acc[a][b][m][n] = (f32x4){0.f, 0.f, 0.f, 0.f};
    bf16x8 At[4][2], B0[2][2], B1[2][2];
    const char* cA = (const char*)g.A + (size_t)cur.pm * tstep + (size_t)cur.k0 * kstep; const char* cB = (const char*)g.Bt + (size_t)cur.pn * tstep + (size_t)cur.k0 * kstep;
    S.a_ready(cur);
    bool pc = permof(cur); unsigned vAc[2] = {pc ? voffAp[0] : voffA[0], pc ? voffAp[1] : voffA[1]};
    if constexpr (SP2) {
        PG8_STAGE(PG8_SB(0, 0), cB, voffB); PG8_STAGE(PG8_SB(0, 1), cB + hstep, voffB); PG8_STAGE(PG8_SA(0, 0), cA, vAc); PG8_STAGE(PG8_SA(0, 1), cA + hstep, vAc);
        if (wr == 1) PG8_BAR;
        PG8_WAIT_V(2); PG8_BAR;
        PG8_STAGE(PG8_SB(1, 0), cB + kstep, voffB); PG8_STAGE(PG8_SA(1, 0), cA + kstep, vAc); PG8_STAGE(PG8_SB(1, 1), cB + hstep + kstep, voffB);
        PG8_WAIT_V(6); PG8_BAR;
    } else {
        PG8_STAGE(PG8_SB(0, 0), cB, voffB); PG8_STAGE(PG8_SA(0, 0), cA, vAc); PG8_STAGE(PG8_SB(0, 1), cB + hstep, voffB); PG8_STAGE(PG8_SA(0, 1), cA + hstep, vAc);
        if (wr == 1) PG8_BAR;
        PG8_WAIT_V(4); PG8_BAR;
        PG8_STAGE(PG8_SB(1, 0), cB + kstep, voffB); PG8_STAGE(PG8_SA(1, 0), cA + kstep, vAc); PG8_STAGE(PG8_SB(1, 1), cB + hstep + kstep, voffB);
        PG8_WAIT_V(6); PG8_BAR;
    }
    for (;;) {
        const bool has_next = S.next(ui + 1, nxt);
        const char* nA = has_next ? (const char*)g.A + (size_t)nxt.pm * tstep + (size_t)nxt.k0 * kstep : cA; const char* nB = has_next ? (const char*)g.Bt + (size_t)nxt.pn * tstep + (size_t)nxt.k0 * kstep : cB;
        const int cnt = cur.nk ? cur.nk : nt;
        const bool pnx = has_next ? permof(nxt) : pc;
        for (int t = 0; t < cnt; t += 2) {
            const bool last = (t == cnt - 2);
            const char* a1 = cA + (size_t)(t + 1) * kstep;
            const char* a2 = last ? nA : cA + (size_t)(t + 2) * kstep; const char* b2 = last ? nB : cB + (size_t)(t + 2) * kstep;
            const char* a3 = a2 + kstep; const char* b3 = b2 + kstep;
            const bool p2 = last ? pnx : pc; const unsigned vA2[2] = {p2 ? voffAp[0] : voffA[0], p2 ? voffAp[1] : voffA[1]};
            if (last && has_next) S.a_ready(nxt);
            if constexpr (SP2) {
            PG8_LDB(B0, 0, 0); PG8_LDB(B1, 0, 1); PG8_SCHED; PG8_LDA(At, 0, 0); PG8_STAGE(PG8_SA(1, 1), a1 + hstep, vAc);
            PG8_WAIT_V(8); PG8_WAIT_L(0); PG8_BAR; PG8_MMA(0, 0, At, B0); PG8_MMA(0, 1, At, B1); PG8_BAR; PG8_SCHED;
            PG8_LDA(At, 0, 1); PG8_STAGE(PG8_SB(0, 0), b2, voffB); PG8_STAGE(PG8_SB(0, 1), b2 + hstep, voffB); PG8_STAGE(PG8_SA(0, 0), a2, vA2);
            PG8_WAIT_V(8); PG8_WAIT_L(0); PG8_BAR; PG8_MMA(1, 0, At, B0); PG8_MMA(1, 1, At, B1); PG8_BAR; PG8_SCHED;
            PG8_LDB(B0, 1, 0); PG8_LDB(B1, 1, 1); PG8_SCHED; PG8_LDA(At, 1, 0); PG8_STAGE(PG8_SA(0, 1), a2 + hstep, vA2);
            PG8_WAIT_V(8); PG8_WAIT_L(0); PG8_BAR; PG8_MMA(0, 0, At, B0); PG8_MMA(0, 1, At, B1); PG8_BAR; PG8_SCHED;
            PG8_LDA(At, 1, 1); PG8_STAGE(PG8_SB(1, 0), b3, voffB); PG8_STAGE(PG8_SB(1, 1), b3 + hstep, voffB); PG8_STAGE(PG8_SA(1, 0), a3, vA2);
            PG8_WAIT_V(8); PG8_WAIT_L(0); PG8_BAR; PG8_MMA(1, 0, At, B0); PG8_MMA(1, 1, At, B1); PG8_BAR; PG8_SCHED;
            } else {
            PG8_LDB(B0, 0, 0); PG8_SCHED; PG8_LDA(At, 0, 0); PG8_STAGE(PG8_SA(1, 1), a1 + hstep, vAc);
            PG8_WAIT_L(8); PG8_BAR; PG8_WAIT_L(0); PG8_MMA(0, 0, At, B0); PG8_BAR; PG8_SCHED;
            PG8_LDB(B1, 0, 1); PG8_STAGE(PG8_SB(0, 0), b2, voffB);
            PG8_BAR; PG8_WAIT_L(0); PG8_MMA(0, 1, At, B1); PG8_BAR;
            PG8_LDA(At, 0, 1); PG8_STAGE(PG8_SA(0, 0), a2, vA2);
            PG8_BAR; PG8_WAIT_L(0); PG8_MMA(1, 0, At, B0); PG8_BAR; PG8_SCHED;
            PG8_STAGE(PG8_SB(0, 1), b2 + hstep, voffB);
            PG8_WAIT_V(6); PG8_BAR; PG8_MMA(1, 1, At, B1); PG8_BAR;
            PG8_LDB(B0, 1, 0); PG8_SCHED; PG8_LDA(At, 1, 0); PG8_STAGE(PG8_SA(0, 1), a2 + hstep, vA2);
            PG8_WAIT_L(8); PG8_BAR; PG8_WAIT_L(0); PG8_MMA(0, 0, At, B0); PG8_BAR; PG8_SCHED;
            PG8_LDB(B1, 1, 1); PG8_STAGE(PG8_SB(1, 0), b3, voffB);
            PG8_BAR; PG8_WAIT_L(0); PG8_MMA(0, 1, At, B1); PG8_BAR;
            PG8_LDA(At, 1, 1); PG8_STAGE(PG8_SA(1, 0), a3, vA2);
            PG8_BAR; PG8_WAIT_L(0); PG8_MMA(1, 0, At, B0); PG8_BAR; PG8_SCHED;
            PG8_STAGE(PG8_SB(1, 1), b3 + hstep, voffB);
            PG8_WAIT_V(6); PG8_BAR; PG8_MMA(1, 1, At, B1); PG8_BAR;
            }
        }
        if constexpr (ALIGN_EPI) { if (wr == 0) PG8_BAR; }
        if constexpr (!Epi::AFTER_DRAIN) { E(acc, cur, wr, wc, fr, fq); S.done(cur); }
        if (!has_next) break;
#pragma unroll
        for (int a = 0; a < 2; ++a)
#pragma unroll
            for (int b = 0; b < 2; ++b)
#pragma unroll
                for (int m = 0; m < 4; ++m)
#pragma unroll
                    for (int n = 0; n < 2; ++n) acc[a][b][m][n] = (f32x4){0.f, 0.f, 0.f, 0.f};
        cur = nxt; cA = nA; cB = nB; ++ui;
        pc = pnx; vAc[0] = pc ? voffAp[0] : voffA[0]; vAc[1] = pc ? voffAp[1] : voffA[1];
        if constexpr (ALIGN_EPI) { if (wr == 1) PG8_BAR; }
    }
    PG8_WAIT_V(0);
    if constexpr (!ALIGN_EPI) { if (wr == 0) PG8_BAR; }
    PG8_BAR;
    if constexpr (Epi::AFTER_DRAIN) { E.fused(acc, cur, wr, wc, fr, fq, lds, wid, lane); S.done(cur); }
#undef PG8_SA
#undef PG8_SB
#undef PG8_STAGE
#undef PG8_LDA
#undef PG8_LDB
#undef PG8_MMA
#undef PG8_WAIT_V
#undef PG8_WAIT_L
#undef PG8_BAR
#undef PG8_SCHED
}
}
#define GAS __attribute__((address_space(1)))
#define LAS __attribute__((address_space(3)))
typedef unsigned short bf16;
typedef unsigned v4u __attribute__((ext_vector_type(4)));
typedef float f32x4 __attribute__((ext_vector_type(4)));
typedef short bf16x8 __attribute__((ext_vector_type(8)));
typedef GAS unsigned gu32;
typedef GAS unsigned long long gu64;
#define RLX_AGENT __ATOMIC_RELAXED, __HIP_MEMORY_SCOPE_AGENT
#define LDS_WAIT() asm volatile("s_waitcnt lgkmcnt(0)" ::: "memory")
#define VM_WAIT() asm volatile("s_waitcnt vmcnt(0)" ::: "memory")
__device__ __forceinline__ unsigned long long rt() { return __builtin_amdgcn_s_memrealtime(); }
__device__ __forceinline__ unsigned f2bf(float f) { unsigned u = __builtin_bit_cast(unsigned, f); return (u + 0x7fffu + ((u >> 16) & 1u)) >> 16; }
__device__ __forceinline__ unsigned pk2(float lo, float hi) { return f2bf(lo) | (f2bf(hi) << 16); }

#define XB_TMO      128
#define XB_XCNT(j)  (256  + 64 * (j))
#define XB_XSUB(j)  (1280 + 64 * (j))
#define XB_XGEN(j)  (2304 + 64 * (j))
#define XB_TOP      3328
#define XB_TOPGEN   3392
#define XCD_BAR_WORDS 3456
#define XB_SPIN_CAP (1u << 18)

__device__ __forceinline__ unsigned xb_ld(unsigned* p)              { return __hip_atomic_load(p, __ATOMIC_RELAXED, __HIP_MEMORY_SCOPE_AGENT); }
__device__ __forceinline__ unsigned xb_add(unsigned* p, unsigned v) { return __hip_atomic_fetch_add(p, v, __ATOMIC_RELAXED, __HIP_MEMORY_SCOPE_AGENT); }
__device__ __forceinline__ unsigned xb_xcc_id() { return (unsigned)__builtin_amdgcn_s_getreg((3 << 11) | 20) & 0xFu; }
#define XB_SPIN(cond, bar) do { unsigned _sp = 0; while (cond) { __builtin_amdgcn_s_sleep(1); \
    if ((++_sp & 255u) == 0u) { if (xb_ld(&(bar)[XB_TMO])) break; if (_sp > XB_SPIN_CAP) { atomicAdd(&(bar)[XB_TMO], 1u); break; } } } } while (0)

struct XcdBarrier {
    unsigned* bar; unsigned x;
    volatile LAS unsigned* st;
};

__device__ __forceinline__ XcdBarrier xcd_barrier_post(unsigned* bar, volatile LAS unsigned* st) {
    XcdBarrier b; b.bar = bar; b.x = xb_xcc_id(); b.st = st;
    if (threadIdx.x == 0) (void)xb_add(&bar[XB_XCNT(b.x)], 1u);
    return b;
}
__device__ __forceinline__ void xcd_barrier_complete(unsigned* bar, unsigned x, unsigned& nloc, unsigned& nx) {
    const unsigned G = gridDim.x * gridDim.y * gridDim.z;
    unsigned sum, cnt, mine, sp = 0u;
    for (;;) {
        sum = 0u; cnt = 0u; mine = 0u;
#pragma unroll
        for (unsigned j = 0; j < 16; ++j) { const unsigned c = xb_ld(&bar[XB_XCNT(j)]); sum += c; cnt += (c > 0u) ? 1u : 0u; mine = (j == x) ? c : mine; }
        if (sum == G) break;
        __builtin_amdgcn_s_sleep(1);
        if ((++sp & 255u) == 0u) { if (xb_ld(&bar[XB_TMO])) break; if (sp > XB_SPIN_CAP) { atomicAdd(&bar[XB_TMO], 1u); break; } }
    }
    nloc = mine > 0u ? mine : 1u; nx = cnt > 0u ? cnt : 1u;
}

__device__ __forceinline__ void xcd_barrier(const XcdBarrier& b) {
    asm volatile("s_waitcnt vmcnt(0)" ::: "memory");
    __syncthreads();
    if (threadIdx.x == 0) {
        unsigned* bar = b.bar;
        __builtin_amdgcn_s_waitcnt(0);
        unsigned nloc = b.st[0], nx = b.st[1];
        if (nloc == 0u) { xcd_barrier_complete(bar, b.x, nloc, nx); b.st[0] = nloc; b.st[1] = nx; }
        const unsigned old = xb_add(&bar[XB_XSUB(b.x)], 1u);
        const unsigned gen = old / nloc;
        if (old + 1u == (gen + 1u) * nloc) {
            __builtin_amdgcn_fence(__ATOMIC_RELEASE, "agent");
            asm volatile("s_waitcnt vmcnt(0)" ::: "memory");
            const unsigned og = xb_add(&bar[XB_TOP], 1u);
            const unsigned tg = og / nx;
            if (og + 1u == (tg + 1u) * nx) xb_add(&bar[XB_TOPGEN], 1u);
            else XB_SPIN(xb_ld(&bar[XB_TOPGEN]) == tg, bar);
            __builtin_amdgcn_fence(__ATOMIC_ACQUIRE, "agent");
            xb_add(&bar[XB_XGEN(b.x)], 1u);
            asm volatile("s_waitcnt vmcnt(0)" ::: "memory");
        } else {
            XB_SPIN(xb_ld(&bar[XB_XGEN(b.x)]) == gen, bar);
            __builtin_amdgcn_fence(__ATOMIC_ACQUIRE, "agent");
            asm volatile("s_waitcnt vmcnt(0)" ::: "memory");
        }
    }
    __syncthreads();
}
constexpr int D = 2048, NH = 16, HD = 128, FF = 5504, F2 = 11008, MP = 8192, MS = 2048, M = 10240;
constexpr int SEQ = 256, DSEQ = 1024, PAST = 512, NG = 128, GC = 16, SP = 64;
constexpr float NORM_EPS = 1e-6f;
constexpr float LOG2E = 1.4426950408889634f;
constexpr float C2 = 0.08838834764831845f * 1.4426950408889634f;
constexpr int NWAVES = 8, NTHR = 512;
enum { I_XP = 0, I_XS, I_CK, I_CV, I_SRE, I_SIM, I_C, I_CCTX, I_ADAW, I_ADAB, I_N1G, I_N2G, I_WQKV, I_RPB, I_WO, I_WIN, I_ARE, I_AIM, I_LOGDT, I_BRE, I_BIM, I_CRE, I_CIM, I_SD, I_WGATE, I_WOUT, I_WUP, I_CONVW, I_CONVB, I_WDN, I_FG, N_IN };

struct Args;
typedef const __attribute__((address_space(4))) unsigned char* kseg_t;
__device__ __forceinline__ const float* ARG_IN(int i) { kseg_t k = (kseg_t)__builtin_amdgcn_kernarg_segment_ptr(); return *(const float* const volatile __attribute__((address_space(4)))*)(k + 8 * i); }
__device__ __forceinline__ float* ARG_OUT() { kseg_t k = (kseg_t)__builtin_amdgcn_kernarg_segment_ptr(); return *(float* const volatile __attribute__((address_space(4)))*)(k + 8 * N_IN); }
__device__ __forceinline__ int ARG_I32(int i) { kseg_t k = (kseg_t)__builtin_amdgcn_kernarg_segment_ptr(); return *(const volatile __attribute__((address_space(4))) int*)(k + 8 * N_IN + 16 + 4 * i); }
__device__ __forceinline__ unsigned char* ARG_WS() { kseg_t k = (kseg_t)__builtin_amdgcn_kernarg_segment_ptr(); return *(unsigned char* const volatile __attribute__((address_space(4)))*)(k + 8 * N_IN + 8); }
constexpr size_t O_Y = 0, O_NK = (size_t)M * D, O_NV = O_NK + (size_t)MP * D, O_SRE = O_NV + (size_t)MP * D, O_SIM = O_SRE + 32 * 2 * 128 * 64, O_END = O_SIM + 32 * 2 * 128 * 64;

constexpr size_t MiB = 1u << 20, KiB = 1u << 10;
constexpr size_t WS_CTL = 0, CTL_ZERO_BYTES = 1 * MiB;
constexpr size_t WS_MOD = 256 * KiB;
constexpr size_t WS_DBG = 768 * KiB;
constexpr size_t WS_WQKV = 1 * MiB, WS_WO = 25 * MiB, WS_WIN = 33 * MiB, WS_WGATE = 41 * MiB, WS_WOUT = 49 * MiB;
constexpr size_t WS_WUP0 = 57 * MiB, WS_WUP1 = 100 * MiB, WS_WDN0 = 143 * MiB, WS_WDN1 = 143 * MiB + 22016 * KiB;
constexpr size_t WS_X1 = 186 * MiB, WS_HB = 266 * MiB, WS_S = 306 * MiB;
constexpr size_t WS_Q = WS_S, WS_KF = WS_S + 40 * MiB, WS_VTF = WS_S + 84 * MiB, WS_O = WS_S + 128 * MiB;
constexpr size_t WS_UP = WS_S, WS_ACT = WS_S + 215 * MiB;
constexpr size_t WS_U = WS_S, WS_Y = WS_S + 40 * MiB, WS_Y2 = WS_S + 80 * MiB, WS_S5W = WS_S + 120 * MiB;
constexpr size_t WS_SLAB = WS_S + 323 * MiB;
constexpr size_t WS_END = WS_SLAB + 64 * MiB;
static_assert(WS_WDN1 + (size_t)D * FF * 2 <= WS_X1 && WS_WUP0 + (size_t)F2 * D * 2 <= WS_WUP1 && WS_WUP1 + (size_t)F2 * D * 2 <= WS_WDN0 && WS_WDN0 + (size_t)D * FF * 2 <= WS_WDN1, "weight map");
static_assert(WS_UP + (size_t)M * F2 * 2 <= WS_ACT && WS_ACT + (size_t)M * FF * 2 <= WS_END && WS_O + (size_t)M * D * 2 <= WS_END && WS_S5W + (size_t)NG * 3 * 131072 <= WS_END, "scratch map");
constexpr int CW_BAR = 4096;

constexpr int RING_BYTES = 131072, LDSCTL_OFF = RING_BYTES, MISC_OFF = LDSCTL_OFF + 320, XCH_OFF = LDSCTL_OFF + 1024  , KFB_OFF = XCH_OFF  , LDS_BYTES = 155648;

typedef float f32x16 __attribute__((ext_vector_type(16)));
typedef unsigned u32x2 __attribute__((ext_vector_type(2)));
__device__ __forceinline__ unsigned cvtpk(float lo, float hi) { unsigned r; asm volatile("v_cvt_pk_bf16_f32 %0, %1, %2" : "=v"(r) : "v"(lo), "v"(hi)); return r; }
__device__ __forceinline__ float bf_lo(unsigned w) { return __uint_as_float(w << 16); }
__device__ __forceinline__ float bf_hi(unsigned w) { return __uint_as_float(w & 0xffff0000u); }
__device__ __forceinline__ float wave_sum(float v) {
#pragma unroll
    for (int o = 1; o < 64; o <<= 1) v += __shfl_xor(v, o);
    return v;
}
__device__ __forceinline__ float silu_f(float x) { return x / (1.0f + __expf(-x)); }
__device__ __forceinline__ float gelu_tanh(float x) {
    const float z = 0.7978845608028654f * (x + 0.044715f * x * x * x);
    return x * __builtin_amdgcn_rcpf(1.0f + __builtin_amdgcn_exp2f(-2.0f * LOG2E * z));
}

__device__ __forceinline__ void p0_ada(LAS unsigned char* lds, const float* adaw, const float* adab, const float* cctx, const float* cs, float* mod, int tid, int wave, int lane) {
    LAS float* red = (LAS float*)lds;
    for (int it = blockIdx.x; it < 768; it += gridDim.x) {
        const int l = it / 384, r = it % 384, cb = r >> 3, ks = r & 7;
        const float* W = adaw + (size_t)l * 2048 * 12288 + cb * 256 + lane * 4;
        const int k0 = ks * 256 + wave * 32;
        f32x4 a0 = {0.f, 0.f, 0.f, 0.f}, a1 = a0, a2 = a0;
#pragma unroll
        for (int hb = 0; hb < 2; ++hb) {
            f32x4 wv[16];
#pragma unroll
            for (int i = 0; i < 16; ++i) wv[i] = *(const f32x4*)(W + (size_t)(k0 + 16 * hb + i) * 12288);
#pragma unroll
            for (int i = 0; i < 16; ++i) {
                const int k = k0 + 16 * hb + i;
                const float s0 = silu_f(cctx[k]), s1 = silu_f(cs[k]), s2 = silu_f(cs[2048 + k]);
                a0 += wv[i] * s0; a1 += wv[i] * s1; a2 += wv[i] * s2;
            }
        }
        *(LAS f32x4*)(red + (wave * 3 + 0) * 256 + lane * 4) = a0;
        *(LAS f32x4*)(red + (wave * 3 + 1) * 256 + lane * 4) = a1;
        *(LAS f32x4*)(red + (wave * 3 + 2) * 256 + lane * 4) = a2;
        __syncthreads();
        for (int idx = tid; idx < 768; idx += NTHR) {
            const int cond = idx >> 8, col = idx & 255;
            float s = 0.f;
#pragma unroll
            for (int w = 0; w < 8; ++w) s += red[(w * 3 + cond) * 256 + col];
            if (ks == 0) s += adab[l * 12288 + cb * 256 + col];
            atomicAdd(mod + (size_t)(l * 3 + cond) * 12288 + cb * 256 + col, s);
        }
        __syncthreads();
    }
}
template <bool UPW = false>
__device__ __forceinline__ void p0_transpose_item(const float* W, int K, int N, bf16* WT, LAS float* scr, int item, int lane) {
    const int nblk = N / 32, kb = item / nblk, nb = item % nblk, k0 = 64 * kb, n0 = 32 * nb, r0 = UPW ? pg8::upw_row(n0) : n0;
    f32x4 v[8];
#pragma unroll
    for (int i = 0; i < 8; ++i) v[i] = *(const f32x4*)(W + (size_t)(k0 + 8 * i + (lane >> 3)) * N + n0 + (lane & 7) * 4);
#pragma unroll
    for (int i = 0; i < 8; ++i) { LAS float* d = scr + (8 * i + (lane >> 3)) * 33 + (lane & 7) * 4; d[0] = v[i].x; d[1] = v[i].y; d[2] = v[i].z; d[3] = v[i].w; }
    LDS_WAIT(); asm volatile("" ::: "memory");
    const int c = lane & 7;
#pragma unroll
    for (int j = 0; j < 4; ++j) { const int n = (lane >> 3) + 8 * j; const LAS float* s = scr + (8 * c) * 33 + n;
        v4u o; o.x = pk2(s[0 * 33], s[1 * 33]); o.y = pk2(s[2 * 33], s[3 * 33]); o.z = pk2(s[4 * 33], s[5 * 33]); o.w = pk2(s[6 * 33], s[7 * 33]);
        *(GAS v4u*)(WT + (size_t)(r0 + n) * K + k0 + 8 * c) = o; }
    LDS_WAIT(); asm volatile("" ::: "memory");
}
__device__ __forceinline__ void p0_weights(LAS unsigned char* lds, unsigned char* ws, int gw, int NGW, int wave, int lane, int it_lo = 0, int it_hi = 47360) {
    LAS float* scr = (LAS float*)(lds + wave * 16384);
    constexpr int I_QKV = 32 * 192, I_SQ = 32 * 64, I_UP = 32 * 344, I_DN = 86 * 64;
    for (int it = it_lo + gw; it < it_hi; it += NGW) {
        int r = it;
        if (r < I_QKV) { p0_transpose_item(ARG_IN(I_WQKV), D, 3 * D, (bf16*)(ws + WS_WQKV), scr, r, lane); continue; } r -= I_QKV;
        if (r < I_SQ) { p0_transpose_item(ARG_IN(I_WO), D, D, (bf16*)(ws + WS_WO), scr, r, lane); continue; } r -= I_SQ;
        if (r < I_SQ) { p0_transpose_item(ARG_IN(I_WIN), D, D, (bf16*)(ws + WS_WIN), scr, r, lane); continue; } r -= I_SQ;
        if (r < I_SQ) { p0_transpose_item(ARG_IN(I_WGATE), D, D, (bf16*)(ws + WS_WGATE), scr, r, lane); continue; } r -= I_SQ;
        if (r < I_SQ) { p0_transpose_item(ARG_IN(I_WOUT), D, D, (bf16*)(ws + WS_WOUT), scr, r, lane); continue; } r -= I_SQ;
        if (r < I_UP) { p0_transpose_item<true>(ARG_IN(I_WUP), D, F2, (bf16*)(ws + WS_WUP0), scr, r, lane); continue; } r -= I_UP;
        if (r < I_UP) { p0_transpose_item<true>(ARG_IN(I_WUP) + (size_t)D * F2, D, F2, (bf16*)(ws + WS_WUP1), scr, r, lane); continue; } r -= I_UP;
        if (r < I_DN) { p0_transpose_item(ARG_IN(I_WDN), FF, D, (bf16*)(ws + WS_WDN0), scr, r, lane); continue; } r -= I_DN;
        p0_transpose_item(ARG_IN(I_WDN) + (size_t)FF * D, FF, D, (bf16*)(ws + WS_WDN1), scr, r, lane);
    }
}
__device__ __forceinline__ void p0_cache(const float* ck, const float* cv, bf16* Kf, bf16* VTf, int gtid, int NGT) {
    for (int i = gtid; i < 2 * 512 * 256; i += NGT) {
        const size_t e = (size_t)i * 8;
        const int bt = i >> 8, col = (i & 255) * 8, bb = bt >> 9, t = bt & 511, h = col >> 7, d0 = col & 127;
        const size_t sb = pg8::seq_base_cache(bb, h);
        const f32x4 a = *(const f32x4*)(ck + e), b = *(const f32x4*)(ck + e + 4);
        const f32x4 c = *(const f32x4*)(cv + e), d = *(const f32x4*)(cv + e + 4);
        v4u o; o.x = pk2(a.x, a.y); o.y = pk2(a.z, a.w); o.z = pk2(b.x, b.y); o.w = pk2(b.z, b.w);
        *(v4u*)(Kf + sb + pg8::kf_off(t, d0)) = o;
        bf16* p = VTf + sb + pg8::vtf_off(t, d0);
        p[0] = (bf16)f2bf(c.x); p[8] = (bf16)f2bf(c.y); p[16] = (bf16)f2bf(c.z); p[24] = (bf16)f2bf(c.w);
        p[32] = (bf16)f2bf(d.x); p[40] = (bf16)f2bf(d.y); p[48] = (bf16)f2bf(d.z); p[56] = (bf16)f2bf(d.w);
    }
}

__device__ __forceinline__ void norm_rows(const float* xa, const float* xb, const float* g, const float* modl, int jshift, int jscale, bf16* out, int gw, int NGW, int lane,
                                          const float* slab = nullptr, const float* gatep = nullptr, float* xw = nullptr) {
    int m = gw; if (m >= M) return;
    f32x4 vn[8];
    { const float* xr = (m < MP ? xa : xb) + (size_t)m * D + lane * 4;
#pragma unroll
      for (int j = 0; j < 8; ++j) vn[j] = *(const f32x4*)(xr + 256 * j); }
    int ccur = -1; f32x4 A[8], B[8];
    while (m < M) {
        f32x4 v[8];
#pragma unroll
        for (int j = 0; j < 8; ++j) v[j] = vn[j];
        const int mn = m + NGW;
        if (mn < M) { const float* xr = (mn < MP ? xa : xb) + (size_t)mn * D + lane * 4;
#pragma unroll
            for (int j = 0; j < 8; ++j) vn[j] = *(const f32x4*)(xr + 256 * j); }
        const int cond = m < MP ? 0 : 1 + ((m - MP) >> 10);
        if (cond != ccur) {
            const float* sh = modl + (size_t)cond * 12288 + jshift * 2048 + lane * 4; const float* sc = modl + (size_t)cond * 12288 + jscale * 2048 + lane * 4;
#pragma unroll
            for (int j = 0; j < 8; ++j) { A[j] = *(const f32x4*)(g + lane * 4 + 256 * j) * (*(const f32x4*)(sc + 256 * j) + 1.0f); B[j] = *(const f32x4*)(sh + 256 * j); }
            ccur = cond;
        }
        if (slab != nullptr && m >= MP) {
            const float* sp = slab + (size_t)(m - MP) * D + lane * 4; const float* gt = gatep + (size_t)cond * 12288 + lane * 4; float* wr = xw + (size_t)m * D + lane * 4;
#pragma unroll
            for (int j = 0; j < 8; ++j) {
                const f32x4 p = (*(const f32x4*)(sp + 256 * j) + *(const f32x4*)(sp + (size_t)2048 * 2048 + 256 * j)) + (*(const f32x4*)(sp + (size_t)2 * 2048 * 2048 + 256 * j) + *(const f32x4*)(sp + (size_t)3 * 2048 * 2048 + 256 * j));
                v[j] = v[j] + *(const f32x4*)(gt + 256 * j) * p; *(f32x4*)(wr + 256 * j) = v[j];
            }
        }
        float ss = 0.f;
#pragma unroll
        for (int j = 0; j < 8; ++j) ss += (v[j].x * v[j].x + v[j].y * v[j].y) + (v[j].z * v[j].z + v[j].w * v[j].w);
        const float rstd = 1.0f / sqrtf(wave_sum(ss) * (1.0f / D) + NORM_EPS);
        bf16* orow = out + (size_t)m * D + lane * 4;
#pragma unroll
        for (int j = 0; j < 8; ++j) {
            const f32x4 o = v[j] * rstd * A[j] + B[j];
            u32x2 w; w.x = pk2(o.x, o.y); w.y = pk2(o.z, o.w);
            *(u32x2*)(orow + 256 * j) = w;
        }
        m = mn;
    }
}
__device__ __forceinline__ void final_norm_rows(float* x, const float* g, float* out, int gw, int NGW, int lane, const float* slab, const float* gate  ) {
    int m = gw; if (m >= M) return;
    f32x4 vn[8], G8[8];
#pragma unroll
    for (int j = 0; j < 8; ++j) { vn[j] = *(const f32x4*)(x + (size_t)m * D + lane * 4 + 256 * j); G8[j] = *(const f32x4*)(g + lane * 4 + 256 * j); }
    while (m < M) {
        float* xr = x + (size_t)m * D + lane * 4;
        f32x4 v[8];
#pragma unroll
        for (int j = 0; j < 8; ++j) v[j] = vn[j];
        const int mn = m + NGW;
        if (mn < M) {
#pragma unroll
            for (int j = 0; j < 8; ++j) vn[j] = *(const f32x4*)(x + (size_t)mn * D + lane * 4 + 256 * j); }
        if (m >= MP) {
            const int cond = 1 + ((m - MP) >> 10);
            const float* sp = slab + (size_t)(m - MP) * D + lane * 4; const float* gt = gate + (size_t)cond * 12288 + lane * 4;
#pragma unroll
            for (int j = 0; j < 8; ++j) {
                const f32x4 p = (*(const f32x4*)(sp + 256 * j) + *(const f32x4*)(sp + (size_t)2048 * 2048 + 256 * j)) + (*(const f32x4*)(sp + (size_t)2 * 2048 * 2048 + 256 * j) + *(const f32x4*)(sp + (size_t)3 * 2048 * 2048 + 256 * j));
                v[j] = v[j] + *(const f32x4*)(gt + 256 * j) * p;
#if DBG_CHECKS
                *(f32x4*)(xr + 256 * j) = v[j];
#endif
            }
        }
        (void)xr;
        float ss = 0.f;
#pragma unroll
        for (int j = 0; j < 8; ++j) ss += (v[j].x * v[j].x + v[j].y * v[j].y) + (v[j].z * v[j].z + v[j].w * v[j].w);
        const float rstd = 1.0f / sqrtf(wave_sum(ss) * (1.0f / D) + NORM_EPS);
        float* orow = out + (size_t)m * D + lane * 4;
#pragma unroll
        for (int j = 0; j < 8; ++j) *(f32x4*)(orow + 256 * j) = v[j] * rstd * G8[j];
        m = mn;
    }
}


__device__ __forceinline__ void unpack8(const v4u w, f32x4& a, f32x4& b) { a = (f32x4){bf_lo(w.x), bf_hi(w.x), bf_lo(w.y), bf_hi(w.y)}; b = (f32x4){bf_lo(w.z), bf_hi(w.z), bf_lo(w.w), bf_hi(w.w)}; }
template <bool SF32>
__device__ __forceinline__ void norm_rows_b(const bf16* x, const float* xs, const float* g, const float* modl, int jshift, int jscale, bf16* out, int gw, int NGW, int lane,
                                            const bf16* slab, const float* gatep, bf16* xw) {
    if (gw >= M) return;
    int m = gw + ((M - 1 - gw) / NGW) * NGW;
    v4u pn[4];
    if (m < MP) { const bf16* xr = x + (size_t)m * D + lane * 8;
#pragma unroll
        for (int j = 0; j < 4; ++j) pn[j] = *(const v4u*)(xr + 512 * j); }
    int ccur = -1; f32x4 A[4][2], B[4][2];
    while (m >= 0) {
        const int mn = m - NGW;
        f32x4 v[4][2];
        const int cond = m < MP ? 0 : 1 + ((m - MP) >> 10);
        if (m >= MP) {
            const bf16* sp = slab + (size_t)(m - MP) * D + lane * 8; const float* gt = gatep + (size_t)cond * 12288 + lane * 8;
            v4u s[4][4];
            if constexpr (SF32) { const float* xr = xs + (size_t)m * D + lane * 8;
#pragma unroll
                for (int j = 0; j < 4; ++j) { v[j][0] = *(const f32x4*)(xr + 512 * j); v[j][1] = *(const f32x4*)(xr + 512 * j + 4); } }
            else { const bf16* xr = x + (size_t)m * D + lane * 8;
#pragma unroll
                for (int j = 0; j < 4; ++j) { const v4u w = *(const v4u*)(xr + 512 * j); unpack8(w, v[j][0], v[j][1]); } }
#pragma unroll
            for (int k = 0; k < 4; ++k)
#pragma unroll
                for (int j = 0; j < 4; ++j) s[k][j] = *(const v4u*)(sp + (size_t)k * 2048 * 2048 + 512 * j);
            if (mn >= 0 && mn < MP) { const bf16* xr = x + (size_t)mn * D + lane * 8;
#pragma unroll
                for (int j = 0; j < 4; ++j) pn[j] = *(const v4u*)(xr + 512 * j); }
            bf16* wr = xw + (size_t)m * D + lane * 8;
#pragma unroll
            for (int j = 0; j < 4; ++j) {
                f32x4 p0, p1, q0, q1; unpack8(s[0][j], p0, p1); unpack8(s[1][j], q0, q1); p0 += q0; p1 += q1; unpack8(s[2][j], q0, q1); f32x4 r0, r1; unpack8(s[3][j], r0, r1); p0 += q0 + r0; p1 += q1 + r1;
                v[j][0] += *(const f32x4*)(gt + 512 * j) * p0; v[j][1] += *(const f32x4*)(gt + 512 * j + 4) * p1;
                v4u o; o.x = cvtpk(v[j][0].x, v[j][0].y); o.y = cvtpk(v[j][0].z, v[j][0].w); o.z = cvtpk(v[j][1].x, v[j][1].y); o.w = cvtpk(v[j][1].z, v[j][1].w);
                *(v4u*)(wr + 512 * j) = o;
                unpack8(o, v[j][0], v[j][1]);
            }
        } else {
#pragma unroll
            for (int j = 0; j < 4; ++j) unpack8(pn[j], v[j][0], v[j][1]);
            if (mn >= 0) { const bf16* xr = x + (size_t)mn * D + lane * 8;
#pragma unroll
                for (int j = 0; j < 4; ++j) pn[j] = *(const v4u*)(xr + 512 * j); }
        }
        if (cond != ccur) {
            const float* sh = modl + (size_t)cond * 12288 + jshift * 2048 + lane * 8; const float* sc = modl + (size_t)cond * 12288 + jscale * 2048 + lane * 8;
#pragma unroll
            for (int j = 0; j < 4; ++j)
#pragma unroll
                for (int h = 0; h < 2; ++h) { A[j][h] = *(const f32x4*)(g + lane * 8 + 512 * j + 4 * h) * (*(const f32x4*)(sc + 512 * j + 4 * h) + 1.0f); B[j][h] = *(const f32x4*)(sh + 512 * j + 4 * h); }
            ccur = cond;
        }
        float ss = 0.f;
#pragma unroll
        for (int j = 0; j < 4; ++j)
#pragma unroll
            for (int h = 0; h < 2; ++h) ss += (v[j][h].x * v[j][h].x + v[j][h].y * v[j][h].y) + (v[j][h].z * v[j][h].z + v[j][h].w * v[j][h].w);
        const float rstd = 1.0f / sqrtf(wave_sum(ss) * (1.0f / D) + NORM_EPS);
        bf16* orow = out + (size_t)m * D + lane * 8;
#pragma unroll
        for (int j = 0; j < 4; ++j) {
            const f32x4 o0 = v[j][0] * rstd * A[j][0] + B[j][0], o1 = v[j][1] * rstd * A[j][1] + B[j][1];
            v4u w; w.x = cvtpk(o0.x, o0.y); w.y = cvtpk(o0.z, o0.w); w.z = cvtpk(o1.x, o1.y); w.w = cvtpk(o1.z, o1.w);
            *(v4u*)(orow + 512 * j) = w;
        }
        m = mn;
    }
}
__device__ __forceinline__ void final_norm_rows_b(const bf16* x, const float* g, float* out, int gw, int NGW, int lane, const bf16* slab, const float* gate  ) {
    if (gw >= M) return;
    int m = gw + ((M - 1 - gw) / NGW) * NGW;
    v4u pn[4]; f32x4 G8[4][2];
#pragma unroll
    for (int j = 0; j < 4; ++j) { G8[j][0] = *(const f32x4*)(g + lane * 8 + 512 * j); G8[j][1] = *(const f32x4*)(g + lane * 8 + 512 * j + 4); }
    { const bf16* xr = x + (size_t)m * D + lane * 8;
#pragma unroll
      for (int j = 0; j < 4; ++j) pn[j] = *(const v4u*)(xr + 512 * j); }
    while (m >= 0) {
        const int mn = m - NGW;
        f32x4 v[4][2];
#pragma unroll
        for (int j = 0; j < 4; ++j) unpack8(pn[j], v[j][0], v[j][1]);
        if (m >= MP) {
            const int cond = 1 + ((m - MP) >> 10);
            const bf16* sp = slab + (size_t)(m - MP) * D + lane * 8; const float* gt = gate + (size_t)cond * 12288 + lane * 8;
            v4u s[4][4];
#pragma unroll
            for (int k = 0; k < 4; ++k)
#pragma unroll
                for (int j = 0; j < 4; ++j) s[k][j] = *(const v4u*)(sp + (size_t)k * 2048 * 2048 + 512 * j);
            if (mn >= 0) { const bf16* xr = x + (size_t)mn * D + lane * 8;
#pragma unroll
                for (int j = 0; j < 4; ++j) pn[j] = *(const v4u*)(xr + 512 * j); }
#pragma unroll
            for (int j = 0; j < 4; ++j) {
                f32x4 p0, p1, q0, q1; unpack8(s[0][j], p0, p1); unpack8(s[1][j], q0, q1); p0 += q0; p1 += q1; unpack8(s[2][j], q0, q1); f32x4 r0, r1; unpack8(s[3][j], r0, r1); p0 += q0 + r0; p1 += q1 + r1;
                v[j][0] += *(const f32x4*)(gt + 512 * j) * p0; v[j][1] += *(const f32x4*)(gt + 512 * j + 4) * p1;
            }
        } else if (mn >= 0) { const bf16* xr = x + (size_t)mn * D + lane * 8;
#pragma unroll
            for (int j = 0; j < 4; ++j) pn[j] = *(const v4u*)(xr + 512 * j); }
        float ss = 0.f;
#pragma unroll
        for (int j = 0; j < 4; ++j)
#pragma unroll
            for (int h = 0; h < 2; ++h) ss += (v[j][h].x * v[j][h].x + v[j][h].y * v[j][h].y) + (v[j][h].z * v[j][h].z + v[j][h].w * v[j][h].w);
        const float rstd = 1.0f / sqrtf(wave_sum(ss) * (1.0f / D) + NORM_EPS);
        float* orow = out + (size_t)m * D + lane * 8;
#pragma unroll
        for (int j = 0; j < 4; ++j) { *(f32x4*)(orow + 512 * j) = v[j][0] * rstd * G8[j][0]; *(f32x4*)(orow + 512 * j + 4) = v[j][1] * rstd * G8[j][1]; }
        m = mn;
    }
}

__device__ __forceinline__ void load8(const bf16* p, float (&o)[8]) {
    const v4u w = *(const v4u*)p;
    o[0] = bf_lo(w.x); o[1] = bf_hi(w.x); o[2] = bf_lo(w.y); o[3] = bf_hi(w.y); o[4] = bf_lo(w.z); o[5] = bf_hi(w.z); o[6] = bf_lo(w.w); o[7] = bf_hi(w.w);
}
__device__ __forceinline__ void conv_gate_s(const bf16* ups, const float* cw, const float* cb, bf16* act, int gtid, int NGT) {
    constexpr int NCH = FF / 8, RB = 8;
    for (int it = gtid; it < (MS / RB) * NCH; it += NGT) {
        const int rb = it / NCH, ch = it % NCH, f0 = ch * 8, r0 = rb * RB, cg = 256 * (f0 >> 7) + (f0 & 127), cv_ = cg + 128;
        float w0g[8], w1g[8], w2g[8], bg[8], w0v[8], w1v[8], w2v[8], bv[8];
#pragma unroll
        for (int e = 0; e < 8; ++e) { w0g[e] = cw[f0 + e]; w1g[e] = cw[F2 + f0 + e]; w2g[e] = cw[2 * F2 + f0 + e]; bg[e] = cb[f0 + e];
            w0v[e] = cw[FF + f0 + e]; w1v[e] = cw[F2 + FF + f0 + e]; w2v[e] = cw[2 * F2 + FF + f0 + e]; bv[e] = cb[FF + f0 + e]; }
        const int pos0 = r0 & (DSEQ - 1);
        float pg[8], pv[8], cg_[8], cv[8], ng[8], nv[8];
        if (pos0 == 0) {
#pragma unroll
            for (int e = 0; e < 8; ++e) { pg[e] = 0.f; pv[e] = 0.f; }
        } else { load8(ups + (size_t)(r0 - 1) * F2 + cg, pg); load8(ups + (size_t)(r0 - 1) * F2 + cv_, pv); }
        load8(ups + (size_t)r0 * F2 + cg, cg_); load8(ups + (size_t)r0 * F2 + cv_, cv);
#pragma unroll
        for (int i = 0; i < RB; ++i) {
            const int r = r0 + i;
            if (pos0 + i + 1 >= DSEQ) {
#pragma unroll
                for (int e = 0; e < 8; ++e) { ng[e] = 0.f; nv[e] = 0.f; }
            } else { load8(ups + (size_t)(r + 1) * F2 + cg, ng); load8(ups + (size_t)(r + 1) * F2 + cv_, nv); }
            float o[8];
#pragma unroll
            for (int e = 0; e < 8; ++e) {
                const float zg = w0g[e] * pg[e] + w1g[e] * cg_[e] + w2g[e] * ng[e] + bg[e];
                const float zv = w0v[e] * pv[e] + w1v[e] * cv[e] + w2v[e] * nv[e] + bv[e];
                o[e] = zg * __builtin_amdgcn_rcpf(1.0f + __builtin_amdgcn_exp2f(-LOG2E * zg)) * zv;
                pg[e] = cg_[e]; pv[e] = cv[e]; cg_[e] = ng[e]; cv[e] = nv[e];
            }
            v4u w; w.x = pk2(o[0], o[1]); w.y = pk2(o[2], o[3]); w.z = pk2(o[4], o[5]); w.w = pk2(o[6], o[7]);
            *(v4u*)(act + (size_t)(MP + r) * FF + f0) = w;
        }
    }
}

__device__ __forceinline__ f32x16 mfma32(bf16x8 a, bf16x8 b, f32x16 c) { return __builtin_amdgcn_mfma_f32_32x32x16_bf16(a, b, c, 0, 0, 0); }
#define LDSR128(dst, a, off) asm volatile("ds_read_b128 %0, %1 offset:%2" : "=v"(dst) : "v"(a), "n"(off))
#define LDSR32(dst, a) asm volatile("ds_read_b32 %0, %1" : "=v"(dst) : "v"(a))
#define LDS_DRAIN() do { asm volatile("s_waitcnt lgkmcnt(0)" ::: "memory"); __builtin_amdgcn_sched_barrier(0); } while (0)
__device__ __forceinline__ void attn_chunk(const LAS unsigned char* kbuf, const LAS unsigned char* vbuf, const bf16x8 (&qf)[8], f32x16 (&o)[4], float& m_run, float& l_run, int lane,
                                           const LAS float* rpbL, bool WIN, int wq, int drb, int jj, bool attend) {
    const int hi = lane >> 5;
    f32x16 s[2];
#pragma unroll
    for (int r = 0; r < 16; ++r) { s[0][r] = 0.f; s[1][r] = 0.f; }
#pragma unroll
    for (int hb = 0; hb < 2; ++hb) {
        bf16x8 kf[8];
#pragma unroll
        for (int q = 0; q < 8; ++q) kf[q] = *(const LAS bf16x8*)(kbuf + (((q >> 2) * 8 + 4 * hb + (q & 3)) * 64 + lane) * 16);
#pragma unroll
        for (int q = 0; q < 4; ++q) { s[0] = mfma32(kf[q], qf[4 * hb + q], s[0]); s[1] = mfma32(kf[4 + q], qf[4 * hb + q], s[1]); }
        __builtin_amdgcn_sched_group_barrier(0x100, 8, 0);
        __builtin_amdgcn_sched_group_barrier(0x008, 8, 0);
    }
    if (WIN) {
        const int cs = attend ? min(max(wq - 8, 0), 48) : 4096;
        const LAS float* tl = rpbL + (attend ? (drb + jj + 7) * 31 + 15 : 15) + (4 * hi - wq);
        const int lo = 4 * hi - cs;
#pragma unroll
        for (int kb = 0; kb < 2; ++kb) {
            float bv[16];
#pragma unroll
            for (int r = 0; r < 16; ++r) bv[r] = tl[32 * kb + (r & 3) + 8 * (r >> 2)];
#pragma unroll
            for (int r = 0; r < 16; ++r) {
                const bool ok = (unsigned)(32 * kb + (r & 3) + 8 * (r >> 2) + lo) < 16u;
                s[kb][r] = ok ? s[kb][r] + bv[r] : -1e30f;
            }
        }
    }
    float mx = s[0][0];
#pragma unroll
    for (int kb = 0; kb < 2; ++kb)
#pragma unroll
        for (int r = 0; r < 16; ++r) mx = fmaxf(mx, s[kb][r]);
    mx = fmaxf(mx, __shfl_xor(mx, 32));
    const float m_new = fmaxf(m_run, mx);
    const float alpha = __builtin_amdgcn_exp2f(m_run - m_new);
    m_run = m_new;
    float ls = 0.f;
#pragma unroll
    for (int kb = 0; kb < 2; ++kb)
#pragma unroll
        for (int r = 0; r < 16; ++r) { const float p = __builtin_amdgcn_exp2f(s[kb][r] - m_new); s[kb][r] = p; ls += p; }
    l_run = l_run * alpha + ls;
#pragma unroll
    for (int db = 0; db < 4; ++db)
#pragma unroll
        for (int r = 0; r < 16; ++r) o[db][r] *= alpha;
#pragma unroll
    for (int kb = 0; kb < 2; ++kb) {
        bf16x8 vf[8];
#pragma unroll
        for (int i = 0; i < 8; ++i) vf[i] = *(const LAS bf16x8*)(vbuf + ((kb * 8 + i) * 64 + lane) * 16);
        bf16x8 pf[2];
#pragma unroll
        for (int s2 = 0; s2 < 2; ++s2) {
            v4u pw; pw.x = cvtpk(s[kb][8 * s2 + 0], s[kb][8 * s2 + 1]); pw.y = cvtpk(s[kb][8 * s2 + 2], s[kb][8 * s2 + 3]); pw.z = cvtpk(s[kb][8 * s2 + 4], s[kb][8 * s2 + 5]); pw.w = cvtpk(s[kb][8 * s2 + 6], s[kb][8 * s2 + 7]);
            pf[s2] = __builtin_bit_cast(bf16x8, pw); }
#pragma unroll
        for (int s2 = 0; s2 < 2; ++s2)
#pragma unroll
            for (int db = 0; db < 4; ++db) o[db] = mfma32(vf[s2 * 4 + db], pf[s2], o[db]);
        __builtin_amdgcn_sched_group_barrier(0x100, 8, 0);
        __builtin_amdgcn_sched_group_barrier(0x008, 8, 0);
    }
}
__device__ __forceinline__ void attn_store(const f32x16 (&o)[4], float l_run, bf16* Obase, LAS unsigned char* stg, int lane) {
    const int hi = lane >> 5, r32 = lane & 31;
    const float lt = l_run + __shfl_xor(l_run, 32);
    const float inv = 1.0f / lt;
#pragma unroll
    for (int db = 0; db < 4; ++db)
#pragma unroll
        for (int rg = 0; rg < 4; ++rg) {
            u32x2 w; w.x = cvtpk(o[db][4 * rg + 0] * inv, o[db][4 * rg + 1] * inv); w.y = cvtpk(o[db][4 * rg + 2] * inv, o[db][4 * rg + 3] * inv);
            *(LAS u32x2*)(stg + r32 * 272 + (32 * db + 8 * rg + 4 * hi) * 2) = w;
        }
    asm volatile("s_waitcnt lgkmcnt(0)" ::: "memory");
#pragma unroll
    for (int i = 0; i < 8; ++i) {
        const int row = (lane >> 4) + 4 * i, c16 = lane & 15;
        const v4u w = *(const LAS v4u*)(stg + row * 272 + c16 * 16);
        *(v4u*)(Obase + (size_t)row * D + c16 * 8) = w;
    }
}
__device__ __forceinline__ void attn_issue(LAS unsigned char* buf, const bf16* Kc, const bf16* Vc, int wave, int lane) {
    const unsigned lo = (unsigned)((2 * wave * 64 + lane) * 16);
    const char* kb = (const char*)Kc; const char* vb = (const char*)Vc;
#pragma unroll
    for (int i = 0; i < 2; ++i) {
        __builtin_amdgcn_global_load_lds((const unsigned*)(kb + lo + i * 1024), (LAS unsigned*)(buf + (2 * wave + i) * 1024), 16, 0, 0);
        __builtin_amdgcn_global_load_lds((const unsigned*)(vb + lo + i * 1024), (LAS unsigned*)(buf + 16384 + (2 * wave + i) * 1024), 16, 0, 0);
    }
}
#define ATTN_WAIT_BAR(n) asm volatile("s_waitcnt vmcnt(" #n ") lgkmcnt(0)\n\ts_barrier" ::: "memory")
__device__ __forceinline__ void attn_wait_bar(int ahead) {
    if (ahead >= 3) ATTN_WAIT_BAR(12); else if (ahead == 2) ATTN_WAIT_BAR(8); else if (ahead == 1) ATTN_WAIT_BAR(4); else ATTN_WAIT_BAR(0);
}
__device__ __forceinline__ void attn_phase(LAS unsigned char* lds, const bf16* Qb, const bf16* Kf, const bf16* VTf, bf16* Ob, const float* rpb, unsigned* qctr, unsigned char* wsp, int cp_lo, int cp_hi, int tid, int wave, int lane) {
    const int r32 = lane & 31, hi = lane >> 5;
    LAS float* rpbL = (LAS float*)(lds + XCH_OFF);
    volatile LAS int* qslot = (volatile LAS int*)(lds + MISC_OFF) + 16;
    const int nunits = 640 + (cp_hi - cp_lo + 31) / 32;
    int un = (int)blockIdx.x;
    while (un < nunits) {
        int nxt = 0;
        if (tid == 0) nxt = (int)gridDim.x + (int)__hip_atomic_fetch_add(qctr, 1u, __ATOMIC_RELAXED, __HIP_MEMORY_SCOPE_AGENT);
        if (un >= 640) { const int c0 = cp_lo + (un - 640) * 32; p0_weights(lds, wsp, wave, NWAVES, wave, lane, c0, min(c0 + 32, cp_hi)); }
        else {
        const bool lat = un < 128; const int ul = lat ? un : un - 128;
        const int b = lat ? ul >> 6 : ul >> 4, h = lat ? (ul >> 2) & 15 : ul & 15, rg4 = ul & 3;
        const int r = 4 * rg4 + (wave >> 1), wq0 = 32 * (wave & 1), start = min(max(r - 4, 0), 8);
        const int jmin = min(max(4 * rg4 - 4, 0), 8), jmax = min(max(4 * rg4 - 1, 0), 8) + 7;
        const int n0 = lat ? 8 : 4, nch = lat ? 8 + (jmax - jmin + 1) : 4;
        const int qrow = lat ? MP + b * DSEQ + r * 64 + wq0 + r32 : b * SEQ + 32 * wave + r32;
        const size_t base0 = lat ? pg8::seq_base_cache(b, h) : (size_t)(b * 16 + h) * 256 * 128, base1 = pg8::KF_SAMPLE + (size_t)(b * 16 + h) * 1024 * 128 + (size_t)jmin * 8192;
        if (lat) for (int i = tid; i < 465; i += NTHR) rpbL[i] = rpb[h * 465 + i] * LOG2E;
        attn_issue(lds, Kf + base0, VTf + base0, wave, lane);
        bf16x8 qf[8];
#pragma unroll
        for (int st = 0; st < 8; ++st) qf[st] = *(const bf16x8*)(Qb + (size_t)qrow * D + h * HD + 16 * st + 8 * hi);
        attn_issue(lds + 32768, Kf + base0 + 8192, VTf + base0 + 8192, wave, lane);
        attn_issue(lds + 65536, Kf + base0 + 16384, VTf + base0 + 16384, wave, lane);
        f32x16 o[4];
#pragma unroll
        for (int db = 0; db < 4; ++db)
#pragma unroll
            for (int rr = 0; rr < 16; ++rr) o[db][rr] = 0.f;
        float m_run = -1e30f, l_run = 0.f;
#pragma unroll 1
        for (int i = 0; i < nch; ++i) {
            attn_wait_bar(min(nch - 1 - i, 2));
            if (i + 3 < nch) { const int n3 = i + 3; const size_t co = n3 < n0 ? base0 + (size_t)n3 * 8192 : base1 + (size_t)(n3 - n0) * 8192;
                attn_issue(lds + (n3 & 3) * 32768, Kf + co, VTf + co, wave, lane); }
            const LAS unsigned char* kb_ = lds + (i & 3) * 32768;
            const int j = jmin + i - n0;
            attn_chunk(kb_, kb_ + 16384, qf, o, m_run, l_run, lane, rpbL, i >= n0, wq0 + r32, start - r, j - start, j >= start && j < start + 8);
        }
        { const int bl = (nch - 1) & 3, fb = wave / 3, bufi = fb < bl ? fb : fb + 1;
          attn_store(o, l_run, Ob + (size_t)(qrow - r32) * D + h * HD, lds + bufi * 32768 + (wave % 3) * 8704, lane); }
        }
        if (tid == 0) *qslot = nxt;
        ATTN_WAIT_BAR(0);
        un = *qslot;
    }
}

__device__ __forceinline__ void cpow(float are, float aim, float dt, int e, float& pr, float& pi) {
    const float fe = (float)e, mag = __expf(are * dt * fe);
    float ang = aim * dt * fe; const float k = rintf(ang * 0.15915494309189535f);
    ang = fmaf(-k, 6.28318548202514648f, ang); ang = fmaf(-k, -1.74845553146e-7f, ang);
    pr = mag * __cosf(ang); pi = mag * __sinf(ang);
}
__device__ __forceinline__ void s5w_gen(LAS unsigned char* lds, bf16* S5W, int tid, int rank, int nrank) {
    LAS float* pwr = (LAS float*)lds; LAS float* pwi = pwr + 17 * 128; LAS float* bbr = pwi + 17 * 128; LAS float* bbi = bbr + 2048; LAS float* bbTr = bbi + 2048; LAS float* bbTi = bbTr + 2048;
    LAS float* ccTr = bbTi + 2048; LAS float* ccTi = ccTr + 2048; LAS float* KFT = ccTi + 2048; LAS float* pwT = KFT + 31 * 256;
    const float* are = ARG_IN(I_ARE); const float* aim = ARG_IN(I_AIM); const float* ldt = ARG_IN(I_LOGDT); const float* bre = ARG_IN(I_BRE); const float* bim = ARG_IN(I_BIM); const float* cre = ARG_IN(I_CRE); const float* cim = ARG_IN(I_CIM); const float* sd = ARG_IN(I_SD);
    for (int it = rank; it < 2 * NG; it += nrank) {
        const int g = it >> 1, half = it & 1;
        __syncthreads();
        {
            const int sp = tid & 127, dir = sp >> 6, p = sp & 63, eq = tid >> 7;
            const float ar = are[(dir * NG + g) * SP + p], ai = aim[(dir * NG + g) * SP + p], dt = __expf(ldt[dir * NG + g]);
            for (int e = eq; e <= 16; e += 4) { float pr, pi; cpow(ar, ai, dt, e, pr, pi); pwr[e * 128 + sp] = pr; pwi[e * 128 + sp] = pi; if (e < 16) { pwT[sp * 32 + e] = pr; pwT[sp * 32 + 16 + e] = pi; } }
            float a1r, a1i; cpow(ar, ai, dt, 1, a1r, a1i);
            const float den = ar * ar + ai * ai, nr = a1r - 1.0f, ni = a1i;
            const float cfr = (nr * ar + ni * ai) / den, cfi = (ni * ar - nr * ai) / den;
            const f32x4 b4r = *(const f32x4*)(bre + ((size_t)(dir * NG + g) * SP + p) * GC + eq * 4), b4i = *(const f32x4*)(bim + ((size_t)(dir * NG + g) * SP + p) * GC + eq * 4);
#pragma unroll
            for (int q = 0; q < 4; ++q) { const int c = eq * 4 + q; const float vr = cfr * b4r[q] - cfi * b4i[q], vi = cfr * b4i[q] + cfi * b4r[q];
                bbr[sp * 16 + c] = vr; bbi[sp * 16 + c] = vi; bbTr[c * 128 + sp] = vr; bbTi[c * 128 + sp] = vi; }
        }
        for (int i = tid; i < 2048; i += NTHR) { const int dir = i >> 10, c = (i >> 6) & 15, p = i & 63; ccTr[(dir * 64 + p) * 16 + c] = cre[((size_t)(dir * NG + g) * GC) * SP + (i & 1023)]; ccTi[(dir * 64 + p) * 16 + c] = cim[((size_t)(dir * NG + g) * GC) * SP + (i & 1023)]; }
        __syncthreads();
        bf16* W0 = S5W + ((size_t)g * 3 + 0) * 65536; bf16* W1 = W0 + 65536; bf16* W2 = W1 + 65536;
        if (half == 0) {
            for (int i = tid; i < 8192; i += NTHR) {
                const int n = (i >> 10) * 32 + (i & 31), k0 = ((i >> 6) & 15) * 16 + ((i >> 5) & 1) * 8;
                {
                    const int dir = n >> 7, ri = (n >> 6) & 1, p = n & 63, s = k0 >> 4, c0 = k0 & 15, e = dir ? s : 15 - s, sp = dir * 64 + p;
                    const float pr = pwr[e * 128 + sp], pi = pwi[e * 128 + sp]; float v[8];
#pragma unroll
                    for (int q = 0; q < 8; ++q) { const float br = bbTr[(c0 + q) * 128 + sp], bi = bbTi[(c0 + q) * 128 + sp]; v[q] = ri ? (pr * bi + pi * br) : (pr * br - pi * bi); }
                    v4u o; o.x = pk2(v[0], v[1]); o.y = pk2(v[2], v[3]); o.z = pk2(v[4], v[5]); o.w = pk2(v[6], v[7]);
                    *(v4u*)(W0 + (size_t)i * 8) = o;
                }
                {
                    const int t = n >> 4, c = n & 15, dir = k0 >> 7, ri = (k0 >> 6) & 1, p0 = k0 & 63, e = dir ? 16 - t : t + 1; float v[8];
#pragma unroll
                    for (int q = 0; q < 8; ++q) { const int sp = dir * 64 + p0 + q; const float pr = pwr[e * 128 + sp], pi = pwi[e * 128 + sp], cr = ccTr[sp * 16 + c], ci = ccTi[sp * 16 + c];
                        v[q] = ri ? -(cr * pi + ci * pr) : (cr * pr - ci * pi); }
                    v4u o; o.x = pk2(v[0], v[1]); o.y = pk2(v[2], v[3]); o.z = pk2(v[4], v[5]); o.w = pk2(v[6], v[7]);
                    *(v4u*)(W1 + (size_t)i * 8) = o;
                }
            }
        } else {
            {
                const int dir = tid >> 8, c = (tid >> 4) & 15, cp = tid & 15;
                float acc[16];
#pragma unroll
                for (int e = 0; e < 16; ++e) acc[e] = 0.f;
                for (int p = 0; p < 64; ++p) {
                    const int sp = dir * 64 + p;
                    const float cr = ccTr[sp * 16 + c], ci = ccTi[sp * 16 + c], br = bbr[sp * 16 + cp], bi = bbi[sp * 16 + cp];
                    const float zr = cr * br - ci * bi, zi = cr * bi + ci * br;
                    f32x4 pr4[4], pi4[4];
#pragma unroll
                    for (int q = 0; q < 4; ++q) { pr4[q] = *(const LAS f32x4*)(pwT + sp * 32 + 4 * q); pi4[q] = *(const LAS f32x4*)(pwT + sp * 32 + 16 + 4 * q); }
#pragma unroll
                    for (int e = 0; e < 16; ++e) acc[e] += zr * pr4[e >> 2][e & 3] - zi * pi4[e >> 2][e & 3];
                }
                if (dir == 0) {
#pragma unroll
                    for (int e = 1; e < 16; ++e) KFT[((15 + e) * 16 + cp) * 16 + c] = acc[e];
                    KFT[(15 * 16 + cp) * 16 + c] = acc[0] + (c == cp ? sd[g * 16 + c] : 0.f);
                } else {
#pragma unroll
                    for (int e = 1; e < 16; ++e) KFT[((15 - e) * 16 + cp) * 16 + c] = acc[e];
                }
                __syncthreads();
                if (dir == 1) KFT[(15 * 16 + cp) * 16 + c] += acc[0];
            }
            __syncthreads();
            for (int i = tid; i < 31 * 256; i += NTHR) {
                const int tau = i >> 8, c = (i >> 4) & 15, cp = i & 15;
                W2[i] = (bf16)f2bf(KFT[(tau * 16 + cp) * 16 + c]);
            }
        }
    }
}
constexpr int S5_SL_OFF = 0, S5_HIN_OFF = 65536, S5_UT_OFF = 98304;
#define LDS_BAR() asm volatile("s_waitcnt lgkmcnt(0)\n\ts_barrier" ::: "memory")
__device__ __forceinline__ void s5_phase(LAS unsigned char* lds, const bf16* U, const bf16* S5W, bf16* Y, float* out, int tid, int wave, int lane) {
    LAS float* Sl = (LAS float*)(lds + S5_SL_OFF); LAS bf16* Hin = (LAS bf16*)(lds + S5_HIN_OFF); const LAS unsigned char* Ut = lds + S5_UT_OFF;
    const int r32 = lane & 31, hi = lane >> 5;
    int gcur = -1; float a16r = 0.f, a16i = 0.f;
    bf16x8 bA[16], bB[16];
    if ((int)blockIdx.x < NG * 10) { const bf16* U0 = U + ((size_t)(((int)blockIdx.x & 127) * 10 + ((int)blockIdx.x >> 7)) * 2 * 16 * 64) * 8;
#pragma unroll
        for (int i = 0; i < 4; ++i) { const int piece = 4 * wave + i; __builtin_amdgcn_global_load_lds((const unsigned*)(U0 + (piece * 64 + lane) * 8), (LAS unsigned*)(lds + S5_UT_OFF + piece * 1024), 16, 0, 0); } }
    for (int un = blockIdx.x; un < NG * 10; un += gridDim.x) {
        const int g = un & 127, rb = un >> 7;
        if (g != gcur) { const int dir = (tid >> 6) & 1, p = tid & 63; const float ar = ARG_IN(I_ARE)[(dir * NG + g) * SP + p], ai = ARG_IN(I_AIM)[(dir * NG + g) * SP + p], dt = __expf(ARG_IN(I_LOGDT)[dir * NG + g]);
            cpow(ar, ai, dt, 16, a16r, a16i); gcur = g;
            LDS_BAR();
            { const bf16* kfg = S5W + ((size_t)g * 3 + 2) * 65536; for (int i = tid; i < 31 * 256 / 8; i += NTHR) *(LAS v4u*)(lds + KFB_OFF + i * 16) = *(const v4u*)(kfg + i * 8); }
            { const bf16* WSt = S5W + ((size_t)g * 3 + 0) * 65536 + ((size_t)(wave * 16) * 64 + lane) * 8;
#pragma unroll
              for (int st = 0; st < 16; ++st) { bA[st] = *(const bf16x8*)(WSt + 512 * st); bB[st] = *(const bf16x8*)(WSt + 65536 + 512 * st); } } }
        const int tok0 = rb * 1024;
        if (un == (int)blockIdx.x) asm volatile("s_waitcnt vmcnt(0)" ::: "memory"); else asm volatile("s_waitcnt vmcnt(4)" ::: "memory");
        LDS_BAR();
        {
            f32x16 acc[2];
#pragma unroll
            for (int mb = 0; mb < 2; ++mb)
#pragma unroll
                for (int r = 0; r < 16; ++r) acc[mb][r] = 0.f;
#pragma unroll
            for (int s2 = 0; s2 < 8; ++s2) {
                bf16x8 af[4];
#pragma unroll
                for (int i = 0; i < 4; ++i) af[i] = *(const LAS bf16x8*)(Ut + (((i & 1) * 16 + 2 * s2 + (i >> 1)) * 64 + lane) * 16);
#pragma unroll
                for (int i = 0; i < 4; ++i) acc[i & 1] = mfma32(af[i], bA[2 * s2 + (i >> 1)], acc[i & 1]);
                __builtin_amdgcn_sched_group_barrier(0x100, 4, 0); __builtin_amdgcn_sched_group_barrier(0x008, 4, 0);
            }
#pragma unroll
            for (int mb = 0; mb < 2; ++mb)
#pragma unroll
                for (int r = 0; r < 16; ++r) Sl[(32 * mb + (r & 3) + 8 * (r >> 2) + 4 * hi) * 256 + 32 * wave + r32] = acc[mb][r];
        }
        LDS_BAR();
        {
            const bool prompt = rb < 8;
            const int dir = (tid >> 6) & 1, p = tid & 63, bi = tid >> 7;
            if (prompt || tid < 128) {
                float hr = 0.f, hi_ = 0.f; const int nc = prompt ? 16 : 64, row0 = prompt ? bi * 16 : 0;
                if (!prompt) { const size_t si = ((size_t)((rb - 8) * 2 + dir) * NG + g) * SP + p; hr = ARG_IN(I_SRE)[si]; hi_ = ARG_IN(I_SIM)[si]; }
                const int cre_ = dir * 128 + p, cim_ = dir * 128 + 64 + p;
                const int hre = (cre_ >> 4) * 512 + ((cre_ >> 3) & 1) * 256 + (cre_ & 7), him = (cim_ >> 4) * 512 + ((cim_ >> 3) & 1) * 256 + (cim_ & 7);
                for (int c = 0; c < nc; ++c) {
                    const int row = row0 + (dir ? nc - 1 - c : c), ro = (row >> 5) * 8192 + (row & 31) * 8;
                    Hin[ro + hre] = (bf16)f2bf(hr); Hin[ro + him] = (bf16)f2bf(hi_);
                    const float sr = Sl[row * 256 + cre_], si = Sl[row * 256 + cim_];
                    const float nr = a16r * hr - a16i * hi_ + sr, ni = a16r * hi_ + a16i * hr + si;
                    hr = nr; hi_ = ni;
                }
                if (prompt) { const size_t so = ((size_t)((rb * 4 + bi) * 2 + dir) * NG + g) * SP + p; out[O_SRE + so] = hr; out[O_SIM + so] = hi_; }
            }
        }
        LDS_BAR();
#ifndef S5REP3
#define S5REP3 0
#endif
#pragma unroll
        for (int rp3_ = 0; rp3_ <= S5REP3; ++rp3_) {
            f32x16 acc[2];
#pragma unroll
            for (int mb = 0; mb < 2; ++mb)
#pragma unroll
                for (int r = 0; r < 16; ++r) acc[mb][r] = 0.f;
            const LAS unsigned char* kfl = lds + KFB_OFF + (((2 * wave + (r32 >> 4) + 15) * 256 + (lane & 15) * 16 + 8 * hi) * 2);
#pragma unroll
            for (int s2 = 0; s2 < 8; ++s2) {
                bf16x8 af[4], kf[2];
#pragma unroll
                for (int i = 0; i < 2; ++i) kf[i] = *(const LAS bf16x8*)(kfl - (2 * s2 + i) * 512);
#pragma unroll
                for (int i = 0; i < 4; ++i) af[i] = *(const LAS bf16x8*)(Ut + (((i & 1) * 16 + 2 * s2 + (i >> 1)) * 64 + lane) * 16);
#pragma unroll
                for (int i = 0; i < 4; ++i) acc[i & 1] = mfma32(af[i], kf[i >> 1], acc[i & 1]);
                __builtin_amdgcn_sched_group_barrier(0x100, 6, 0); __builtin_amdgcn_sched_group_barrier(0x008, 4, 0);
            }
            LDS_BAR();
            { const int un1 = un + (int)gridDim.x;
              if (un1 < NG * 10) { const bf16* U1 = U + ((size_t)((un1 & 127) * 10 + (un1 >> 7)) * 2 * 16 * 64) * 8;
#pragma unroll
                for (int i = 0; i < 4; ++i) { const int piece = 4 * wave + i; __builtin_amdgcn_global_load_lds((const unsigned*)(U1 + (piece * 64 + lane) * 8), (LAS unsigned*)(lds + S5_UT_OFF + piece * 1024), 16, 0, 0); } } }
#pragma unroll
            for (int s2 = 0; s2 < 8; ++s2) {
                bf16x8 af[4];
#pragma unroll
                for (int i = 0; i < 4; ++i) af[i] = *(const LAS bf16x8*)(Hin + (((i & 1) * 16 + 2 * s2 + (i >> 1)) * 64 + lane) * 8);
#pragma unroll
                for (int i = 0; i < 4; ++i) acc[i & 1] = mfma32(af[i], bB[2 * s2 + (i >> 1)], acc[i & 1]);
                __builtin_amdgcn_sched_group_barrier(0x100, 4, 0); __builtin_amdgcn_sched_group_barrier(0x008, 4, 0);
            }
            const int t = 2 * wave + (r32 >> 4), c = lane & 15;
            LAS bf16* Yt = (LAS bf16*)(lds + S5_SL_OFF);
#pragma unroll
            for (int mb = 0; mb < 2; ++mb)
#pragma unroll
                for (int r = 0; r < 16; ++r) { const int row = 32 * mb + (r & 3) + 8 * (r >> 2) + 4 * hi; Yt[(row * 16 + t) * 16 + c] = (bf16)f2bf(gelu_tanh(acc[mb][r])); }
        }
        LDS_BAR();
#pragma unroll
        for (int i = 0; i < 4; ++i) { const int p = tid + NTHR * i, tok = p >> 1, hf = p & 1;
            *(v4u*)(Y + (size_t)(tok0 + tok) * D + g * 16 + hf * 8) = *(const LAS v4u*)(lds + S5_SL_OFF + p * 16); }
    }
}
#ifndef DBG_CHECKS
#define DBG_CHECKS 0
#endif
#ifndef XB16
#define XB16 1
#endif
constexpr int N_PHASES = 19;
struct Args { const float* in[N_IN]; float* out; unsigned char* ws; int ph_lo, ph_hi, use_bar, pad; };
__global__ void __launch_bounds__(NTHR, 2) mega_fwd(Args args) {
    extern __shared__ __attribute__((aligned(16))) unsigned char lds_raw[];
    LAS unsigned char* lds = (LAS unsigned char*)lds_raw;
    { const int t0 = threadIdx.x; for (int u = t0; u < (LDS_BYTES - LDSCTL_OFF) / 4; u += NTHR) ((LAS unsigned*)(lds + LDSCTL_OFF))[u] = 0u; }
    __syncthreads();
    if (ARG_I32(2)) (void)xcd_barrier_post((unsigned*)((gu32*)(ARG_WS() + WS_CTL) + CW_BAR), (volatile LAS unsigned*)(lds + MISC_OFF) + 8);
#define PH_IDS() int tid = threadIdx.x; asm volatile("" : "+v"(tid)); int bid = blockIdx.x, G = gridDim.x; asm volatile("" : "+s"(bid), "+s"(G)); LAS unsigned char* lds_p = lds; asm volatile("" : "+s"(lds_p)); const int lane = tid & 63, wave = __builtin_amdgcn_readfirstlane(tid >> 6); \
    const int gw = bid * NWAVES + wave, NGW = G * NWAVES, gtid = bid * NTHR + tid, NGT = G * NTHR; (void)lane; (void)gw; (void)NGW; (void)gtid; (void)NGT; (void)G
#define ws ARG_WS()
#define out ARG_OUT()
#define mod ((float*)(ARG_WS() + WS_MOD))
#define HB ((bf16*)(ARG_WS() + WS_HB))
#define X1 ((float*)(ARG_WS() + WS_X1))
#define X1B ((bf16*)(ARG_WS() + WS_X1))
#define SLABB ((bf16*)(ARG_WS() + WS_SLAB))
#define IN(k) (ARG_I32(0) <= (k) && (k) < ARG_I32(1))
#define SEAM(k) do { if (IN(k) && IN((k) + 1)) { XcdBarrier bar_; bar_.bar = (unsigned*)((gu32*)(ARG_WS() + WS_CTL) + CW_BAR); bar_.x = xb_xcc_id(); bar_.st = (volatile LAS unsigned*)(lds + MISC_OFF) + 8; xcd_barrier(bar_); } } while (0)
#ifndef DEFER_P0
#define DEFER_P0 1
#endif
#ifndef DEFER_GO
#define DEFER_GO 1
#endif
#ifndef DEFER_UP0
#define DEFER_UP0 1
#endif
#ifndef DEFER_UP1
#define DEFER_UP1 1
#endif
#ifndef REP_MASK
#define REP_MASK 0
#endif
#define REPL(k) for (int rep_ = 0; rep_ <= (((unsigned)REP_MASK >> (k)) & 1); ++rep_)
#define xs_off (ARG_IN(I_XS) - (size_t)MP * D)

    if (IN(0)) { PH_IDS();
        p0_ada(lds_p, ARG_IN(I_ADAW), ARG_IN(I_ADAB), ARG_IN(I_CCTX), ARG_IN(I_C), mod, tid, wave, lane);
        const bool defer = DEFER_P0 && G == 256;
        p0_weights(lds_p, ws, gw, NGW, wave, lane, 0, 6144);
        p0_weights(lds_p, ws, gw, NGW, wave, lane, defer ? 8192 : 6144, (defer && DEFER_UP0) ? (DEFER_GO ? 10240 : 14336) : 25344);
        if (!defer) p0_weights(lds_p, ws, gw, NGW, wave, lane, 25344, 47360);
        else if (!DEFER_UP1) { p0_weights(lds_p, ws, gw, NGW, wave, lane, 25344, 36352); p0_weights(lds_p, ws, gw, NGW, wave, lane, 41856, 47360); }
        p0_cache(ARG_IN(I_CK), ARG_IN(I_CV), (bf16*)(ws + WS_KF), (bf16*)(ws + WS_VTF), gtid, NGT);
    }
    SEAM(0);
#pragma unroll
    for (int l = 0; l < 2; ++l) {
        const int pb = l == 0 ? 1 : 9;
        const float* modl = mod + (size_t)l * 3 * 12288;
        if (IN(pb)) { PH_IDS();
            if (l == 0) REPL(1) norm_rows(ARG_IN(I_XP), xs_off, ARG_IN(I_N1G), modl, 0, 1, HB, gw, NGW, lane);
#if XB16
            else norm_rows_b<false>(X1B, nullptr, ARG_IN(I_N1G) + D, modl, 0, 1, HB, gw, NGW, lane, SLABB, mod + 5 * 2048, X1B);
#else
            else norm_rows(X1, X1, ARG_IN(I_N1G) + D, modl, 0, 1, HB, gw, NGW, lane, (const float*)(ws + WS_SLAB), mod + 5 * 2048, X1);
#endif
            if (l == 1 && G <= 64) s5w_gen(lds_p, (bf16*)(ws + WS_S5W), tid, bid, G);
        }
        SEAM(pb);
        if (l == 0) {
            if (IN(2)) { PH_IDS();
                pg8::Gemm g{HB, (const bf16*)(ws + WS_WQKV), M, 3 * D, D}; pg8::StaticOrder S; S.init(M, 3 * D, G, bid);
                pg8::EpiQKV E{(bf16*)(ws + WS_Q), (bf16*)(ws + WS_KF), (bf16*)(ws + WS_VTF), out + O_NK, out + O_NV, C2};
#if defined(PROBE_NULLEPI) && PROBE_NULLEPI == 2
                if (ARG_I32(3)) { pg8::EpiQKV E2{(bf16*)(ws + WS_Q), (bf16*)(ws + WS_KF), (bf16*)(ws + WS_VTF), (float*)(ws + WS_ACT), (float*)(ws + WS_ACT) + (size_t)8192 * 2048, C2}; pg8::gemm_phase<pg8::EpiQKV, pg8::StaticOrder, true, true>(lds_p, g, S, E2, tid); } else
#elif defined(PROBE_NULLEPI)
                if (ARG_I32(3)) { pg8::EpiNull EN; pg8::gemm_phase<pg8::EpiNull, pg8::StaticOrder, true, true>(lds_p, g, S, EN, tid); } else
#endif
                pg8::gemm_phase<pg8::EpiQKV, pg8::StaticOrder, true, true>(lds_p, g, S, E, tid);
                if (DEFER_P0 && G == 256 && bid >= 192) p0_weights(lds_p, ws, (bid - 192) * NWAVES + wave, 64 * NWAVES, wave, lane, 6144, 8192); if (DEFER_P0 && DEFER_UP0 && G == 256 && bid >= 192) p0_weights(lds_p, ws, (bid - 192) * NWAVES + wave, 64 * NWAVES, wave, lane, 14336, 18006);
            }
            SEAM(2);
            if (IN(3)) { PH_IDS(); REPL(3) attn_phase(lds_p, (const bf16*)(ws + WS_Q), (const bf16*)(ws + WS_KF), (const bf16*)(ws + WS_VTF), (bf16*)(ws + WS_O), ARG_IN(I_RPB), (unsigned*)((gu32*)(ws + WS_CTL) + 16384), ws, (DEFER_P0 && DEFER_UP0 && G == 256) ? 18006 : 25344, 25344, tid, wave, lane); }
            SEAM(3);
            if (IN(4)) { PH_IDS();
                pg8::Gemm g{(const bf16*)(ws + WS_O), (const bf16*)(ws + WS_WO), M, D, D}; pg8::TailOrder S; S.init(D, G, bid);
#if XB16
                pg8::EpiRes3<true> E{ARG_IN(I_XP), (pg8::bf16_t*)X1B, modl + 2 * 2048, (pg8::bf16_t*)SLABB};
                pg8::gemm_phase<pg8::EpiRes3<true>, pg8::TailOrder, true, true>(lds_p, g, S, E, tid);
#else
                pg8::EpiRes2 E{ARG_IN(I_XP), X1, modl + 2 * 2048, (float*)(ws + WS_SLAB)};
                pg8::gemm_phase<pg8::EpiRes2, pg8::TailOrder, true, true>(lds_p, g, S, E, tid);
#endif
            }
            SEAM(4);
        } else {
            if (IN(10)) { PH_IDS();
                pg8::Gemm g{HB, (const bf16*)(ws + WS_WIN), M, D, D}; pg8::StaticOrder S; S.init(M, D, G, bid);
                pg8::EpiU E{(bf16*)(ws + WS_U)};
                pg8::gemm_phase<pg8::EpiU, pg8::StaticOrder, true, true>(lds_p, g, S, E, tid);
                if (G > 64 && bid >= 64) { s5w_gen(lds_p, (bf16*)(ws + WS_S5W), tid, bid - 64, G - 64);
                    if (DEFER_P0 && DEFER_UP0 && DEFER_GO && G == 256) { __syncthreads(); p0_weights(lds_p, ws, (bid - 64) * NWAVES + wave, 192 * NWAVES, wave, lane, 10240, 14336); } }
            }
            SEAM(10);
            if (IN(11)) { PH_IDS(); REPL(11) s5_phase(lds_p, (const bf16*)(ws + WS_U), (const bf16*)(ws + WS_S5W), (bf16*)(ws + WS_Y), out, tid, wave, lane); }
            SEAM(11);
            if (IN(12)) { PH_IDS();
                pg8::Gemm g{(const bf16*)(ws + WS_Y), (const bf16*)(ws + WS_WGATE), M, D, D}; pg8::StaticOrder S; S.init(M, D, G, bid);
                pg8::EpiGate E{(const bf16*)(ws + WS_Y), (bf16*)(ws + WS_Y2)};
                pg8::gemm_phase<pg8::EpiGate, pg8::StaticOrder, true, true>(lds_p, g, S, E, tid);
                if (DEFER_P0 && DEFER_UP1 && G == 256 && bid >= 64) { const int sw = (bid - 64) * NWAVES + wave;
                    p0_weights(lds_p, ws, sw, 192 * NWAVES, wave, lane, 25344, 36352); p0_weights(lds_p, ws, sw, 192 * NWAVES, wave, lane, 41856, 44608); }
            }
            SEAM(12);
            if (IN(13)) { PH_IDS();
                pg8::Gemm g{(const bf16*)(ws + WS_Y2), (const bf16*)(ws + WS_WOUT), M, D, D}; pg8::TailOrder S; S.init(D, G, bid);
#if XB16
                pg8::EpiRes3<false> E{X1B, (pg8::bf16_t*)X1B, modl + 2 * 2048, (pg8::bf16_t*)SLABB};
                pg8::gemm_phase<pg8::EpiRes3<false>, pg8::TailOrder, true, true>(lds_p, g, S, E, tid);
#else
                pg8::EpiRes2 E{X1, X1, modl + 2 * 2048, (float*)(ws + WS_SLAB)};
                pg8::gemm_phase<pg8::EpiRes2, pg8::TailOrder, true, true>(lds_p, g, S, E, tid);
#endif
            }
            SEAM(13);
        }
        const int fb = l == 0 ? 5 : 14;
#if XB16
        if (IN(fb)) { PH_IDS();
            if (l == 0) norm_rows_b<true>(X1B, xs_off, ARG_IN(I_N2G), modl, 3, 4, HB, gw, NGW, lane, SLABB, modl + 2 * 2048, X1B);
            else norm_rows_b<false>(X1B, nullptr, ARG_IN(I_N2G) + D, modl, 3, 4, HB, gw, NGW, lane, SLABB, modl + 2 * 2048, X1B); }
#else
        if (IN(fb)) { PH_IDS(); norm_rows(X1, l == 0 ? xs_off : X1, ARG_IN(I_N2G) + l * D, modl, 3, 4, HB, gw, NGW, lane, (const float*)(ws + WS_SLAB), modl + 2 * 2048, X1); }
#endif
        SEAM(fb);
        if (IN(fb + 1)) { PH_IDS();
            pg8::Gemm g{HB, (const bf16*)(ws + (l == 0 ? WS_WUP0 : WS_WUP1)), M, F2, D}; pg8::UpOrder S; S.init(G, bid);
            pg8::EpiConv E{(bf16*)(ws + WS_ACT), ARG_IN(I_CONVW) + (size_t)l * 3 * F2, ARG_IN(I_CONVB) + (size_t)l * F2, (LAS float*)(lds_p + XCH_OFF)};
#ifdef PROBE_NULLEPI
            if (ARG_I32(3)) { pg8::EpiNull EN; pg8::gemm_phase<pg8::EpiNull, pg8::UpOrder, true, true>(lds_p, g, S, EN, tid); } else
#endif
            pg8::gemm_phase<pg8::EpiConv, pg8::UpOrder, true, true>(lds_p, g, S, E, tid);
            if (DEFER_P0 && G == 256 && bid >= 184) { if (l == 0) p0_weights(lds_p, ws, (bid - 184) * NWAVES + wave, 72 * NWAVES, wave, lane, 36352, 41856); else if (DEFER_UP1) p0_weights(lds_p, ws, (bid - 184) * NWAVES + wave, 72 * NWAVES, wave, lane, 44608, 47360); }
        }
        do { if (IN(fb + 1) && (IN(fb + 2) || IN(fb + 3))) { XcdBarrier bar_; bar_.bar = (unsigned*)((gu32*)(ARG_WS() + WS_CTL) + CW_BAR); bar_.x = xb_xcc_id(); bar_.st = (volatile LAS unsigned*)(lds + MISC_OFF) + 8; xcd_barrier(bar_); } } while (0);
        if (IN(fb + 3)) { PH_IDS();
            pg8::Gemm g{(const bf16*)(ws + WS_ACT), (const bf16*)(ws + (l == 0 ? WS_WDN0 : WS_WDN1)), M, D, FF}; pg8::TailOrder S; S.init(FF, G, bid);
#if XB16
            pg8::EpiRes3<false> E{X1B, (pg8::bf16_t*)X1B, modl + 5 * 2048, (pg8::bf16_t*)SLABB};
#ifdef PROBE_NULLEPI
            if (ARG_I32(3)) { pg8::EpiNull EN; pg8::gemm_phase<pg8::EpiNull, pg8::TailOrder, true, true>(lds_p, g, S, EN, tid); } else
#endif
            pg8::gemm_phase<pg8::EpiRes3<false>, pg8::TailOrder, true, true>(lds_p, g, S, E, tid);
#else
            pg8::EpiRes2 E{X1, X1, modl + 5 * 2048, (float*)(ws + WS_SLAB)};
            pg8::gemm_phase<pg8::EpiRes2, pg8::TailOrder, true, true>(lds_p, g, S, E, tid);
#endif
        }
        SEAM(fb + 3);
    }
#if XB16
    if (IN(18)) { PH_IDS(); final_norm_rows_b(X1B, ARG_IN(I_FG), out + O_Y, gw, NGW, lane, SLABB, mod + (size_t)3 * 12288 + 5 * 2048); }
#else
    if (IN(18)) { PH_IDS(); REPL(18) final_norm_rows(X1, ARG_IN(I_FG), out + O_Y, gw, NGW, lane, (const float*)(ws + WS_SLAB), mod + (size_t)3 * 12288 + 5 * 2048); }
#endif
#ifdef PROBE_COPY
    if (IN(19)) { PH_IDS(); p0_weights(lds_p, ws, gw, NGW, wave, lane, 0, 47360); }
#endif
#undef IN
#undef SEAM
#undef ws
#undef out
#undef mod
#undef HB
#undef X1
#undef X1B
#undef SLABB
#undef xs_off
}
#if DBG_CHECKS
constexpr size_t WS_XBK = WS_S;
__device__ __forceinline__ unsigned hashu(unsigned x) { x ^= x >> 16; x *= 0x7feb352dU; x ^= x >> 15; x *= 0x846ca68bU; x ^= x >> 16; return x; }
__device__ __forceinline__ float bff(bf16 v) { return __uint_as_float((unsigned)v << 16); }
__device__ __forceinline__ void dacc(float* dbg, int stage, float got, float ref) { const float d = got - ref; atomicAdd(dbg + 2 * stage, d * d); atomicAdd(dbg + 2 * stage + 1, ref * ref); }
__device__ __forceinline__ float dotbf(const bf16* a, const bf16* b, int K) { float s = 0.f; for (int k = 0; k < K; ++k) s += bff(a[k]) * bff(b[k]); return s; }

__global__ void chk_mod(const float* adaw, const float* adab, const float* cctx, const float* cs, const float* mod, float* dbg) {
    const unsigned id = blockIdx.x * blockDim.x + threadIdx.x, hsh = hashu(id * 7919u + 13u);
    const int l = hsh & 1, cond = (hsh >> 1) % 3, n = (hsh >> 8) % 12288;
    const float* cv = cond == 0 ? cctx : cs + (cond - 1) * 2048;
    float s = adab[l * 12288 + n];
    for (int k = 0; k < 2048; ++k) s += silu_f(cv[k]) * adaw[((size_t)l * 2048 + k) * 12288 + n];
    dacc(dbg, 0, mod[(size_t)(l * 3 + cond) * 12288 + n], s);
}
__global__ void chk_wt(const float* W, const bf16* WT, int K, int N, float* dbg, int upw) {
    const unsigned id = blockIdx.x * blockDim.x + threadIdx.x, hsh = hashu(id * 7919u + 17u), h2 = hashu(hsh + 99u);
    const int k = hsh % K, n = h2 % N;
    dacc(dbg, 1, bff(WT[(size_t)(upw ? pg8::upw_row(n) : n) * K + k]), bff((bf16)f2bf(W[(size_t)k * N + n])));
}
__global__ void chk_cache(const float* ck, const float* cv, const bf16* Kf, const bf16* VTf, float* dbg) {
    const unsigned id = blockIdx.x * blockDim.x + threadIdx.x, hsh = hashu(id * 7919u + 19u);
    const int i = hsh % (2 * 512 * 2048), bt = i >> 11, col = i & 2047, b = bt >> 9, t = bt & 511, h = col >> 7, d = col & 127;
    dacc(dbg, 2, bff(Kf[pg8::seq_base_cache(b, h) + pg8::kf_off(t, d)]), ck[i]);
    dacc(dbg, 2, bff(VTf[pg8::seq_base_cache(b, h) + pg8::vtf_off(t, d)]), cv[i]);
}
__global__ void chk_norm(const float* xa, const float* xb, int xb_sub, const float* g, const float* modl, int jshift, int jscale, const bf16* out, float* dbg, int stage) {
    const unsigned id = blockIdx.x * blockDim.x + threadIdx.x, hsh = hashu(id * 7919u + 23u + stage), h2 = hashu(hsh + 5u);
    const int m = hsh % M, n = h2 % D;
    const float* xr = m < MP ? xa + (size_t)m * D : xb + (size_t)(m - xb_sub) * D;
    float ss = 0.f; for (int k = 0; k < D; ++k) ss += xr[k] * xr[k];
    const float rstd = 1.0f / sqrtf(ss / D + NORM_EPS); const int cond = m < MP ? 0 : 1 + ((m - MP) >> 10);
    const float ref = xr[n] * rstd * g[n] * (1.0f + modl[cond * 12288 + jscale * 2048 + n]) + modl[cond * 12288 + jshift * 2048 + n];
    dacc(dbg, stage, bff(out[(size_t)m * D + n]), ref);
}
__global__ void chk_final(const float* x, const float* g, const float* out, float* dbg, int stage) {
    const unsigned id = blockIdx.x * blockDim.x + threadIdx.x, hsh = hashu(id * 7919u + 29u), h2 = hashu(hsh + 5u);
    const int m = hsh % M, n = h2 % D; const float* xr = x + (size_t)m * D;
    float ss = 0.f; for (int k = 0; k < D; ++k) ss += xr[k] * xr[k];
    dacc(dbg, stage, out[(size_t)m * D + n], xr[n] / sqrtf(ss / D + NORM_EPS) * g[n]);
}
__global__ void chk_qkv(const bf16* HB, const bf16* Wt, const bf16* Q, const bf16* Kf, const bf16* VTf, const float* nk, const float* nv, float* dbg) {
    const unsigned id = blockIdx.x * blockDim.x + threadIdx.x, hsh = hashu(id * 7919u + 31u), h2 = hashu(hsh + 5u);
    const int m = hsh % M, n = h2 % (3 * D), sec = n / D, col = n % D, h = col >> 7, d = col & 127;
    const float acc = dotbf(HB + (size_t)m * D, Wt + (size_t)n * D, D);
    int t; const size_t sb = pg8::seq_base_row(m, h, t);
    if (sec == 0) dacc(dbg, 4, bff(Q[(size_t)m * D + col]), acc * C2);
    else if (sec == 1) { dacc(dbg, 4, bff(Kf[sb + pg8::kf_off(t, d)]), acc); if (m < MP) dacc(dbg, 4, nk[(size_t)m * D + col], acc); }
    else { dacc(dbg, 4, bff(VTf[sb + pg8::vtf_off(t, d)]), acc); if (m < MP) dacc(dbg, 4, nv[(size_t)m * D + col], acc); }
}
__device__ __forceinline__ float dotqk(const bf16* q, const bf16* Kf, size_t sb, int t) { float s = 0.f; for (int k = 0; k < HD; ++k) s += bff(q[k]) * bff(Kf[sb + pg8::kf_off(t, k)]); return s; }
__global__ void chk_attn(const bf16* Q, const bf16* Kf, const bf16* VTf, const float* rpb, const bf16* O, float* dbg) {
    const unsigned id = blockIdx.x * blockDim.x + threadIdx.x, hsh = hashu(id * 7919u + 37u), h2 = hashu(hsh + 5u);
    int m = hsh % M; if (id & 1) m = MP + (hsh % MS);
    const int h = h2 & 15, d = (h2 >> 4) & 127;
    const bf16* q = Q + (size_t)m * D + h * HD;
    float mx = -1e30f, l = 0.f, o = 0.f;
    auto step = [&](float lg, float v) { const float mn = fmaxf(mx, lg), a = exp2f(mx - mn), p = exp2f(lg - mn); l = l * a + p; o = o * a + p * v; mx = mn; };
    int tq; const size_t sb = pg8::seq_base_row(m, h, tq);
    if (m < MP) {
        for (int t = 0; t < 256; ++t) step(dotqk(q, Kf, sb, t), bff(VTf[sb + pg8::vtf_off(t, d)]));
    } else { const int b = (m - MP) >> 10, pos = tq, r = pos >> 6, wq = pos & 63, start = min(max(r - 4, 0), 8), cs = min(max(wq - 8, 0), 48);
        for (int j = 0; j < 8; ++j) for (int wk = cs; wk < cs + 16; ++wk) { const int t = (start + j) * 64 + wk;
            step(dotqk(q, Kf, sb, t) + rpb[(h * 15 + (start + j - r + 7)) * 31 + (wk - wq + 15)] * LOG2E, bff(VTf[sb + pg8::vtf_off(t, d)])); }
        const size_t sc = pg8::seq_base_cache(b, h);
        for (int t = 0; t < 512; ++t) step(dotqk(q, Kf, sc, t), bff(VTf[sc + pg8::vtf_off(t, d)]));
    }
    dacc(dbg, 5, bff(O[(size_t)m * D + h * HD + d]), o / l);
}
__global__ void chk_res(const bf16* A, const bf16* Bt, int K, const float* baseP, const float* baseS, int bs_sub, const float* gate, const float* out, float* dbg, int stage) {
    const unsigned id = blockIdx.x * blockDim.x + threadIdx.x, hsh = hashu(id * 7919u + 41u + stage), h2 = hashu(hsh + 5u);
    const int m = hsh % M, n = h2 % D, cond = m < MP ? 0 : 1 + ((m - MP) >> 10);
    const float acc = dotbf(A + (size_t)m * K, Bt + (size_t)n * K, K);
    const float ref = (m < MP ? baseP[(size_t)m * D + n] : baseS[(size_t)(m - bs_sub) * D + n]) + gate[cond * 12288 + n] * acc;
    dacc(dbg, stage, out[(size_t)m * D + n], ref);
}
__global__ void chk_gemm_bf(const bf16* A, const bf16* Bt, int K, int N, const bf16* O, float* dbg, int stage, int ulay) {
    const unsigned id = blockIdx.x * blockDim.x + threadIdx.x, hsh = hashu(id * 7919u + 43u + stage), h2 = hashu(hsh + 5u);
    const int m = hsh % M, n = h2 % N;
    dacc(dbg, stage, bff(O[ulay ? pg8::s5u_off(m, n) : (size_t)m * N + n]), dotbf(A + (size_t)m * K, Bt + (size_t)n * K, K));
}
__global__ void chk_gate(const bf16* Y, const bf16* Bt, const bf16* Y2, float* dbg, int stage) {
    const unsigned id = blockIdx.x * blockDim.x + threadIdx.x, hsh = hashu(id * 7919u + 47u), h2 = hashu(hsh + 5u);
    const int m = hsh % M, n = h2 % D;
    const float z = dotbf(Y + (size_t)m * D, Bt + (size_t)n * D, D);
    dacc(dbg, stage, bff(Y2[(size_t)m * D + n]), bff(Y[(size_t)m * D + n]) / (1.0f + expf(-z)));
}
__global__ void chk_upconv(const bf16* HB, const bf16* WupT, const float* cw, const float* cb, const bf16* act, float* dbg, int stage) {
    const unsigned id = blockIdx.x * blockDim.x + threadIdx.x, hsh = hashu(id * 7919u + 53u + stage), h2 = hashu(hsh + 5u);
    int m = hsh % M; const int f = h2 % FF;
    if ((id & 7) == 0) m = (m & ~255);
    if ((id & 7) == 1) m = (m | 255);
    if ((id & 7) == 2) m = (m & ~63);
    if ((id & 7) == 3) m = (m | 63);
    if ((id & 7) >= 6) m = MP + (hsh % MS);
    const int seqlen = m < MP ? SEQ : DSEQ, pos = m < MP ? (m & 255) : ((m - MP) & 1023);
    float z[2];
    for (int q = 0; q < 2; ++q) { const int c = f + q * FF; const bf16* wrow = WupT + (size_t)pg8::upw_row(c) * D;
        const float a = pos > 0 ? bff((bf16)f2bf(dotbf(HB + (size_t)(m - 1) * D, wrow, D))) : 0.f, b = bff((bf16)f2bf(dotbf(HB + (size_t)m * D, wrow, D))), d = pos + 1 < seqlen ? bff((bf16)f2bf(dotbf(HB + (size_t)(m + 1) * D, wrow, D))) : 0.f;
        z[q] = cw[c] * a + cw[F2 + c] * b + cw[2 * F2 + c] * d + cb[c]; }
    dacc(dbg, stage, bff(act[(size_t)m * FF + f]), z[0] / (1.0f + expf(-z[0])) * z[1]);
}
struct S5P { const float* p[8]; };
__global__ void chk_s5(const bf16* U, S5P inp, const float* sre, const float* sim, const bf16* Y, const float* out, float* dbg, int stage) {
    const float* are = inp.p[0]; const float* aim = inp.p[1]; const float* ldt = inp.p[2]; const float* bre = inp.p[3]; const float* bim = inp.p[4]; const float* cre = inp.p[5]; const float* cim = inp.p[6]; const float* sd = inp.p[7];
    const int wv = (blockIdx.x * blockDim.x + threadIdx.x) >> 6, p = threadIdx.x & 63;
    const unsigned hsh = hashu(wv * 7919u + 59u), h2 = hashu(hsh + 5u);
    const bool stchk = (wv & 3) == 3;
    int m = hsh % M; if (wv & 1) m = MP + (hsh % MS);
    if (stchk) m = hsh % MP;
    const int ch = h2 % D, g = ch >> 4, c = ch & 15;
    const int L = m < MP ? SEQ : DSEQ, tokbase = m < MP ? (m & ~255) : MP + ((m - MP) & ~1023), t = m - tokbase;
    float ysum = 0.f;
    for (int dir = 0; dir < 2; ++dir) {
        const double ar = are[(dir * NG + g) * SP + p], ai = aim[(dir * NG + g) * SP + p], dt = exp((double)ldt[dir * NG + g]);
        const double mag = exp(ar * dt), abr = mag * cos(ai * dt), abi = mag * sin(ai * dt), den = ar * ar + ai * ai, nr = abr - 1.0;
        const double cfr = (nr * ar + abi * ai) / den, cfi = (abi * ar - nr * ai) / den;
        float bbr[16], bbi[16];
#pragma unroll
        for (int q = 0; q < 16; ++q) { const double br = bre[((size_t)(dir * NG + g) * SP + p) * GC + q], bi = bim[((size_t)(dir * NG + g) * SP + p) * GC + q]; bbr[q] = (float)(cfr * br - cfi * bi); bbi[q] = (float)(cfr * bi + cfi * br); }
        float hr = 0.f, hi = 0.f;
        if (m >= MP) { const size_t si = ((size_t)(((m - MP) >> 10) * 2 + dir) * NG + g) * SP + p; hr = sre[si]; hi = sim[si]; }
        const int tend = stchk ? (dir ? 0 : L - 1) : t;
        for (int s = dir ? L - 1 : 0; dir ? s >= tend : s <= tend; s += dir ? -1 : 1) {
            float ur = 0.f, ui = 0.f;
#pragma unroll
            for (int q = 0; q < 16; ++q) { const float u = bff(U[pg8::s5u_off(tokbase + s, g * 16 + q)]); ur += bbr[q] * u; ui += bbi[q] * u; }
            const float n_r = (float)abr * hr - (float)abi * hi + ur, n_i = (float)abr * hi + (float)abi * hr + ui; hr = n_r; hi = n_i;
        }
        if (stchk) { const size_t so = ((size_t)((m >> 8) * 2 + dir) * NG + g) * SP + p; dacc(dbg, stage + 1, out[O_SRE + so], hr); dacc(dbg, stage + 1, out[O_SIM + so], hi); }
        ysum += hr * cre[((size_t)(dir * NG + g) * GC + c) * SP + p] - hi * cim[((size_t)(dir * NG + g) * GC + c) * SP + p];
    }
    if (!stchk) {
        float y = wave_sum(ysum) + sd[ch] * bff(U[pg8::s5u_off(m, ch)]);
        if (p == 0) { const float z = 0.7978845608028654f * (y + 0.044715f * y * y * y); dacc(dbg, stage, bff(Y[(size_t)m * D + ch]), 0.5f * y * (1.0f + tanhf(z))); }
    }
}
constexpr int DBG_NSTAGE = 22;
__device__ const float DBG_TOL[DBG_NSTAGE] = {1e-9f, 1e-12f, 2e-5f, 2e-5f, 2e-5f, 1e-4f, 1e-9f, 2e-5f, 2e-5f, 3e-5f, 1e-9f, 2e-5f, 2e-5f, 3e-4f, 3e-4f, 3e-5f, 1e-9f, 2e-5f, 2e-5f, 3e-5f, 1e-9f, 1e-9f};
__global__ void dbg_report(const float* dbg, float* out, size_t nout, int force_stage) {
    __shared__ float code;
    if (threadIdx.x == 0) {
        float cv = 0.f;
        for (int s = 0; s < DBG_NSTAGE; ++s) {
            const float num = dbg[2 * s], den = dbg[2 * s + 1]; const float r = num / den;
            if (num == 0.f && den == 0.f) continue;
            const bool bad = !(r <= DBG_TOL[s]) || !(den > 0.f);
            if ((force_stage < 0 && bad) || s == force_stage) {
                float lg = (r == r && r > 0.f) ? log10f(r) : (r == 0.f ? -8.f : 3.f); lg = fminf(fmaxf(lg, -8.f), 2.f);
                float mant = 1.0f + (lg + 8.0f) * 0.85f; if (!(r == r) || !(den > 0.f)) mant = 9.9f;
                cv = mant * powf(10.f, (float)(s + 3)); break; }
        }
        code = cv;
    }
    __syncthreads();
    const float cv = code;
    if (cv != 0.f) { for (size_t i = (size_t)blockIdx.x * blockDim.x + threadIdx.x; i < nout; i += (size_t)gridDim.x * blockDim.x) out[i] = (i == 0) ? cv : 0.f; }
}
#endif
#ifndef DBG_CHECKS
#define DBG_CHECKS 0
#endif
#ifndef N_LAUNCHES
#define N_LAUNCHES 1
#endif
#ifndef DBG_FORCE_STAGE
#define DBG_FORCE_STAGE (-1)
#endif
__global__ void err_code_kernel(float* o, float v) { if (threadIdx.x == 0 && blockIdx.x == 0) o[0] = v; }
extern "C" void kernel_launch(void* const* d_in, const int* in_sizes, int n_in, void* d_out, int out_size, void* d_ws, size_t ws_size, hipStream_t stream) {
    static int grid = 0;
    if (grid == 0) {
        size_t need = WS_END;
        if (n_in != N_IN || (size_t)out_size != O_END || ws_size < need) { fprintf(stderr, "kernel_launch: shape mismatch: n_in %d, out %d (want %zu), ws %zu (need %zu); nothing launched\n", n_in, out_size, (size_t)O_END, ws_size, need); grid = -1; return; }
        int dev = 0, cus = 0, per_cu = 0;
        if (hipGetDevice(&dev) != hipSuccess || hipDeviceGetAttribute(&cus, hipDeviceAttributeMultiprocessorCount, dev) != hipSuccess) { fprintf(stderr, "kernel_launch: device query failed\n"); grid = -1; return; }
        if (hipFuncSetAttribute((const void*)mega_fwd, hipFuncAttributeMaxDynamicSharedMemorySize, LDS_BYTES) != hipSuccess) { fprintf(stderr, "kernel_launch: hipFuncSetAttribute failed\n"); grid = -1; return; }
        if (hipOccupancyMaxActiveBlocksPerMultiprocessor(&per_cu, (const void*)mega_fwd, NTHR, LDS_BYTES) != hipSuccess || per_cu < 1) fprintf(stderr, "kernel_launch: note: occupancy query reports %d workgroups per CU\n", per_cu);
        (void)hipGetLastError();
        grid = cus;
    }
    if (grid < 0) { if (out_size > 0) hipLaunchKernelGGL(err_code_kernel, dim3(1), dim3(64), 0, stream, (float*)d_out, 7.7e37f); return; }
    unsigned char* ws = (unsigned char*)d_ws;
    (void)hipMemsetAsync(ws + WS_CTL, 0, CTL_ZERO_BYTES, stream);
    Args a{};
    for (int i = 0; i < N_IN; ++i) a.in[i] = (const float*)d_in[i];
    a.out = (float*)d_out; a.ws = ws;
#if !DBG_CHECKS
    if (N_LAUNCHES == 1) { a.ph_lo = 0; a.ph_hi = N_PHASES; a.use_bar = 1; hipLaunchKernelGGL(mega_fwd, dim3(grid), dim3(NTHR), LDS_BYTES, stream, a); }
    else for (int p = 0; p < N_PHASES; ++p) { a.ph_lo = p; a.ph_hi = p + 1; a.use_bar = 0; hipLaunchKernelGGL(mega_fwd, dim3(grid), dim3(NTHR), LDS_BYTES, stream, a); }
#ifdef PROBE_PHASE
#ifndef PROBE_VARIANT
#define PROBE_VARIANT 0
#endif
    for (int r = 0; r < PROBE_REPS; ++r) { a.ph_lo = PROBE_PHASE; a.ph_hi = PROBE_PHASE + 1; a.use_bar = 0; a.pad = PROBE_VARIANT; hipLaunchKernelGGL(mega_fwd, dim3(grid), dim3(NTHR), LDS_BYTES, stream, a); }
#endif
#ifdef PROBE_COPY
    for (int r = 0; r < PROBE_COPY; ++r) { a.ph_lo = 19; a.ph_hi = 20; a.use_bar = 0; hipLaunchKernelGGL(mega_fwd, dim3(grid), dim3(NTHR), LDS_BYTES, stream, a); }
#endif
#else
    float* dbg = (float*)(ws + WS_DBG); float* out = (float*)d_out; const float* const* in = (const float* const*)a.in;
    float* mod = (float*)(ws + WS_MOD); bf16* HB = (bf16*)(ws + WS_HB); float* X1 = (float*)(ws + WS_X1); float* XBK = (float*)(ws + WS_XBK);
    const dim3 cg(32), cb(256);
    for (int p = 0; p < N_PHASES; ++p) {
        if (p == 8 || p == 13 || p == 17) (void)hipMemcpyAsync(XBK, X1, (size_t)M * D * 4, hipMemcpyDeviceToDevice, stream);
        a.ph_lo = p; a.ph_hi = p + 1; a.use_bar = 0; hipLaunchKernelGGL(mega_fwd, dim3(grid), dim3(NTHR), LDS_BYTES, stream, a);
        const int l = p >= 9 ? 1 : 0; const float* modl = mod + (size_t)l * 3 * 12288;
        switch (p) {
        case 0:
            hipLaunchKernelGGL(chk_mod, cg, cb, 0, stream, a.in[I_ADAW], a.in[I_ADAB], a.in[I_CCTX], a.in[I_C], mod, dbg);
            hipLaunchKernelGGL(chk_wt, cg, cb, 0, stream, a.in[I_WQKV], (const bf16*)(ws + WS_WQKV), D, 3 * D, dbg, 0);
            hipLaunchKernelGGL(chk_wt, cg, cb, 0, stream, a.in[I_WIN], (const bf16*)(ws + WS_WIN), D, D, dbg, 0);
            hipLaunchKernelGGL(chk_wt, cg, cb, 0, stream, a.in[I_WGATE], (const bf16*)(ws + WS_WGATE), D, D, dbg, 0);
            hipLaunchKernelGGL(chk_wt, cg, cb, 0, stream, a.in[I_WOUT], (const bf16*)(ws + WS_WOUT), D, D, dbg, 0);
            hipLaunchKernelGGL(chk_wt, cg, cb, 0, stream, a.in[I_WUP], (const bf16*)(ws + WS_WUP0), D, F2, dbg, 1);
            hipLaunchKernelGGL(chk_cache, cg, cb, 0, stream, a.in[I_CK], a.in[I_CV], (const bf16*)(ws + WS_KF), (const bf16*)(ws + WS_VTF), dbg);
            break;
        case 1: hipLaunchKernelGGL(chk_norm, cg, cb, 0, stream, a.in[I_XP], a.in[I_XS], (int)MP, a.in[I_N1G], modl, 0, 1, (const bf16*)HB, dbg, 3); break;
        case 2: hipLaunchKernelGGL(chk_wt, cg, cb, 0, stream, a.in[I_WO], (const bf16*)(ws + WS_WO), D, D, dbg, 0); hipLaunchKernelGGL(chk_qkv, cg, cb, 0, stream, (const bf16*)HB, (const bf16*)(ws + WS_WQKV), (const bf16*)(ws + WS_Q), (const bf16*)(ws + WS_KF), (const bf16*)(ws + WS_VTF), (const float*)(out + O_NK), (const float*)(out + O_NV), dbg); break;
        case 3: hipLaunchKernelGGL(chk_attn, cg, cb, 0, stream, (const bf16*)(ws + WS_Q), (const bf16*)(ws + WS_KF), (const bf16*)(ws + WS_VTF), a.in[I_RPB], (const bf16*)(ws + WS_O), dbg); break;
        case 5: hipLaunchKernelGGL(chk_norm, cg, cb, 0, stream, (const float*)X1, (const float*)X1, 0, a.in[I_N2G], modl, 3, 4, (const bf16*)HB, dbg, 7); hipLaunchKernelGGL(chk_res, cg, cb, 0, stream, (const bf16*)(ws + WS_O), (const bf16*)(ws + WS_WO), D, a.in[I_XP], a.in[I_XS], (int)MP, (mod + (size_t)0 * 3 * 12288) + 2 * 2048, (const float*)X1, dbg, 6); break;
        case 6: hipLaunchKernelGGL(chk_wt, cg, cb, 0, stream, a.in[I_WDN], (const bf16*)(ws + WS_WDN0), FF, D, dbg, 0); break;
        case 7: hipLaunchKernelGGL(chk_upconv, cg, cb, 0, stream, (const bf16*)HB, (const bf16*)(ws + WS_WUP0), a.in[I_CONVW], a.in[I_CONVB], (const bf16*)(ws + WS_ACT), dbg, 9); break;
        case 9: hipLaunchKernelGGL(chk_norm, cg, cb, 0, stream, (const float*)X1, (const float*)X1, 0, a.in[I_N1G] + D, modl, 0, 1, (const bf16*)HB, dbg, 11); hipLaunchKernelGGL(chk_res, cg, cb, 0, stream, (const bf16*)(ws + WS_ACT), (const bf16*)(ws + WS_WDN0), FF, (const float*)XBK, (const float*)XBK, 0, (mod + (size_t)0 * 3 * 12288) + 5 * 2048, (const float*)X1, dbg, 10); break;
        case 10: hipLaunchKernelGGL(chk_gemm_bf, cg, cb, 0, stream, (const bf16*)HB, (const bf16*)(ws + WS_WIN), D, D, (const bf16*)(ws + WS_U), dbg, 12, 1); break;
        case 11: { S5P sp; sp.p[0] = a.in[I_ARE]; sp.p[1] = a.in[I_AIM]; sp.p[2] = a.in[I_LOGDT]; sp.p[3] = a.in[I_BRE]; sp.p[4] = a.in[I_BIM]; sp.p[5] = a.in[I_CRE]; sp.p[6] = a.in[I_CIM]; sp.p[7] = a.in[I_SD];
            hipLaunchKernelGGL(chk_s5, dim3(128), cb, 0, stream, (const bf16*)(ws + WS_U), sp, a.in[I_SRE], a.in[I_SIM], (const bf16*)(ws + WS_Y), (const float*)out, dbg, 13); } break;
        case 12: hipLaunchKernelGGL(chk_wt, cg, cb, 0, stream, a.in[I_WUP] + (size_t)D * F2, (const bf16*)(ws + WS_WUP1), D, F2, dbg, 1); hipLaunchKernelGGL(chk_wt, cg, cb, 0, stream, a.in[I_WDN] + (size_t)FF * D, (const bf16*)(ws + WS_WDN1), FF, D, dbg, 0); hipLaunchKernelGGL(chk_gate, cg, cb, 0, stream, (const bf16*)(ws + WS_Y), (const bf16*)(ws + WS_WGATE), (const bf16*)(ws + WS_Y2), dbg, 15); break;
        case 14: hipLaunchKernelGGL(chk_norm, cg, cb, 0, stream, (const float*)X1, (const float*)X1, 0, a.in[I_N2G] + D, modl, 3, 4, (const bf16*)HB, dbg, 17); hipLaunchKernelGGL(chk_res, cg, cb, 0, stream, (const bf16*)(ws + WS_Y2), (const bf16*)(ws + WS_WOUT), D, (const float*)XBK, (const float*)XBK, 0, (mod + (size_t)1 * 3 * 12288) + 2 * 2048, (const float*)X1, dbg, 16); break;
        case 16: hipLaunchKernelGGL(chk_upconv, cg, cb, 0, stream, (const bf16*)HB, (const bf16*)(ws + WS_WUP1), a.in[I_CONVW] + (size_t)3 * F2, a.in[I_CONVB] + F2, (const bf16*)(ws + WS_ACT), dbg, 19); break;
        case 18: hipLaunchKernelGGL(chk_final, cg, cb, 0, stream, (const float*)X1, a.in[I_FG], (const float*)out, dbg, 21); hipLaunchKernelGGL(chk_res, cg, cb, 0, stream, (const bf16*)(ws + WS_ACT), (const bf16*)(ws + WS_WDN1), FF, (const float*)XBK, (const float*)XBK, 0, (mod + (size_t)1 * 3 * 12288) + 5 * 2048, (const float*)X1, dbg, 20); break;
        }
    }
    hipLaunchKernelGGL(dbg_report, dim3(1024), dim3(256), 0, stream, (const float*)dbg, out, (size_t)O_END, (int)DBG_FORCE_STAGE);
#endif
}
```
